# Optimizing an MI355X kernel written in HIP

```python
import math
import jax
import jax.numpy as jnp
from jax import lax
import numpy as np

D_MODEL = 1024
BATCH = 16
SEQ = 2048
DEPTH = 2

HEAD_DIM = 64
A_HEADS = 6
B_HEADS = 5
C_HEADS = 5
MIX_WIDTH = (A_HEADS + B_HEADS + C_HEADS) * HEAD_DIM
DILATED_PATTERNS = ((128, 1), (512, 4), (2048, 16))
MLA_Q_RANK = 256
MLA_KV_RANK = 128
MLA_NOPE_DIM = 64
MLA_ROPE_DIM = 32
MLA_V_DIM = HEAD_DIM
IDX_HEADS = 8
IDX_DIM = 64
IDX_ROPE_DIM = 32
TOPK_MAX = 256
D_FF = 2816
MACARON_WEIGHT = 0.5
N_BUCKETS = 32
MAX_DISTANCE = 128
ROPE_THETA = 10000.0
QBLOCK = 128
RMS_EPS = 1e-6
N_MOD = 9
NEG_INF = -1e30

IN_SPLITS = (A_HEADS * HEAD_DIM, A_HEADS * HEAD_DIM, A_HEADS * HEAD_DIM,
             MLA_Q_RANK, MLA_KV_RANK, MLA_ROPE_DIM,
             C_HEADS * HEAD_DIM, C_HEADS * HEAD_DIM, C_HEADS * HEAD_DIM,
             IDX_HEADS * IDX_DIM, IDX_DIM, IDX_HEADS)
IN_WIDTH = sum(IN_SPLITS)

kernel_name = 'hybrid_dilated_mla_dsa_macaron_adaln'


def rmsnorm(x, g):
    xf = x.astype(jnp.float32)
    y = xf * lax.rsqrt(jnp.mean(xf * xf, axis=-1, keepdims=True) + RMS_EPS)
    return (y * g.astype(jnp.float32)).astype(x.dtype)


def modulate(x, shift, scale):
    return x * (1 + scale[:, None, :]) + shift[:, None, :]


def swiglu(x, w_gu, w_down):
    g, u = jnp.split(x @ w_gu, 2, axis=-1)
    return (jax.nn.silu(g) * u) @ w_down


def t5_bucket(dist):
    n = jnp.maximum(dist, 0)
    max_exact = N_BUCKETS // 2
    nf = jnp.maximum(n, 1).astype(jnp.float32)
    large = max_exact + (jnp.log(nf / max_exact) / math.log(MAX_DISTANCE / max_exact)
                         * (N_BUCKETS - max_exact)).astype(jnp.int32)
    large = jnp.minimum(large, N_BUCKETS - 1)
    return jnp.where(n < max_exact, n, large)


def rope(x, pos):
    half = x.shape[-1] // 2
    inv = ROPE_THETA ** (-jnp.arange(half, dtype=jnp.float32) / half)
    ang = pos.astype(jnp.float32)[..., None] * inv
    cos = jnp.cos(ang)[:, :, None, :]
    sin = jnp.sin(ang)[:, :, None, :]
    x1 = x[..., :half].astype(jnp.float32)
    x2 = x[..., half:].astype(jnp.float32)
    return jnp.concatenate([x1 * cos - x2 * sin, x2 * cos + x1 * sin], axis=-1).astype(x.dtype)


def dilated_branch(q, k, v, window, dilation, bias_tab):
    B, T, H, Dh = q.shape
    n = T // dilation
    steps = window // dilation
    n_pad = -(-n // QBLOCK) * QBLOCK
    nb = n_pad // QBLOCK

    def regroup(z):
        z = z.reshape(B, n, dilation, H, Dh).transpose(0, 2, 1, 3, 4)
        z = jnp.pad(z, ((0, 0), (0, 0), (0, n_pad - n), (0, 0), (0, 0)))
        return z.reshape(B, dilation, nb, QBLOCK, H, Dh)

    def band(z):
        prev = jnp.pad(z, ((0, 0), (0, 0), (1, 0), (0, 0), (0, 0), (0, 0)))[:, :, :-1]
        return jnp.concatenate([prev, z], axis=3)

    qb = regroup(q)
    kband = band(regroup(k))
    vband = band(regroup(v))
    logits = jnp.einsum('bdnqhe,bdnkhe->bdnhqk', qb, kband).astype(jnp.float32) * HEAD_DIM ** -0.5
    qi = jnp.arange(QBLOCK)[:, None]
    kj = jnp.arange(2 * QBLOCK)[None, :]
    step = QBLOCK + qi - kj
    bias = bias_tab[t5_bucket(step * dilation)].astype(jnp.float32).transpose(2, 0, 1)
    in_band = (step >= 0) & (step <= steps)
    key_idx = jnp.arange(nb)[:, None, None] * QBLOCK + kj[None] - QBLOCK
    valid = in_band[None] & (key_idx >= 0)
    logits = jnp.where(valid[None, None, :, None], logits + bias, NEG_INF)
    m = jnp.max(logits, axis=-1, keepdims=True)
    p = jnp.exp(logits - m)
    s = jnp.sum(p, axis=-1, keepdims=True)
    o = jnp.einsum('bdnhqk,bdnkhe->bdnqhe', (p / s).astype(v.dtype), vband)
    lse = (m + jnp.log(s))[..., 0]
    o = o.reshape(B, dilation, n_pad, H, Dh)[:, :, :n].transpose(0, 2, 1, 3, 4).reshape(B, T, H, Dh)
    lse = lse.transpose(0, 1, 2, 4, 3).reshape(B, dilation, n_pad, H)[:, :, :n]
    lse = lse.transpose(0, 2, 1, 3).reshape(B, T, H)
    return o, lse


def dilated_attention(q, k, v, bias_tab):
    results = [dilated_branch(q, k, v, w, d, bias_tab) for (w, d) in DILATED_PATTERNS]
    outs = jnp.stack([r[0] for r in results], axis=0).astype(jnp.float32)
    lses = jnp.stack([r[1] for r in results], axis=0)
    wts = jax.nn.softmax(lses, axis=0)
    return jnp.sum(wts[..., None] * outs, axis=0).astype(q.dtype)


def causal_block_attention(q, k, v, scale):
    B, T, H, _ = q.shape
    kpos = jnp.arange(T)

    def one_block(i):
        start = i * QBLOCK
        q_b = lax.dynamic_slice_in_dim(q, start, QBLOCK, axis=1)
        qpos = start + jnp.arange(QBLOCK)
        logits = jnp.einsum('bqhd,bkhd->bhqk', q_b, k).astype(jnp.float32) * scale
        logits = jnp.where(kpos[None, :] <= qpos[:, None], logits, NEG_INF)
        p = jax.nn.softmax(logits, axis=-1)
        return jnp.einsum('bhqk,bkhd->bqhd', p.astype(v.dtype), v)

    out = lax.map(one_block, jnp.arange(T // QBLOCK))
    return out.transpose(1, 0, 2, 3, 4).reshape(B, T, H, v.shape[-1])


def mla_attention(cq, ckv, k_rope_raw, pos, q_norm, w_uq, kv_norm, w_ukv):
    B, T, _ = cq.shape
    q = (rmsnorm(cq, q_norm) @ w_uq).reshape(B, T, B_HEADS, MLA_NOPE_DIM + MLA_ROPE_DIM)
    q = jnp.concatenate([q[..., :MLA_NOPE_DIM], rope(q[..., MLA_NOPE_DIM:], pos)], axis=-1)
    kv = (rmsnorm(ckv, kv_norm) @ w_ukv).reshape(B, T, B_HEADS, MLA_NOPE_DIM + MLA_V_DIM)
    k_nope = kv[..., :MLA_NOPE_DIM]
    v = kv[..., MLA_NOPE_DIM:]
    k_r = rope(k_rope_raw[:, :, None, :], pos)
    k = jnp.concatenate([k_nope, jnp.broadcast_to(k_r, (B, T, B_HEADS, MLA_ROPE_DIM))], axis=-1)
    return causal_block_attention(q, k, v, (MLA_NOPE_DIM + MLA_ROPE_DIM) ** -0.5)


def dsa_attention(q, k, v, iq, ik, iw, pos, ik_norm, bias_tab):
    B, T, H, Dh = q.shape
    n_sel = min(TOPK_MAX, T // 4)
    iq = iq.reshape(B, T, IDX_HEADS, IDX_DIM)
    iq = jnp.concatenate([rope(iq[..., :IDX_ROPE_DIM], pos), iq[..., IDX_ROPE_DIM:]], axis=-1)
    ik = rmsnorm(ik, ik_norm)[:, :, None, :]
    ik = jnp.concatenate([rope(ik[..., :IDX_ROPE_DIM], pos), ik[..., IDX_ROPE_DIM:]], axis=-1)[:, :, 0]
    iw = iw.astype(jnp.float32) * (IDX_HEADS ** -0.5 * IDX_DIM ** -0.5)
    kpos = jnp.arange(T)
    bidx = jnp.arange(B)[:, None, None]

    def one_block(i):
        start = i * QBLOCK
        qpos = start + jnp.arange(QBLOCK)
        iq_b = lax.dynamic_slice_in_dim(iq, start, QBLOCK, axis=1)
        iw_b = lax.dynamic_slice_in_dim(iw, start, QBLOCK, axis=1)
        rel = jax.nn.relu(jnp.einsum('bqhd,bkd->bqhk', iq_b, ik).astype(jnp.float32))
        score = jnp.einsum('bqhk,bqh->bqk', rel, iw_b)
        score = jnp.where(kpos[None, None, :] <= qpos[None, :, None], score, -jnp.inf)
        _, idx = lax.top_k(score, n_sel)
        dist = qpos[None, :, None] - idx
        kg = k[bidx, idx]
        vg = v[bidx, idx]
        q_b = lax.dynamic_slice_in_dim(q, start, QBLOCK, axis=1)
        logits = jnp.einsum('bqhd,bqkhd->bhqk', q_b, kg).astype(jnp.float32) * Dh ** -0.5
        logits = logits + bias_tab[t5_bucket(dist)].astype(jnp.float32).transpose(0, 3, 1, 2)
        logits = jnp.where((dist >= 0)[:, None], logits, NEG_INF)
        p = jax.nn.softmax(logits, axis=-1)
        return jnp.einsum('bhqk,bqkhd->bqhd', p.astype(v.dtype), vg)

    out = lax.map(one_block, jnp.arange(T // QBLOCK))
    return out.transpose(1, 0, 2, 3, 4).reshape(B, T, H, Dh)


def hybrid_mixer(n, pos, rel_bias, w_in, q_norm, w_uq, kv_norm, w_ukv, ik_norm, w_out):
    B, T, _ = n.shape
    offsets = np.cumsum(IN_SPLITS)[:-1].tolist()
    (qa, ka, va, cq, ckv, kr, qc, kc, vc, iq, ik, iw) = jnp.split(n @ w_in, offsets, axis=-1)
    bias_a = rel_bias[:, :A_HEADS]
    bias_c = rel_bias[:, A_HEADS:]
    oa = dilated_attention(qa.reshape(B, T, A_HEADS, HEAD_DIM), ka.reshape(B, T, A_HEADS, HEAD_DIM),
                           va.reshape(B, T, A_HEADS, HEAD_DIM), bias_a)
    ob = mla_attention(cq, ckv, kr, pos, q_norm, w_uq, kv_norm, w_ukv)
    oc = dsa_attention(qc.reshape(B, T, C_HEADS, HEAD_DIM), kc.reshape(B, T, C_HEADS, HEAD_DIM),
                       vc.reshape(B, T, C_HEADS, HEAD_DIM), iq, ik, iw, pos, ik_norm, bias_c)
    o = jnp.concatenate([oa.reshape(B, T, -1), ob.reshape(B, T, -1), oc.reshape(B, T, -1)], axis=-1)
    return o @ w_out


def setup_inputs(seed: int = 0) -> dict:
    key = jax.random.key(seed)
    ks = iter(jax.random.split(key, 32))
    f32 = jnp.float32
    L, D = DEPTH, D_MODEL

    def dense(shape, fan_in, gain=1.0):
        return gain * fan_in ** -0.5 * jax.random.normal(next(ks), shape, f32)

    def norm_gain(shape):
        return 1.0 + 0.05 * jax.random.normal(next(ks), shape, f32)

    x = jax.random.normal(next(ks), (BATCH, SEQ, D), f32)
    c = jax.random.normal(next(ks), (BATCH, D), f32)
    offset = jax.random.randint(next(ks), (BATCH, 1), 0, 4096, dtype=jnp.int32)
    positions = offset + jnp.arange(SEQ, dtype=jnp.int32)[None, :]
    rel_bias = 0.5 * jax.random.normal(next(ks), (N_BUCKETS, A_HEADS + C_HEADS), f32)
    ada_w = dense((L, D, N_MOD * D), D, 0.5)
    ada_b = 0.02 * jax.random.normal(next(ks), (L, N_MOD * D), f32)
    norm_ffn1 = norm_gain((L, D))
    ffn1_w_gu = dense((L, D, 2 * D_FF), D)
    ffn1_w_down = dense((L, D_FF, D), D_FF)
    norm_mix = norm_gain((L, D))
    w_in = dense((L, D, IN_WIDTH), D)
    mla_q_norm = norm_gain((L, MLA_Q_RANK))
    mla_w_uq = dense((L, MLA_Q_RANK, B_HEADS * (MLA_NOPE_DIM + MLA_ROPE_DIM)), MLA_Q_RANK)
    mla_kv_norm = norm_gain((L, MLA_KV_RANK))
    mla_w_ukv = dense((L, MLA_KV_RANK, B_HEADS * (MLA_NOPE_DIM + MLA_V_DIM)), MLA_KV_RANK)
    idx_k_norm = norm_gain((L, IDX_DIM))
    w_out = dense((L, MIX_WIDTH, D), MIX_WIDTH)
    norm_ffn2 = norm_gain((L, D))
    ffn2_w_gu = dense((L, D, 2 * D_FF), D)
    ffn2_w_down = dense((L, D_FF, D), D_FF)
    final_norm = norm_gain((D,))
    return {'x': x, 'c': c, 'positions': positions, 'rel_bias': rel_bias,
            'ada_w': ada_w, 'ada_b': ada_b,
            'norm_ffn1': norm_ffn1, 'ffn1_w_gu': ffn1_w_gu, 'ffn1_w_down': ffn1_w_down,
            'norm_mix': norm_mix, 'w_in': w_in,
            'mla_q_norm': mla_q_norm, 'mla_w_uq': mla_w_uq,
            'mla_kv_norm': mla_kv_norm, 'mla_w_ukv': mla_w_ukv,
            'idx_k_norm': idx_k_norm, 'w_out': w_out,
            'norm_ffn2': norm_ffn2, 'ffn2_w_gu': ffn2_w_gu, 'ffn2_w_down': ffn2_w_down,
            'final_norm': final_norm}


def reference(x, c, positions, rel_bias, ada_w, ada_b, norm_ffn1, ffn1_w_gu, ffn1_w_down,
              norm_mix, w_in, mla_q_norm, mla_w_uq, mla_kv_norm, mla_w_ukv, idx_k_norm,
              w_out, norm_ffn2, ffn2_w_gu, ffn2_w_down, final_norm):
    h = x
    cond = jax.nn.silu(c)
    for l in range(DEPTH):
        mod = cond @ ada_w[l] + ada_b[l]
        (sh1, sc1, g1, sh2, sc2, g2, sh3, sc3, g3) = jnp.split(mod, N_MOD, axis=-1)
        n1 = modulate(rmsnorm(h, norm_ffn1[l]), sh1, sc1)
        h = h + MACARON_WEIGHT * g1[:, None, :] * swiglu(n1, ffn1_w_gu[l], ffn1_w_down[l])
        n2 = modulate(rmsnorm(h, norm_mix[l]), sh2, sc2)
        h = h + g2[:, None, :] * hybrid_mixer(n2, positions, rel_bias, w_in[l], mla_q_norm[l],
                                              mla_w_uq[l], mla_kv_norm[l], mla_w_ukv[l],
                                              idx_k_norm[l], w_out[l])
        n3 = modulate(rmsnorm(h, norm_ffn2[l]), sh3, sc3)
        h = h + MACARON_WEIGHT * g3[:, None, :] * swiglu(n3, ffn2_w_gu[l], ffn2_w_down[l])
    return rmsnorm(h, final_norm)
```

```cpp
#include <hip/hip_runtime.h>
#include <hip/hip_cooperative_groups.h>
#include <cstdio>
#include <cstdint>
namespace cg = cooperative_groups;

#define LAS __attribute__((address_space(3)))
typedef unsigned short bf16_t;
typedef short bf16x8 __attribute__((ext_vector_type(8)));
typedef short s16x4 __attribute__((ext_vector_type(4)));
typedef float f32x4 __attribute__((ext_vector_type(4)));
typedef float f32x2 __attribute__((ext_vector_type(2)));
typedef unsigned u32x4 __attribute__((ext_vector_type(4)));
typedef unsigned u32x2 __attribute__((ext_vector_type(2)));
typedef unsigned long long u64;

constexpr int BATCH = 16, SEQ = 2048, DM = 1024, MTOK = BATCH * SEQ, DFF = 2816, NGU = 2 * DFF, INW = 3112, INWP = 3328, NMOD = 9, DEPTH = 2;
constexpr int OFF_QA = 0, OFF_KA = 384, OFF_VA = 768, OFF_CQ = 1152, OFF_CKV = 1408, OFF_KR = 1536, OFF_QC = 1568, OFF_KC = 1888, OFF_VC = 2208, OFF_IQ = 2528, OFF_IK = 3040, OFF_IW = 3104;
constexpr int MLA_K = 384, MLA_N = 1280;
constexpr int MODW = NMOD * DM;
constexpr float RMS_EPS = 1e-6f;
constexpr float NEGV = -1e30f;

constexpr size_t MiB = 1ull << 20;
constexpr size_t WS_NB = 0;
constexpr size_t WS_BIG = 64 * MiB;
constexpr size_t WS_MLAA = 272 * MiB;
constexpr size_t WS_MLAO = 296 * MiB;
constexpr size_t WS_KROPE = 376 * MiB;
constexpr size_t WS_IKN = 378 * MiB;
constexpr size_t WS_MASK = 382 * MiB;
constexpr size_t WS_MOD = 390 * MiB;
constexpr size_t WS_ADAP = 392 * MiB;
constexpr size_t WS_W = 402 * MiB;
constexpr size_t WL_STRIDE = 43 * MiB;
constexpr size_t WO_GU1 = 0, WO_D1 = 11 * MiB, WO_IN = 11 * MiB + 5632 * 1024, WO_MLA = WO_IN + (size_t)INWP * 1024 * 2, WO_OUT = WO_MLA + 1 * MiB, WO_GU2 = WO_OUT + 2 * MiB, WO_D2 = WO_GU2 + 11 * MiB;
static_assert(WO_D2 + 5632 * 1024 <= WL_STRIDE, "weights map");
constexpr size_t WS_END = WS_W + 2 * WL_STRIDE;

constexpr int LDS_BYTES = 143360;

struct Params {
  const float* x; const float* c; const int* pos; const float* rel_bias; const float* ada_w; const float* ada_b;
  const float* norm_ffn1; const float* ffn1_gu; const float* ffn1_down; const float* norm_mix; const float* w_in;
  const float* q_norm; const float* w_uq; const float* kv_norm; const float* w_ukv; const float* ik_norm; const float* w_out;
  const float* norm_ffn2; const float* ffn2_gu; const float* ffn2_down; const float* final_norm;
  float* out; unsigned char* ws;
};

__device__ __forceinline__ unsigned cvt_pk_bf16(float lo, float hi) { unsigned r; asm volatile("v_cvt_pk_bf16_f32 %0, %1, %2" : "=v"(r) : "v"(lo), "v"(hi)); return r; }
__device__ __forceinline__ float bf2f(unsigned short h) { return __builtin_bit_cast(float, (unsigned)h << 16); }
__device__ __forceinline__ float bflo(unsigned w) { return __builtin_bit_cast(float, w << 16); }
__device__ __forceinline__ float bfhi(unsigned w) { return __builtin_bit_cast(float, w & 0xffff0000u); }
__device__ __forceinline__ unsigned short f2bf(float f) { return (unsigned short)(cvt_pk_bf16(f, 0.f) & 0xffffu); }
__device__ __forceinline__ int otid() { int t = threadIdx.x; asm volatile("" : "+v"(t)); return t; }
__device__ __forceinline__ float wave_sum(float v) {
#pragma unroll
  for (int o = 1; o < 64; o <<= 1) v += __shfl_xor(v, o);
  return v;
}
__device__ __forceinline__ int t5_bucket(int n) {
  if (n < 16) return n;
  int b = 16;
  b += (n >= 19); b += (n >= 21); b += (n >= 24); b += (n >= 27); b += (n >= 31); b += (n >= 35); b += (n >= 40); b += (n >= 46);
  b += (n >= 52); b += (n >= 59); b += (n >= 67); b += (n >= 77); b += (n >= 87); b += (n >= 99); b += (n >= 113);
  return b;
}
__device__ __forceinline__ void sincos_big(float ang, float& s, float& c) {
  double rev = (double)ang * 0.15915494309189535;
  rev -= __builtin_floor(rev);
  float fr = (float)rev;
  s = __builtin_amdgcn_sinf(fr); c = __builtin_amdgcn_cosf(fr);
}
__device__ __forceinline__ float rope_inv(int i) { return __builtin_amdgcn_exp2f(-(float)i * (13.287712379549449f / 16.f)); }

namespace pg8 {
constexpr int BM = 256, BK = 64, HALF = 128, HTB = HALF * BK * 2, STAGE_BYTES = 8 * HTB, NXCD = 8, WGM = 8;
__host__ __device__ __forceinline__ int lds_byte(int r, int c) { const int st = (r >> 4) * 2 + (c >> 5), rr = r & 15, cc = c & 31, ob = rr * 64 + cc * 2; return st * 1024 + (ob ^ (((ob >> 9) & 1) << 5)); }
__host__ __device__ __forceinline__ void stage_rc(int b, int& R, int& C) { const int st = b / 1024, sb = b % 1024, swz = sb ^ (((sb >> 9) & 1) << 5); R = (st >> 1) * 16 + swz / 64; C = (st & 1) * 32 + (swz % 64) / 2; }
__host__ __device__ __forceinline__ int perm32(int rho) { const int n = rho >> 4, i = rho & 15; return 8 * (i >> 2) + 4 * n + (i & 3); }
struct Unit { int pm, pn; };
struct Gemm { const bf16_t* A; const bf16_t* Bt; int M, N, K; };
struct StaticOrder {
  int nM, nN, nwg, G, c;
  __host__ __device__ void init(int M, int N, int G_, int c_) { nM = M / BM; nN = N / BM; nwg = nM * nN; G = G_; c = c_; }
  __host__ __device__ bool next(int i, Unit& u) const {
    const long L = (long)i * G + c; if (L >= nwg) return false;
    int wgid = (int)L; { const int q = nwg / NXCD, r = nwg % NXCD, xcd = wgid % NXCD, off = wgid / NXCD; wgid = (xcd < r ? xcd * (q + 1) : r * (q + 1) + (xcd - r) * q) + off; }
    const int nig = WGM * nN, gid = wgid / nig, fm = gid * WGM, gsz = (nM - fm) < WGM ? (nM - fm) : WGM;
    u.pm = fm + ((wgid % nig) % gsz); u.pn = (wgid % nig) / gsz; return true;
  }
  __device__ __forceinline__ void a_ready(const Unit&) const {}
  __device__ __forceinline__ void done(const Unit&) const {}
};

struct EpiStore {
  static constexpr bool PERM = true, AFTER_DRAIN = false;
  bf16_t* O; int ldc;
  __device__ __forceinline__ void operator()(const f32x4 (&acc)[2][2][4][2], const Unit& u, int wr, int wc, int fr, int fq) const {
    const int row0 = u.pm * BM + wr * 64 + fr, col0 = u.pn * BM + wc * 32 + 8 * fq;
#pragma unroll
    for (int ai = 0; ai < 2; ++ai)
#pragma unroll
      for (int m = 0; m < 4; ++m) { bf16_t* rowp = O + (size_t)(row0 + ai * HALF + m * 16) * ldc + col0;
#pragma unroll
        for (int bj = 0; bj < 2; ++bj) { const f32x4 v0 = acc[ai][bj][m][0], v1 = acc[ai][bj][m][1];
          u32x4 w; w.x = cvt_pk_bf16(v0[0], v0[1]); w.y = cvt_pk_bf16(v0[2], v0[3]); w.z = cvt_pk_bf16(v1[0], v1[1]); w.w = cvt_pk_bf16(v1[2], v1[3]);
          *(u32x4*)(rowp + bj * HALF) = w; } }
  }
};
__device__ __forceinline__ float silu_mul(float g, float uu) { return g * __builtin_amdgcn_rcpf(1.f + __expf(-g)) * uu; }
struct EpiSwiglu {
  static constexpr bool PERM = true, AFTER_DRAIN = false;
  bf16_t* O;
  __device__ __forceinline__ void operator()(const f32x4 (&acc)[2][2][4][2], const Unit& u, int wr, int wc, int fr, int fq) const {
    const int row0 = u.pm * BM + wr * 64 + fr, col0 = u.pn * HALF + wc * 32 + 8 * fq;
#pragma unroll
    for (int ai = 0; ai < 2; ++ai)
#pragma unroll
      for (int m = 0; m < 4; ++m) { bf16_t* rowp = O + (size_t)(row0 + ai * HALF + m * 16) * DFF + col0;
        const f32x4 g0 = acc[ai][0][m][0], g1 = acc[ai][0][m][1], u0 = acc[ai][1][m][0], u1 = acc[ai][1][m][1];
        u32x4 w; w.x = cvt_pk_bf16(silu_mul(g0[0], u0[0]), silu_mul(g0[1], u0[1])); w.y = cvt_pk_bf16(silu_mul(g0[2], u0[2]), silu_mul(g0[3], u0[3]));
        w.z = cvt_pk_bf16(silu_mul(g1[0], u1[0]), silu_mul(g1[1], u1[1])); w.w = cvt_pk_bf16(silu_mul(g1[2], u1[2]), silu_mul(g1[3], u1[3]));
        *(u32x4*)rowp = w; }
  }
};
struct EpiResid {
  static constexpr bool PERM = true, AFTER_DRAIN = false;
  const float* src; float* dst; const float* gate; float coef;
  __device__ __forceinline__ void operator()(const f32x4 (&acc)[2][2][4][2], const Unit& u, int wr, int wc, int fr, int fq) const {
    const int row0 = u.pm * BM + wr * 64 + fr, col0 = u.pn * BM + wc * 32 + 8 * fq;
    const float* gp = gate + (size_t)(u.pm >> 3) * MODW + col0;
    f32x4 gv[2][2];
#pragma unroll
    for (int bj = 0; bj < 2; ++bj)
#pragma unroll
      for (int n = 0; n < 2; ++n) gv[bj][n] = *(const f32x4*)(gp + bj * HALF + 4 * n) * coef;
#pragma unroll
    for (int ai = 0; ai < 2; ++ai)
#pragma unroll
      for (int m = 0; m < 4; ++m) { const size_t ro = (size_t)(row0 + ai * HALF + m * 16) * DM + col0;
#pragma unroll
        for (int bj = 0; bj < 2; ++bj)
#pragma unroll
          for (int n = 0; n < 2; ++n) { const f32x4 s = *(const f32x4*)(src + ro + bj * HALF + 4 * n);
            *(f32x4*)(dst + ro + bj * HALF + 4 * n) = s + gv[bj][n] * acc[ai][bj][m][n]; } }
  }
};

struct EpiDyn {
  static constexpr bool PERM = true, AFTER_DRAIN = false;
  int type; bf16_t* O; int ldc; const float* src; float* dst; const float* gate; float coef;
  __device__ __forceinline__ void operator()(const f32x4 (&acc)[2][2][4][2], const Unit& u, int wr, int wc, int fr, int fq) const {
    if (type == 0) { EpiStore e{O, ldc}; e(acc, u, wr, wc, fr, fq); }
    else if (type == 1) { EpiSwiglu e{O}; e(acc, u, wr, wc, fr, fq); }
    else { EpiResid e{src, dst, gate, coef}; e(acc, u, wr, wc, fr, fq); }
  }
};

template <class Epi, class Sched, bool ALIGN_EPI = false, bool SP2 = false>
__device__ __forceinline__ void gemm_phase(LAS unsigned char* lds, const Gemm g, const Sched& S, const Epi& E) {
  const int tid = otid(), wid = __builtin_amdgcn_readfirstlane(tid >> 6), lane = tid & 63, wr = wid >> 2, wc = wid & 3, fr = lane & 15, fq = lane >> 4;
  const int K = g.K, nt = K / BK;
  unsigned voffA[2], voffB[2];
#pragma unroll
  for (int i = 0; i < 2; ++i) { int R, C; stage_rc(tid * 16 + i * 8192, R, C); const int Rb = Epi::PERM ? ((R & ~31) + perm32(R & 31)) : R;
    voffA[i] = (unsigned)(R * K + C) * 2u; voffB[i] = (unsigned)(Rb * K + C) * 2u; }
  const size_t kstep = (size_t)(BK * 2);
  const size_t hstep = (size_t)HALF * K * 2;
  const size_t tstep = 2 * hstep;
  const unsigned ldsw = (unsigned)wid * 1024u;
  const int aoff = lds_byte(wr * 64 + fr, fq * 8), boff = lds_byte(wc * 32 + fr, fq * 8);
#define PG8_SA(b, h) (((b) * 2 + (h)) * HTB)
#define PG8_SB(b, h) ((4 + (b) * 2 + (h)) * HTB)
#define PG8_STAGE(bufoff, gbase, voff) do { _Pragma("unroll") for (int _i = 0; _i < 2; ++_i) \
        __builtin_amdgcn_global_load_lds((const unsigned*)((const char*)(gbase) + (voff)[_i]), (LAS unsigned*)(lds + (bufoff) + ldsw + _i * 8192), 16, 0, 0); } while (0)
#define PG8_LDA(dst, b, h) do { _Pragma("unroll") for (int m = 0; m < 4; ++m) _Pragma("unroll") for (int k = 0; k < 2; ++k) dst[m][k] = *(const LAS bf16x8*)(lds + PG8_SA(b, h) + aoff + m * 2048 + k * 1024); } while (0)
#define PG8_LDB(dst, b, h) do { _Pragma("unroll") for (int n = 0; n < 2; ++n) _Pragma("unroll") for (int k = 0; k < 2; ++k) dst[n][k] = *(const LAS bf16x8*)(lds + PG8_SB(b, h) + boff + n * 2048 + k * 1024); } while (0)
#define PG8_MMA(ai, bj, At, Bt) do { __builtin_amdgcn_s_setprio(1); _Pragma("unroll") for (int m = 0; m < 4; ++m) _Pragma("unroll") for (int n = 0; n < 2; ++n) _Pragma("unroll") for (int k = 0; k < 2; ++k) \
        acc[ai][bj][m][n] = __builtin_amdgcn_mfma_f32_16x16x32_bf16(Bt[n][k], At[m][k], acc[ai][bj][m][n], 0, 0, 0); __builtin_amdgcn_s_setprio(0); } while (0)
#define PG8_WAIT_V(n) asm volatile("s_waitcnt vmcnt(" #n ")" ::: "memory")
#define PG8_WAIT_L(n) asm volatile("s_waitcnt lgkmcnt(" #n ")" ::: "memory")
#define PG8_BAR __builtin_amdgcn_s_barrier()
#define PG8_SCHED __builtin_amdgcn_sched_barrier(0)
  Unit cur, nxt; int ui = 0;
  if (!S.next(0, cur)) return;
  f32x4 acc[2][2][4][2];
#pragma unroll
  for (int a = 0; a < 2; ++a)
#pragma unroll
    for (int b = 0; b < 2; ++b)
#pragma unroll
      for (int m = 0; m < 4; ++m)
#pragma unroll
        for (int n = 0; n < 2; ++n) acc[a][b][m][n] = (f32x4){0.f, 0.f, 0.f, 0.f};
  bf16x8 At[4][2], B0[2][2], B1[2][2];
  const char* cA = (const char*)g.A + (size_t)cur.pm * tstep; const char* cB = (const char*)g.Bt + (size_t)cur.pn * tstep;
  S.a_ready(cur);
  if constexpr (SP2) {
    PG8_STAGE(PG8_SB(0, 0), cB, voffB); PG8_STAGE(PG8_SB(0, 1), cB + hstep, voffB); PG8_STAGE(PG8_SA(0, 0), cA, voffA); PG8_STAGE(PG8_SA(0, 1), cA + hstep, voffA);
    if (wr == 1) PG8_BAR;
    PG8_WAIT_V(2); PG8_BAR;
    PG8_STAGE(PG8_SB(1, 0), cB + kstep, voffB); PG8_STAGE(PG8_SA(1, 0), cA + kstep, voffA); PG8_STAGE(PG8_SB(1, 1), cB + hstep + kstep, voffB);
    PG8_WAIT_V(6); PG8_BAR;
  } else {
    PG8_STAGE(PG8_SB(0, 0), cB, voffB); PG8_STAGE(PG8_SA(0, 0), cA, voffA); PG8_STAGE(PG8_SB(0, 1), cB + hstep, voffB); PG8_STAGE(PG8_SA(0, 1), cA + hstep, voffA);
    if (wr == 1) PG8_BAR;
    PG8_WAIT_V(4); PG8_BAR;
    PG8_STAGE(PG8_SB(1, 0), cB + kstep, voffB); PG8_STAGE(PG8_SA(1, 0), cA + kstep, voffA); PG8_STAGE(PG8_SB(1, 1), cB + hstep + kstep, voffB);
    PG8_WAIT_V(6); PG8_BAR;
  }
  for (;;) {
    const bool has_next = S.next(ui + 1, nxt);
    const char* nA = has_next ? (const char*)g.A + (size_t)nxt.pm * tstep : cA; const char* nB = has_next ? (const char*)g.Bt + (size_t)nxt.pn * tstep : cB;
#pragma unroll 1
    for (int t = 0; t < nt; t += 2) {
      const bool last = (t == nt - 2);
      const char* a1 = cA + (size_t)(t + 1) * kstep;
      const char* a2 = last ? nA : cA + (size_t)(t + 2) * kstep; const char* b2 = last ? nB : cB + (size_t)(t + 2) * kstep;
      const char* a3 = a2 + kstep; const char* b3 = b2 + kstep;
      if (last && has_next) S.a_ready(nxt);
      if constexpr (SP2) {
        PG8_LDB(B0, 0, 0); PG8_LDB(B1, 0, 1); PG8_SCHED; PG8_LDA(At, 0, 0); PG8_STAGE(PG8_SA(1, 1), a1 + hstep, voffA);
        PG8_WAIT_V(8); PG8_WAIT_L(0); PG8_BAR; PG8_MMA(0, 0, At, B0); PG8_MMA(0, 1, At, B1); PG8_BAR; PG8_SCHED;
        PG8_LDA(At, 0, 1); PG8_STAGE(PG8_SB(0, 0), b2, voffB); PG8_STAGE(PG8_SB(0, 1), b2 + hstep, voffB); PG8_STAGE(PG8_SA(0, 0), a2, voffA);
        PG8_WAIT_V(8); PG8_WAIT_L(0); PG8_BAR; PG8_MMA(1, 0, At, B0); PG8_MMA(1, 1, At, B1); PG8_BAR; PG8_SCHED;
        PG8_LDB(B0, 1, 0); PG8_LDB(B1, 1, 1); PG8_SCHED; PG8_LDA(At, 1, 0); PG8_STAGE(PG8_SA(0, 1), a2 + hstep, voffA);
        PG8_WAIT_V(8); PG8_WAIT_L(0); PG8_BAR; PG8_MMA(0, 0, At, B0); PG8_MMA(0, 1, At, B1); PG8_BAR; PG8_SCHED;
        PG8_LDA(At, 1, 1); PG8_STAGE(PG8_SB(1, 0), b3, voffB); PG8_STAGE(PG8_SB(1, 1), b3 + hstep, voffB); PG8_STAGE(PG8_SA(1, 0), a3, voffA);
        PG8_WAIT_V(8); PG8_WAIT_L(0); PG8_BAR; PG8_MMA(1, 0, At, B0); PG8_MMA(1, 1, At, B1); PG8_BAR; PG8_SCHED;
      } else {
        PG8_LDB(B0, 0, 0); PG8_SCHED; PG8_LDA(At, 0, 0); PG8_STAGE(PG8_SA(1, 1), a1 + hstep, voffA);
        PG8_WAIT_L(8); PG8_BAR; PG8_WAIT_L(0); PG8_MMA(0, 0, At, B0); PG8_BAR; PG8_SCHED;
        PG8_LDB(B1, 0, 1); PG8_STAGE(PG8_SB(0, 0), b2, voffB);
        PG8_BAR; PG8_WAIT_L(0); PG8_MMA(0, 1, At, B1); PG8_BAR;
        PG8_LDA(At, 0, 1); PG8_STAGE(PG8_SA(0, 0), a2, voffA);
        PG8_BAR; PG8_WAIT_L(0); PG8_MMA(1, 0, At, B0); PG8_BAR; PG8_SCHED;
        PG8_STAGE(PG8_SB(0, 1), b2 + hstep, voffB);
        PG8_WAIT_V(6); PG8_BAR; PG8_MMA(1, 1, At, B1); PG8_BAR;
        PG8_LDB(B0, 1, 0); PG8_SCHED; PG8_LDA(At, 1, 0); PG8_STAGE(PG8_SA(0, 1), a2 + hstep, voffA);
        PG8_WAIT_L(8); PG8_BAR; PG8_WAIT_L(0); PG8_MMA(0, 0, At, B0); PG8_BAR; PG8_SCHED;
        PG8_LDB(B1, 1, 1); PG8_STAGE(PG8_SB(1, 0), b3, voffB);
        PG8_BAR; PG8_WAIT_L(0); PG8_MMA(0, 1, At, B1); PG8_BAR;
        PG8_LDA(At, 1, 1); PG8_STAGE(PG8_SA(1, 0), a3, voffA);
        PG8_BAR; PG8_WAIT_L(0); PG8_MMA(1, 0, At, B0); PG8_BAR; PG8_SCHED;
        PG8_STAGE(PG8_SB(1, 1), b3 + hstep, voffB);
        PG8_WAIT_V(6); PG8_BAR; PG8_MMA(1, 1, At, B1); PG8_BAR;
      }
    }
    if constexpr (ALIGN_EPI) { if (wr == 0) PG8_BAR; }
    if constexpr (!Epi::AFTER_DRAIN) { E(acc, cur, wr, wc, fr, fq); S.done(cur); }
    if (!has_next) break;
#pragma unroll
    for (int a = 0; a < 2; ++a)
#pragma unroll
      for (int b = 0; b < 2; ++b)
#pragma unroll
        for (int m = 0; m < 4; ++m)
#pragma unroll
          for (int n = 0; n < 2; ++n) acc[a][b][m][n] = (f32x4){0.f, 0.f, 0.f, 0.f};
    cur = nxt; cA = nA; cB = nB; ++ui;
    if constexpr (ALIGN_EPI) { if (wr == 1) PG8_BAR; }
  }
  PG8_WAIT_V(0);
  if constexpr (!ALIGN_EPI) { if (wr == 0) PG8_BAR; }
  PG8_BAR;
#undef PG8_SA
#undef PG8_SB
#undef PG8_STAGE
#undef PG8_LDA
#undef PG8_LDB
#undef PG8_MMA
#undef PG8_WAIT_V
#undef PG8_WAIT_L
#undef PG8_BAR
#undef PG8_SCHED
}
}

template <class Epi>
__device__ __forceinline__ void run_gemm(unsigned char* lds, const bf16_t* A, const bf16_t* Bt, int N, int K, const Epi& E) {
  pg8::Gemm g{A, Bt, MTOK, N, K}; pg8::StaticOrder S; S.init(MTOK, N, (int)gridDim.x, (int)blockIdx.x);
  pg8::gemm_phase<Epi, pg8::StaticOrder, true, true>((LAS unsigned char*)lds, g, S, E);
  __syncthreads();
}

template <class F>
__device__ __forceinline__ void cvt_tile(F src, bf16_t* dst, int ldd, int n0, int k0, float* tile) {
  const int tid = otid();
#pragma unroll
  for (int i = 0; i < 8; ++i) { const int k = i * 8 + (tid >> 6), n = tid & 63; tile[k * 65 + n] = src(k0 + k, n0 + n); }
  __syncthreads();
  { const int n = tid >> 3, kc = (tid & 7) * 8; const float* s = tile + kc * 65 + n;
    u32x4 o; o.x = cvt_pk_bf16(s[0], s[65]); o.y = cvt_pk_bf16(s[2 * 65], s[3 * 65]); o.z = cvt_pk_bf16(s[4 * 65], s[5 * 65]); o.w = cvt_pk_bf16(s[6 * 65], s[7 * 65]);
    *(u32x4*)(dst + (size_t)(n0 + n) * ldd + k0 + kc) = o; }
  __syncthreads();
}

__device__ __forceinline__ void phase0(const Params& p, unsigned char* lds) {
  float* tile = (float*)lds;
  const int tid = otid();
  constexpr int N_ADA = DEPTH * 18 * 8;
  constexpr int T_GU = 88 * 16, T_D = 16 * 44, T_IN = 52 * 16, T_MLA = 20 * 6, T_OUT = 16 * 16;
  constexpr int T_LAYER = 2 * T_GU + 2 * T_D + T_IN + T_MLA + T_OUT;
  constexpr int NITEMS = N_ADA + DEPTH * T_LAYER;
  for (int it = blockIdx.x; it < NITEMS; it += gridDim.x) {
    if (it < N_ADA) {
      const int l = it / 144, r = it % 144, cb = r / 8, ks = r % 8;
      __syncthreads();
      for (int e = tid; e < 16 * 128; e += 512) { const int b = e >> 7, k = e & 127; const float v = p.c[b * DM + ks * 128 + k]; tile[e] = v / (1.f + __expf(-v)); }
      __syncthreads();
      const int j = cb * 512 + tid;
      const float* w = p.ada_w + (size_t)l * DM * MODW + (size_t)(ks * 128) * MODW + j;
      float acc[16];
#pragma unroll
      for (int b = 0; b < 16; ++b) acc[b] = 0.f;
      for (int k = 0; k < 128; ++k) { const float wv = w[(size_t)k * MODW];
#pragma unroll
        for (int b = 0; b < 16; ++b) acc[b] += tile[b * 128 + k] * wv; }
      float* dstp = (float*)(p.ws + WS_ADAP) + ((size_t)(ks * DEPTH + l) * 16) * MODW + j;
#pragma unroll
      for (int b = 0; b < 16; ++b) dstp[(size_t)b * MODW] = acc[b];
      __syncthreads();
      continue;
    }
    int r = it - N_ADA; const int l = r / T_LAYER; r -= l * T_LAYER;
    unsigned char* wl = p.ws + WS_W + (size_t)l * WL_STRIDE;
    if (r < 2 * T_GU) {
      const int f = r / T_GU; r -= f * T_GU; const int nt = r / 16, kt = r % 16, n0 = nt * 64;
      const int pn = n0 >> 8, bj = (n0 >> 7) & 1, i0 = n0 & 127, scol0 = bj * DFF + pn * 128 + i0 - n0;
      const float* W = (f ? p.ffn2_gu : p.ffn1_gu) + (size_t)l * DM * NGU;
      cvt_tile([=](int k, int n) { return W[(size_t)k * NGU + n + scol0]; }, (bf16_t*)(wl + (f ? WO_GU2 : WO_GU1)), DM, n0, kt * 64, tile);
      continue;
    }
    r -= 2 * T_GU;
    if (r < 2 * T_D) {
      const int f = r / T_D; r -= f * T_D; const int nt = r / 44, kt = r % 44;
      const float* W = (f ? p.ffn2_down : p.ffn1_down) + (size_t)l * DFF * DM;
      cvt_tile([=](int k, int n) { return W[(size_t)k * DM + n]; }, (bf16_t*)(wl + (f ? WO_D2 : WO_D1)), DFF, nt * 64, kt * 64, tile);
      continue;
    }
    r -= 2 * T_D;
    if (r < T_IN) {
      const int nt = r / 16, kt = r % 16;
      const float* W = p.w_in + (size_t)l * DM * INW;
      cvt_tile([=](int k, int n) { return n < INW ? W[(size_t)k * INW + n] : 0.f; }, (bf16_t*)(wl + WO_IN), DM, nt * 64, kt * 64, tile);
      continue;
    }
    r -= T_IN;
    if (r < T_MLA) {
      const int nt = r / 6, kt = r % 6;
      const float* Wq = p.w_uq + (size_t)l * 256 * 480; const float* Wkv = p.w_ukv + (size_t)l * 128 * 640;
      cvt_tile([=](int k, int n) { float v = 0.f; if (n < 480) { if (k < 256) v = Wq[(size_t)k * 480 + n]; } else if (n < 1120) { if (k >= 256) v = Wkv[(size_t)(k - 256) * 640 + (n - 480)]; } return v; },
               (bf16_t*)(wl + WO_MLA), MLA_K, nt * 64, kt * 64, tile);
      continue;
    }
    r -= T_MLA;
    { const int nt = r / 16, kt = r % 16;
      const float* W = p.w_out + (size_t)l * DM * DM;
      cvt_tile([=](int k, int n) { return W[(size_t)k * DM + n]; }, (bf16_t*)(wl + WO_OUT), DM, nt * 64, kt * 64, tile); }
  }
}
__device__ __forceinline__ void phase_mod_reduce(const Params& p) {
  float* mod = (float*)(p.ws + WS_MOD); const float* part = (const float*)(p.ws + WS_ADAP);
  constexpr int TOT = DEPTH * 16 * MODW;
  for (int e = blockIdx.x * 512 + otid(); e < TOT; e += gridDim.x * 512) {
    const int l = e / (16 * MODW), j = e % MODW;
    float s = p.ada_b[l * MODW + j];
#pragma unroll
    for (int ks = 0; ks < 8; ++ks) s += part[(size_t)ks * TOT + e];
    mod[e] = s;
  }
}

__device__ __forceinline__ void phase_norm(const float* src, const float* gain, const float* shift, const float* scale, bf16_t* dst) {
  const int tid_ = otid(), lane = tid_ & 63, gw = blockIdx.x * 8 + (tid_ >> 6), NGW = gridDim.x * 8;
  for (int m = gw; m < MTOK; m += NGW) {
    const f32x4* xr = (const f32x4*)(src + (size_t)m * DM) + lane;
    f32x4 v[4]; float s = 0.f;
#pragma unroll
    for (int j = 0; j < 4; ++j) { v[j] = xr[64 * j]; s += (v[j].x * v[j].x + v[j].y * v[j].y) + (v[j].z * v[j].z + v[j].w * v[j].w); }
    const float rs = 1.f / sqrtf(wave_sum(s) * (1.f / DM) + RMS_EPS);
    const int b = m / SEQ;
    const f32x4* gp = (const f32x4*)gain + lane; const f32x4* shp = (const f32x4*)(shift + (size_t)b * MODW) + lane; const f32x4* scp = (const f32x4*)(scale + (size_t)b * MODW) + lane;
    u64* o8 = (u64*)(dst + (size_t)m * DM) + lane;
#pragma unroll
    for (int j = 0; j < 4; ++j) { const f32x4 g = gp[64 * j], sh = shp[64 * j], sc = scp[64 * j];
      const f32x4 y = (v[j] * rs) * g * (sc + 1.f) + sh;
      o8[64 * j] = (u64)cvt_pk_bf16(y.x, y.y) | ((u64)cvt_pk_bf16(y.z, y.w) << 32); }
  }
}
__device__ __forceinline__ void phase_final_norm(float* h, const float* gain) {
  const int tid_ = otid(), lane = tid_ & 63, gw = blockIdx.x * 8 + (tid_ >> 6), NGW = gridDim.x * 8;
  for (int m = gw; m < MTOK; m += NGW) {
    f32x4* xr = (f32x4*)(h + (size_t)m * DM) + lane;
    f32x4 v[4]; float s = 0.f;
#pragma unroll
    for (int j = 0; j < 4; ++j) { v[j] = xr[64 * j]; s += (v[j].x * v[j].x + v[j].y * v[j].y) + (v[j].z * v[j].z + v[j].w * v[j].w); }
    const float rs = 1.f / sqrtf(wave_sum(s) * (1.f / DM) + RMS_EPS);
    const f32x4* gp = (const f32x4*)gain + lane;
#pragma unroll
    for (int j = 0; j < 4; ++j) xr[64 * j] = (v[j] * rs) * gp[64 * j];
  }
}

__device__ __forceinline__ void phase_prep(const Params& p, int l) {
  const int tid_ = otid(), lane = tid_ & 63, gw = blockIdx.x * 8 + (tid_ >> 6), NGW = gridDim.x * 8;
  bf16_t* proj = (bf16_t*)(p.ws + WS_BIG); bf16_t* mlaa = (bf16_t*)(p.ws + WS_MLAA); bf16_t* krope = (bf16_t*)(p.ws + WS_KROPE); bf16_t* ikn = (bf16_t*)(p.ws + WS_IKN);
  const float* qn = p.q_norm + l * 256; const float* kvn = p.kv_norm + l * 128; const float* ikg = p.ik_norm + l * 64;
  const float inv = rope_inv(lane & 15);
  for (int m = gw; m < MTOK; m += NGW) {
    bf16_t* pr = proj + (size_t)m * INWP;
    float sn, cs; sincos_big((float)p.pos[m] * inv, sn, cs);
    {
      const u32x2 w = *(const u32x2*)(pr + OFF_CQ + 4 * lane);
      const float a0 = bflo(w.x), a1 = bfhi(w.x), a2 = bflo(w.y), a3 = bfhi(w.y);
      const float rs = 1.f / sqrtf(wave_sum(a0 * a0 + a1 * a1 + a2 * a2 + a3 * a3) * (1.f / 256) + RMS_EPS);
      const f32x4 g = *(const f32x4*)(qn + 4 * lane);
      u32x2 o; o.x = cvt_pk_bf16(a0 * rs * g.x, a1 * rs * g.y); o.y = cvt_pk_bf16(a2 * rs * g.z, a3 * rs * g.w);
      *(u32x2*)(mlaa + (size_t)m * MLA_K + 4 * lane) = o; }
    {
      const unsigned w = *(const unsigned*)(pr + OFF_CKV + 2 * lane);
      const float a0 = bflo(w), a1 = bfhi(w);
      const float rs = 1.f / sqrtf(wave_sum(a0 * a0 + a1 * a1) * (1.f / 128) + RMS_EPS);
      const f32x2 g = *(const f32x2*)(kvn + 2 * lane);
      *(unsigned*)(mlaa + (size_t)m * MLA_K + 256 + 2 * lane) = cvt_pk_bf16(a0 * rs * g.x, a1 * rs * g.y); }
    if (lane < 16) {
      const float x1 = bf2f(pr[OFF_KR + lane]), x2 = bf2f(pr[OFF_KR + 16 + lane]);
      krope[(size_t)m * 32 + lane] = f2bf(x1 * cs - x2 * sn); krope[(size_t)m * 32 + 16 + lane] = f2bf(x2 * cs + x1 * sn); }
#pragma unroll
    for (int j = 0; j < 2; ++j) {
      const int pp = lane + 64 * j, hd = pp >> 4, i = pp & 15; bf16_t* q = pr + OFF_IQ + hd * 64;
      const float x1 = bf2f(q[i]), x2 = bf2f(q[16 + i]);
      q[i] = f2bf(x1 * cs - x2 * sn); q[16 + i] = f2bf(x2 * cs + x1 * sn); }
    {
      const float a = bf2f(pr[OFF_IK + lane]);
      const float rs = 1.f / sqrtf(wave_sum(a * a) * (1.f / 64) + RMS_EPS);
      const float y = a * rs * ikg[lane];
      const float pa = __shfl_xor(y, 16);
      float o = y;
      if (lane < 16) o = y * cs - pa * sn; else if (lane < 32) o = y * cs + pa * sn;
      ikn[(size_t)m * 64 + lane] = f2bf(o); }
  }
}
__device__ __forceinline__ void phase_qrope(const Params& p) {
  const int tid_ = otid(), lane = tid_ & 63, gw = blockIdx.x * 8 + (tid_ >> 6), NGW = gridDim.x * 8;
  bf16_t* mlao = (bf16_t*)(p.ws + WS_MLAO);
  const float inv = rope_inv(lane & 15);
  for (int m = gw; m < MTOK; m += NGW) {
    float sn, cs; sincos_big((float)p.pos[m] * inv, sn, cs);
#pragma unroll
    for (int j = 0; j < 2; ++j) { const int pp = lane + 64 * j;
      if (pp < 80) { const int hd = pp >> 4, i = pp & 15; bf16_t* q = mlao + (size_t)m * MLA_N + hd * 96 + 64;
        const float x1 = bf2f(q[i]), x2 = bf2f(q[16 + i]);
        q[i] = f2bf(x1 * cs - x2 * sn); q[16 + i] = f2bf(x2 * cs + x1 * sn); } }
  }
}

constexpr int SC_STRIDE = 2112;
__device__ __forceinline__ int wave_count(int c) { int t = 0;
#pragma unroll
  for (int b = 0; b < 6; ++b) t += (int)__popcll(__ballot((c >> b) & 1)) << b;
  return t; }
__device__ __forceinline__ unsigned fkey(float v) { const unsigned u = __builtin_bit_cast(unsigned, v + 0.0f); return (u & 0x80000000u) ? ~u : (u | 0x80000000u); }
__device__ __forceinline__ void phase_indexer(const Params& p, unsigned char* lds) {
  float* sc = (float*)lds;
  const int tid = otid(), lane = tid & 63, wave = __builtin_amdgcn_readfirstlane(tid >> 6), fr = lane & 15, fq = lane >> 4;
  const bf16_t* proj = (const bf16_t*)(p.ws + WS_BIG); const bf16_t* ikn = (const bf16_t*)(p.ws + WS_IKN); u64* mask = (u64*)(p.ws + WS_MASK);
  constexpr int NITEMS = BATCH * (SEQ / 16);
  for (int it = blockIdx.x; it < NITEMS; it += gridDim.x) {
    const int b = it % BATCH, qg = (SEQ / 16 - 1) - it / BATCH, t0 = qg * 16;
    const size_t rowb = (size_t)b * SEQ;
    if (t0 + 16 <= 256) {
      if (lane < 32) { mask[(rowb + t0 + 2 * wave) * 32 + lane] = ~0ull; mask[(rowb + t0 + 2 * wave + 1) * 32 + lane] = ~0ull; }
      continue;
    }
    __syncthreads();
    {
      const bf16_t* qrow = proj + (rowb + t0 + fr) * INWP;
      bf16x8 qf[8][2];
#pragma unroll
      for (int h = 0; h < 8; ++h)
#pragma unroll
        for (int s = 0; s < 2; ++s) qf[h][s] = *(const bf16x8*)(qrow + OFF_IQ + h * 64 + s * 32 + fq * 8);
      float wq[8];
      { const u32x4 w = *(const u32x4*)(qrow + OFF_IW); const float cw = 0.04419417382415922f;
        wq[0] = bflo(w.x) * cw; wq[1] = bfhi(w.x) * cw; wq[2] = bflo(w.y) * cw; wq[3] = bfhi(w.y) * cw; wq[4] = bflo(w.z) * cw; wq[5] = bfhi(w.z) * cw; wq[6] = bflo(w.w) * cw; wq[7] = bfhi(w.w) * cw; }
      const int nkt = qg + 1;
      for (int kt = wave; kt < nkt; kt += 8) {
        const bf16_t* krow = ikn + (rowb + kt * 16 + fr) * 64 + fq * 8;
        const bf16x8 k0 = *(const bf16x8*)krow, k1 = *(const bf16x8*)(krow + 32);
        f32x4 s4 = (f32x4){0.f, 0.f, 0.f, 0.f};
#pragma unroll
        for (int h = 0; h < 8; ++h) {
          f32x4 a = (f32x4){0.f, 0.f, 0.f, 0.f};
          a = __builtin_amdgcn_mfma_f32_16x16x32_bf16(k0, qf[h][0], a, 0, 0, 0);
          a = __builtin_amdgcn_mfma_f32_16x16x32_bf16(k1, qf[h][1], a, 0, 0, 0);
#pragma unroll
          for (int j = 0; j < 4; ++j) s4[j] += wq[h] * fmaxf(a[j], 0.f);
        }
        { const int c0 = kt * 16 + fq * 4; float* dp = sc + fr * SC_STRIDE + c0 + (c0 >> 5);
          dp[0] = s4[0]; dp[1] = s4[1]; dp[2] = s4[2]; dp[3] = s4[3]; }
      }
    }
    __syncthreads();
    for (int rr = 0; rr < 2; ++rr) {
      const int r = 2 * wave + rr, t = t0 + r;
      unsigned key[32];
#pragma unroll
      for (int j = 0; j < 32; ++j) { const int idx = lane * 32 + j; const float v = sc[r * SC_STRIDE + lane * 33 + j]; key[j] = (idx <= t) ? fkey(v) : 0u; }
      unsigned T = 0u;
#pragma unroll 1
      for (int bit = 31; bit >= 0; --bit) {
        const unsigned cand = T | (1u << bit);
        int c = 0;
#pragma unroll
        for (int j = 0; j < 32; ++j) asm volatile("v_cmp_ge_u32 vcc, %1, %2\n\tv_addc_co_u32 %0, vcc, 0, %0, vcc" : "+v"(c) : "v"(key[j]), "v"(cand) : "vcc");
        if (wave_count(c) >= 256) T = cand;
      }
      int cgt = 0, ceql = 0;
#pragma unroll
      for (int j = 0; j < 32; ++j) {
        asm volatile("v_cmp_gt_u32 vcc, %1, %2\n\tv_addc_co_u32 %0, vcc, 0, %0, vcc" : "+v"(cgt) : "v"(key[j]), "v"(T) : "vcc");
        asm volatile("v_cmp_eq_u32 vcc, %1, %2\n\tv_addc_co_u32 %0, vcc, 0, %0, vcc" : "+v"(ceql) : "v"(key[j]), "v"(T) : "vcc"); }
      cgt = wave_count(cgt); const int ceq = wave_count(ceql);
      const int need = 256 - cgt;
      int cutoff = 4096;
      if (ceq > need) {
        int incl = ceql;
#pragma unroll
        for (int o = 1; o < 64; o <<= 1) { const int v = __shfl_up(incl, o); if (lane >= o) incl += v; }
        const int excl = incl - ceql;
        int mycut = 4096;
        if (excl < need && incl >= need) { int k = need - excl;
#pragma unroll
          for (int j = 0; j < 32; ++j) { if (key[j] == T) { --k; if (k == 0) mycut = lane * 32 + j; } } }
#pragma unroll
        for (int o = 1; o < 64; o <<= 1) mycut = min(mycut, __shfl_xor(mycut, o));
        cutoff = mycut;
      }
      unsigned W = 0u;
#pragma unroll
      for (int j = 0; j < 32; ++j) { const int idx = lane * 32 + j; W |= ((key[j] > T || (key[j] == T && idx <= cutoff)) ? 1u : 0u) << j; __builtin_amdgcn_sched_barrier(0); }
      ((unsigned*)mask)[(rowb + t) * 64 + lane] = W;
    }
  }
  __syncthreads();
}

constexpr int KROW = 208, VROW = 144;
constexpr int AT_K = 0, AT_V = 64 * KROW, AT_TAB = AT_V + 64 * VROW, AT_END = AT_TAB + 2048 * 4;
__device__ __forceinline__ s16x4 vtr(const LAS unsigned char* ptr) { return __builtin_bit_cast(s16x4, __builtin_amdgcn_ds_read_tr16_b64_v4i16((LAS s16x4*)ptr)); }

template <int KS, int TYPE>
__device__ __forceinline__ void attn_item(const Params& p, unsigned char* lds, int b, int head, int qb) {
  const int tid = otid(), lane = tid & 63, wave = __builtin_amdgcn_readfirstlane(tid >> 6), fr = lane & 15, fq = lane >> 4;
  const bf16_t* proj = (const bf16_t*)(p.ws + WS_BIG); const bf16_t* mlao = (const bf16_t*)(p.ws + WS_MLAO);
  const bf16_t* Qp; const bf16_t* Kp; const bf16_t* Vp; int qpitch, kpitch; float scale;
  const size_t rowb = (size_t)b * SEQ;
  if (TYPE == 0) { Qp = proj + OFF_QA + head * 64; Kp = proj + OFF_KA + head * 64; Vp = proj + OFF_VA + head * 64; qpitch = kpitch = INWP; scale = 0.125f; }
  else if (TYPE == 1) { const int hb = head - 6; Qp = mlao + hb * 96; Kp = mlao + 480 + hb * 128; Vp = Kp + 64; qpitch = kpitch = MLA_N; scale = 0.10206207261596575f; }
  else { const int hc = head - 11; Qp = proj + OFF_QC + hc * 64; Kp = proj + OFF_KC + hc * 64; Vp = proj + OFF_VC + hc * 64; qpitch = kpitch = INWP; scale = 0.125f; }
  const bf16_t* K2p = (const bf16_t*)(p.ws + WS_KROPE);
  const u64* mask = (const u64*)(p.ws + WS_MASK);
  float* tab = (float*)(lds + AT_TAB);
  LAS unsigned char* l3 = (LAS unsigned char*)lds;

  __syncthreads();
  if (TYPE != 1) {
    const int col = (TYPE == 0) ? head : (head - 11 + 6);
    for (int d = tid; d < 2048; d += 512) {
      float v = p.rel_bias[t5_bucket(d) * 11 + col];
      if (TYPE == 0) { const int mult = (d <= 128) + ((d & 3) == 0 && d <= 512) + ((d & 15) == 0);
        v = (mult == 0) ? NEGV : v + (mult == 1 ? 0.f : (mult == 2 ? 0.6931471805599453f : 1.0986122886681098f)); }
      tab[d] = v;
    }
  }
  const int q0 = qb * 256 + wave * 32;
  bf16x8 qf[2][KS];
#pragma unroll
  for (int u = 0; u < 2; ++u)
#pragma unroll
    for (int s = 0; s < KS; ++s) qf[u][s] = *(const bf16x8*)(Qp + (rowb + q0 + u * 16 + fr) * qpitch + s * 32 + fq * 8);
  f32x4 o[4][2]; float mrow[2], lrow[2];
#pragma unroll
  for (int u = 0; u < 2; ++u) { mrow[u] = NEGV; lrow[u] = 0.f;
#pragma unroll
    for (int dt = 0; dt < 4; ++dt) o[dt][u] = (f32x4){0.f, 0.f, 0.f, 0.f}; }

  const int nkt = (qb + 1) * 4;
  const int lkey = tid >> 3, lch = tid & 7;
  u32x4 kreg, vreg, k2reg; u64 mreg[2] = {0ull, 0ull};
  auto prefetch = [&](int kt) {
    const size_t r = rowb + kt * 64 + lkey;
    kreg = *(const u32x4*)(Kp + r * kpitch + lch * 8);
    vreg = *(const u32x4*)(Vp + r * kpitch + lch * 8);
    if (KS == 3) { if (tid < 256) k2reg = *(const u32x4*)(K2p + (rowb + kt * 64 + (tid >> 2)) * 32 + (tid & 3) * 8); }
    if (TYPE == 2) { mreg[0] = mask[(rowb + q0 + fr) * 32 + kt]; mreg[1] = mask[(rowb + q0 + 16 + fr) * 32 + kt]; }
  };
  prefetch(0);
  for (int kt = 0; kt < nkt; ++kt) {
    __syncthreads();
    *(u32x4*)(lds + AT_K + lkey * KROW + lch * 16) = kreg;
    *(u32x4*)(lds + AT_V + lkey * VROW + lch * 16) = vreg;
    if (KS == 3) { if (tid < 256) *(u32x4*)(lds + AT_K + (tid >> 2) * KROW + 128 + (tid & 3) * 16) = k2reg; }
    const u64 mcur0 = mreg[0], mcur1 = mreg[1];
    __syncthreads();
    if (kt + 1 < nkt) prefetch(kt + 1);
    const int kbase = kt * 64;
    if (kbase > q0 + 31) continue;
    f32x4 s[4][2];
#pragma unroll
    for (int k16 = 0; k16 < 4; ++k16) {
      s[k16][0] = (f32x4){0.f, 0.f, 0.f, 0.f}; s[k16][1] = (f32x4){0.f, 0.f, 0.f, 0.f};
#pragma unroll
      for (int ss = 0; ss < KS; ++ss) {
        const bf16x8 kf = *(const LAS bf16x8*)(l3 + AT_K + (k16 * 16 + fr) * KROW + ss * 64 + fq * 16);
        s[k16][0] = __builtin_amdgcn_mfma_f32_16x16x32_bf16(kf, qf[0][ss], s[k16][0], 0, 0, 0);
        s[k16][1] = __builtin_amdgcn_mfma_f32_16x16x32_bf16(kf, qf[1][ss], s[k16][1], 0, 0, 0);
      }
    }
    bf16x8 pb[2][2];
#pragma unroll
    for (int u = 0; u < 2; ++u) {
      const int qpos = q0 + u * 16 + fr;
      const u64 mw = u ? mcur1 : mcur0;
      float mx = NEGV;
#pragma unroll
      for (int k16 = 0; k16 < 4; ++k16)
#pragma unroll
        for (int j = 0; j < 4; ++j) {
          const int kl = k16 * 16 + fq * 4 + j, dist = qpos - (kbase + kl);
          float v = s[k16][u][j] * scale;
          if (TYPE != 1) v += tab[dist < 0 ? 0 : dist];
          bool ok = dist >= 0;
          if (TYPE == 2) ok = ok && ((mw >> kl) & 1ull);
          v = ok ? v : NEGV;
          s[k16][u][j] = v; mx = fmaxf(mx, v);
        }
      mx = fmaxf(mx, __shfl_xor(mx, 16)); mx = fmaxf(mx, __shfl_xor(mx, 32));
      const float mnew = fmaxf(mrow[u], mx), alpha = __expf(mrow[u] - mnew);
      mrow[u] = mnew;
      float ps = 0.f;
#pragma unroll
      for (int k16 = 0; k16 < 4; ++k16)
#pragma unroll
        for (int j = 0; j < 4; ++j) { const float e = __expf(s[k16][u][j] - mnew); s[k16][u][j] = e; ps += e; }
      lrow[u] = lrow[u] * alpha + ps;
#pragma unroll
      for (int dt = 0; dt < 4; ++dt) o[dt][u] = o[dt][u] * alpha;
#pragma unroll
      for (int kc = 0; kc < 2; ++kc) {
        u32x4 w; w.x = cvt_pk_bf16(s[2 * kc][u][0], s[2 * kc][u][1]); w.y = cvt_pk_bf16(s[2 * kc][u][2], s[2 * kc][u][3]);
        w.z = cvt_pk_bf16(s[2 * kc + 1][u][0], s[2 * kc + 1][u][1]); w.w = cvt_pk_bf16(s[2 * kc + 1][u][2], s[2 * kc + 1][u][3]);
        pb[u][kc] = __builtin_bit_cast(bf16x8, w);
      }
    }
#pragma unroll
    for (int kc = 0; kc < 2; ++kc)
#pragma unroll
      for (int dt = 0; dt < 4; ++dt) {
        const LAS unsigned char* vb = l3 + AT_V + (kc * 32 + 4 * fq + (fr >> 2)) * VROW + (dt * 16 + 4 * (fr & 3)) * 2;
        const s16x4 v0 = vtr(vb), v1 = vtr(vb + 16 * VROW);
        bf16x8 vf; vf[0] = v0[0]; vf[1] = v0[1]; vf[2] = v0[2]; vf[3] = v0[3]; vf[4] = v1[0]; vf[5] = v1[1]; vf[6] = v1[2]; vf[7] = v1[3];
        o[dt][0] = __builtin_amdgcn_mfma_f32_16x16x32_bf16(vf, pb[0][kc], o[dt][0], 0, 0, 0);
        o[dt][1] = __builtin_amdgcn_mfma_f32_16x16x32_bf16(vf, pb[1][kc], o[dt][1], 0, 0, 0);
      }
  }
  bf16_t* outp = (bf16_t*)(p.ws + WS_NB);
#pragma unroll
  for (int u = 0; u < 2; ++u) {
    float l = lrow[u]; l += __shfl_xor(l, 16); l += __shfl_xor(l, 32);
    const float il = 1.f / l;
    bf16_t* orow = outp + (rowb + q0 + u * 16 + fr) * DM + head * 64 + fq * 4;
#pragma unroll
    for (int dt = 0; dt < 4; ++dt) { u32x2 w; w.x = cvt_pk_bf16(o[dt][u][0] * il, o[dt][u][1] * il); w.y = cvt_pk_bf16(o[dt][u][2] * il, o[dt][u][3] * il);
      *(u32x2*)(orow + dt * 16) = w; }
  }
}
__device__ __forceinline__ void phase_attn(const Params& p, unsigned char* lds) {
  constexpr int NITEMS = BATCH * 16 * 8;
  for (int it = blockIdx.x; it < NITEMS; it += gridDim.x) {
    const int r = it >> 8, c = it & 255;
    const int qb = (r & 1) ? (r >> 1) : 7 - (r >> 1), b = c >> 4, head = ((c & 15) + 2 * r) & 15;
    if (head < 6) attn_item<2, 0>(p, lds, b, head, qb);
    else if (head < 11) attn_item<3, 1>(p, lds, b, head, qb);
    else attn_item<2, 2>(p, lds, b, head, qb);
  }
  __syncthreads();
}

#ifndef PHMASK
#define PHMASK 0xFFFFu
#endif
typedef const Params __attribute__((address_space(4)))* cparams_t;
__device__ __forceinline__ cparams_t kparams() { cparams_t q = (cparams_t)__builtin_amdgcn_kernarg_segment_ptr(); asm volatile("" : "+s"(q)); return q; }
__global__ void __launch_bounds__(512) mega(Params p_unused) {
#if defined(__HIP_DEVICE_COMPILE__)
  extern __shared__ __attribute__((aligned(16))) unsigned char lds[];
  cg::grid_group grid = cg::this_grid();
  int nsteps = 2 + 13 * DEPTH + 1;
  asm volatile("" : "+s"(nsteps));
#pragma unroll 1
  for (int step = 0; step < nsteps; ++step) {
    const Params p = *kparams();
    if (step == 0) { if (PHMASK & 1u) phase0(p, lds); }
    else if (step == 1) { if (PHMASK & 1u) phase_mod_reduce(p); }
    else if (step == nsteps - 1) { if (PHMASK & 2u) phase_final_norm(p.out, p.final_norm); }
    else {
      const int l = (step - 2) / 13, sub = (step - 2) % 13;
      unsigned char* wl = p.ws + WS_W + (size_t)l * WL_STRIDE;
      const float* mod = (const float*)(p.ws + WS_MOD) + (size_t)l * 16 * MODW;
      const float* hin = (l == 0) ? p.x : p.out;
      bf16_t* NB = (bf16_t*)(p.ws + WS_NB); bf16_t* BIG = (bf16_t*)(p.ws + WS_BIG);
      if (sub == 0 || sub == 3 || sub == 10) {
        const float* src = (sub == 0) ? hin : p.out;
        const float* gain = ((sub == 0) ? p.norm_ffn1 : (sub == 3) ? p.norm_mix : p.norm_ffn2) + l * DM;
        const int mo = (sub == 0) ? 0 : (sub == 3) ? 3 : 6;
        if (PHMASK & 4u) phase_norm(src, gain, mod + mo * DM, mod + (mo + 1) * DM, NB);
      } else if (sub == 5) { if (PHMASK & 8u) phase_prep(p, l); }
      else if (sub == 7) { if (PHMASK & 16u) { phase_qrope(p); phase_indexer(p, lds); } }
      else if (sub == 8) { if (PHMASK & 32u) phase_attn(p, lds); }
      else {
        const bf16_t* A = NB; const bf16_t* Bt; int N = DM, K = DM; pg8::EpiDyn E{};
        if (sub == 1 || sub == 11) { Bt = (const bf16_t*)(wl + (sub == 1 ? WO_GU1 : WO_GU2)); N = NGU; E.type = 1; E.O = BIG; }
        else if (sub == 2 || sub == 12) { A = BIG; Bt = (const bf16_t*)(wl + (sub == 2 ? WO_D1 : WO_D2)); K = DFF; E.type = 2; E.src = (sub == 2) ? hin : p.out; E.dst = p.out; E.gate = mod + (sub == 2 ? 2 : 8) * DM; E.coef = 0.5f; }
        else if (sub == 4) { Bt = (const bf16_t*)(wl + WO_IN); N = INWP; E.type = 0; E.O = BIG; E.ldc = INWP; }
        else if (sub == 6) { A = (const bf16_t*)(p.ws + WS_MLAA); Bt = (const bf16_t*)(wl + WO_MLA); N = MLA_N; K = MLA_K; E.type = 0; E.O = (bf16_t*)(p.ws + WS_MLAO); E.ldc = MLA_N; }
        else { Bt = (const bf16_t*)(wl + WO_OUT); E.type = 2; E.src = p.out; E.dst = p.out; E.gate = mod + 5 * DM; E.coef = 1.0f; }
        if (PHMASK & 64u) run_gemm(lds, A, Bt, N, K, E);
      }
    }
    grid.sync();
  }
#endif
}

extern "C" void kernel_launch(void* const* d_in, const int* in_sizes, int n_in, void* d_out, int out_size, void* d_ws, size_t ws_size, hipStream_t stream) {
  static int grid_blocks = 0;
  if (!grid_blocks) {
    int dev = 0, cus = 0, per_cu = 0;
    (void)hipGetDevice(&dev);
    (void)hipDeviceGetAttribute(&cus, hipDeviceAttributeMultiprocessorCount, dev);
    (void)hipFuncSetAttribute((const void*)mega, hipFuncAttributeMaxDynamicSharedMemorySize, LDS_BYTES);
    (void)hipOccupancyMaxActiveBlocksPerMultiprocessor(&per_cu, (const void*)mega, 512, LDS_BYTES);
    if (per_cu < 1) per_cu = 1;
    grid_blocks = cus * per_cu;
    if (ws_size < WS_END) fprintf(stderr, "kernel_launch: workspace too small: %zu < %zu\n", ws_size, (size_t)WS_END);
  }
  Params p{};
  p.x = (const float*)d_in[0]; p.c = (const float*)d_in[1]; p.pos = (const int*)d_in[2]; p.rel_bias = (const float*)d_in[3]; p.ada_w = (const float*)d_in[4]; p.ada_b = (const float*)d_in[5];
  p.norm_ffn1 = (const float*)d_in[6]; p.ffn1_gu = (const float*)d_in[7]; p.ffn1_down = (const float*)d_in[8]; p.norm_mix = (const float*)d_in[9]; p.w_in = (const float*)d_in[10];
  p.q_norm = (const float*)d_in[11]; p.w_uq = (const float*)d_in[12]; p.kv_norm = (const float*)d_in[13]; p.w_ukv = (const float*)d_in[14]; p.ik_norm = (const float*)d_in[15]; p.w_out = (const float*)d_in[16];
  p.norm_ffn2 = (const float*)d_in[17]; p.ffn2_gu = (const float*)d_in[18]; p.ffn2_down = (const float*)d_in[19]; p.final_norm = (const float*)d_in[20];
  p.out = (float*)d_out; p.ws = (unsigned char*)d_ws;
  void* args[] = {&p};
  hipError_t e = hipLaunchCooperativeKernel((void*)mega, dim3(grid_blocks), dim3(512), args, LDS_BYTES, stream);
  if (e != hipSuccess) fprintf(stderr, "cooperative launch failed: %s (grid %d)\n", hipGetErrorString(e), grid_blocks);
}
```

```cpp
#include <hip/hip_runtime.h>
#include <hip/hip_cooperative_groups.h>
#include <cstdio>
#include <cstdint>
namespace cg = cooperative_groups;

#define LAS __attribute__((address_space(3)))
typedef unsigned short bf16_t;
typedef short bf16x8 __attribute__((ext_vector_type(8)));
typedef short s16x4 __attribute__((ext_vector_type(4)));
typedef float f32x4 __attribute__((ext_vector_type(4)));
typedef float f32x2 __attribute__((ext_vector_type(2)));
typedef unsigned u32x4 __attribute__((ext_vector_type(4)));
typedef unsigned u32x2 __attribute__((ext_vector_type(2)));
typedef unsigned long long u64;

constexpr int BATCH = 16, SEQ = 2048, DM = 1024, MTOK = BATCH * SEQ, DFF = 2816, NGU = 2 * DFF, INW = 3112, INWP = 3328, NMOD = 9, DEPTH = 2;
constexpr int OFF_QA = 0, OFF_KA = 384, OFF_VA = 768, OFF_CQ = 1152, OFF_CKV = 1408, OFF_KR = 1536, OFF_QC = 1568, OFF_KC = 1888, OFF_VC = 2208, OFF_IQ = 2528, OFF_IK = 3040, OFF_IW = 3104;
constexpr int MLA_K = 384, MLA_N = 1280;
constexpr int MODW = NMOD * DM;
constexpr float RMS_EPS = 1e-6f;
constexpr float NEGV = -1e30f;

constexpr size_t MiB = 1ull << 20;
constexpr size_t WS_NB = 0;
constexpr size_t WS_BIG = 64 * MiB;
constexpr size_t WS_MLAA = 272 * MiB;
constexpr size_t WS_MLAO = 296 * MiB;
constexpr size_t WS_KROPE = 376 * MiB;
constexpr size_t WS_IKN = 378 * MiB;
constexpr size_t WS_MASK = 382 * MiB;
constexpr size_t WS_MOD = 390 * MiB;
constexpr size_t WS_ADAP = 392 * MiB;
constexpr size_t WS_W = 402 * MiB;
constexpr size_t WL_STRIDE = 43 * MiB;
constexpr size_t WO_GU1 = 0, WO_D1 = 11 * MiB, WO_IN = 11 * MiB + 5632 * 1024, WO_MLA = WO_IN + (size_t)INWP * 1024 * 2, WO_OUT = WO_MLA + 1 * MiB, WO_GU2 = WO_OUT + 2 * MiB, WO_D2 = WO_GU2 + 11 * MiB;
static_assert(WO_D2 + 5632 * 1024 <= WL_STRIDE, "weights map");
constexpr size_t WS_BAR = WS_W + 2 * WL_STRIDE;
constexpr size_t WS_END = WS_BAR + 16384;

constexpr int LDS_BYTES = 143360;

struct Params {
  const float* x; const float* c; const int* pos; const float* rel_bias; const float* ada_w; const float* ada_b;
  const float* norm_ffn1; const float* ffn1_gu; const float* ffn1_down; const float* norm_mix; const float* w_in;
  const float* q_norm; const float* w_uq; const float* kv_norm; const float* w_ukv; const float* ik_norm; const float* w_out;
  const float* norm_ffn2; const float* ffn2_gu; const float* ffn2_down; const float* final_norm;
  float* out; unsigned char* ws;
};

__device__ __forceinline__ unsigned cvt_pk_bf16(float lo, float hi) { unsigned r; asm volatile("v_cvt_pk_bf16_f32 %0, %1, %2" : "=v"(r) : "v"(lo), "v"(hi)); return r; }
__device__ __forceinline__ float bf2f(unsigned short h) { return __builtin_bit_cast(float, (unsigned)h << 16); }
__device__ __forceinline__ float bflo(unsigned w) { return __builtin_bit_cast(float, w << 16); }
__device__ __forceinline__ float bfhi(unsigned w) { return __builtin_bit_cast(float, w & 0xffff0000u); }
__device__ __forceinline__ unsigned short f2bf(float f) { return (unsigned short)(cvt_pk_bf16(f, 0.f) & 0xffffu); }
__device__ __forceinline__ int otid() { int t = threadIdx.x; asm volatile("" : "+v"(t)); return t; }
__device__ __forceinline__ float wave_sum(float v) {
#pragma unroll
  for (int o = 1; o < 64; o <<= 1) v += __shfl_xor(v, o);
  return v;
}
__device__ __forceinline__ int t5_bucket(int n) {
  if (n < 16) return n;
  int b = 16;
  b += (n >= 19); b += (n >= 21); b += (n >= 24); b += (n >= 27); b += (n >= 31); b += (n >= 35); b += (n >= 40); b += (n >= 46);
  b += (n >= 52); b += (n >= 59); b += (n >= 67); b += (n >= 77); b += (n >= 87); b += (n >= 99); b += (n >= 113);
  return b;
}
__device__ __forceinline__ void sincos_big(float ang, float& s, float& c) {
  double rev = (double)ang * 0.15915494309189535;
  rev -= __builtin_floor(rev);
  float fr = (float)rev;
  s = __builtin_amdgcn_sinf(fr); c = __builtin_amdgcn_cosf(fr);
}
__device__ __forceinline__ float rope_inv(int i) { return __builtin_amdgcn_exp2f(-(float)i * (13.287712379549449f / 16.f)); }

namespace pg8 {
constexpr int BM = 256, BK = 64, HALF = 128, HTB = HALF * BK * 2, STAGE_BYTES = 8 * HTB, NXCD = 8, WGM = 8;
__host__ __device__ __forceinline__ int lds_byte(int r, int c) { const int st = (r >> 4) * 2 + (c >> 5), rr = r & 15, cc = c & 31, ob = rr * 64 + cc * 2; return st * 1024 + (ob ^ (((ob >> 9) & 1) << 5)); }
__host__ __device__ __forceinline__ void stage_rc(int b, int& R, int& C) { const int st = b / 1024, sb = b % 1024, swz = sb ^ (((sb >> 9) & 1) << 5); R = (st >> 1) * 16 + swz / 64; C = (st & 1) * 32 + (swz % 64) / 2; }
__host__ __device__ __forceinline__ int perm32(int rho) { const int n = rho >> 4, i = rho & 15; return 8 * (i >> 2) + 4 * n + (i & 3); }
struct Unit { int pm, pn; };
struct Gemm { const bf16_t* A; const bf16_t* Bt; int M, N, K; };
struct StaticOrder {
  int nM, nN, nwg, G, c;
  __host__ __device__ void init(int M, int N, int G_, int c_) { nM = M / BM; nN = N / BM; nwg = nM * nN; G = G_; c = c_; }
  __host__ __device__ bool next(int i, Unit& u) const {
    const long L = (long)i * G + c; if (L >= nwg) return false;
    int wgid = (int)L; { const int q = nwg / NXCD, r = nwg % NXCD, xcd = wgid % NXCD, off = wgid / NXCD; wgid = (xcd < r ? xcd * (q + 1) : r * (q + 1) + (xcd - r) * q) + off; }
    const int nig = WGM * nN, gid = wgid / nig, fm = gid * WGM, gsz = (nM - fm) < WGM ? (nM - fm) : WGM;
    u.pm = fm + ((wgid % nig) % gsz); u.pn = (wgid % nig) / gsz; return true;
  }
  __device__ __forceinline__ void a_ready(const Unit&) const {}
  __device__ __forceinline__ void done(const Unit&) const {}
};

struct EpiStore {
  static constexpr bool PERM = true, AFTER_DRAIN = false;
  bf16_t* O; int ldc;
  __device__ __forceinline__ void operator()(const f32x4 (&acc)[2][2][4][2], const Unit& u, int wr, int wc, int fr, int fq) const {
    const int row0 = u.pm * BM + wr * 64 + fr, col0 = u.pn * BM + wc * 32 + 8 * fq;
#pragma unroll
    for (int ai = 0; ai < 2; ++ai)
#pragma unroll
      for (int m = 0; m < 4; ++m) { bf16_t* rowp = O + (size_t)(row0 + ai * HALF + m * 16) * ldc + col0;
#pragma unroll
        for (int bj = 0; bj < 2; ++bj) { const f32x4 v0 = acc[ai][bj][m][0], v1 = acc[ai][bj][m][1];
          u32x4 w; w.x = cvt_pk_bf16(v0[0], v0[1]); w.y = cvt_pk_bf16(v0[2], v0[3]); w.z = cvt_pk_bf16(v1[0], v1[1]); w.w = cvt_pk_bf16(v1[2], v1[3]);
          *(u32x4*)(rowp + bj * HALF) = w; } }
  }
};
__device__ __forceinline__ float silu_mul(float g, float uu) { return g * __builtin_amdgcn_rcpf(1.f + __expf(-g)) * uu; }
struct EpiSwiglu {
  static constexpr bool PERM = true, AFTER_DRAIN = false;
  bf16_t* O;
  __device__ __forceinline__ void operator()(const f32x4 (&acc)[2][2][4][2], const Unit& u, int wr, int wc, int fr, int fq) const {
    const int row0 = u.pm * BM + wr * 64 + fr, col0 = u.pn * HALF + wc * 32 + 8 * fq;
#pragma unroll
    for (int ai = 0; ai < 2; ++ai)
#pragma unroll
      for (int m = 0; m < 4; ++m) { bf16_t* rowp = O + (size_t)(row0 + ai * HALF + m * 16) * DFF + col0;
        const f32x4 g0 = acc[ai][0][m][0], g1 = acc[ai][0][m][1], u0 = acc[ai][1][m][0], u1 = acc[ai][1][m][1];
        u32x4 w; w.x = cvt_pk_bf16(silu_mul(g0[0], u0[0]), silu_mul(g0[1], u0[1])); w.y = cvt_pk_bf16(silu_mul(g0[2], u0[2]), silu_mul(g0[3], u0[3]));
        w.z = cvt_pk_bf16(silu_mul(g1[0], u1[0]), silu_mul(g1[1], u1[1])); w.w = cvt_pk_bf16(silu_mul(g1[2], u1[2]), silu_mul(g1[3], u1[3]));
        *(u32x4*)rowp = w; }
  }
};
struct EpiResid {
  static constexpr bool PERM = true, AFTER_DRAIN = false;
  const float* src; float* dst; const float* gate; float coef;
  __device__ __forceinline__ void operator()(const f32x4 (&acc)[2][2][4][2], const Unit& u, int wr, int wc, int fr, int fq) const {
    const int row0 = u.pm * BM + wr * 64 + fr, col0 = u.pn * BM + wc * 32 + 8 * fq;
    const float* gp = gate + (size_t)(u.pm >> 3) * MODW + col0;
    f32x4 gv[2][2];
#pragma unroll
    for (int bj = 0; bj < 2; ++bj)
#pragma unroll
      for (int n = 0; n < 2; ++n) gv[bj][n] = *(const f32x4*)(gp + bj * HALF + 4 * n) * coef;
#pragma unroll
    for (int ai = 0; ai < 2; ++ai)
#pragma unroll
      for (int m = 0; m < 4; ++m) { const size_t ro = (size_t)(row0 + ai * HALF + m * 16) * DM + col0;
#pragma unroll
        for (int bj = 0; bj < 2; ++bj)
#pragma unroll
          for (int n = 0; n < 2; ++n) { const f32x4 s = *(const f32x4*)(src + ro + bj * HALF + 4 * n);
            *(f32x4*)(dst + ro + bj * HALF + 4 * n) = s + gv[bj][n] * acc[ai][bj][m][n]; } }
  }
};

struct EpiDyn {
  static constexpr bool PERM = true, AFTER_DRAIN = false;
  int type; bf16_t* O; int ldc; const float* src; float* dst; const float* gate; float coef;
  __device__ __forceinline__ void operator()(const f32x4 (&acc)[2][2][4][2], const Unit& u, int wr, int wc, int fr, int fq) const {
    if (type == 0) { EpiStore e{O, ldc}; e(acc, u, wr, wc, fr, fq); }
    else if (type == 1) { EpiSwiglu e{O}; e(acc, u, wr, wc, fr, fq); }
    else { EpiResid e{src, dst, gate, coef}; e(acc, u, wr, wc, fr, fq); }
  }
};

template <class Epi, class Sched, bool ALIGN_EPI = false, bool SP2 = false>
__device__ __forceinline__ void gemm_phase(LAS unsigned char* lds, const Gemm g, const Sched& S, const Epi& E) {
  const int tid = otid(), wid = __builtin_amdgcn_readfirstlane(tid >> 6), lane = tid & 63, wr = wid >> 2, wc = wid & 3, fr = lane & 15, fq = lane >> 4;
  const int K = g.K, nt = K / BK;
  unsigned voffA[2], voffB[2];
#pragma unroll
  for (int i = 0; i < 2; ++i) { int R, C; stage_rc(tid * 16 + i * 8192, R, C); const int Rb = Epi::PERM ? ((R & ~31) + perm32(R & 31)) : R;
    voffA[i] = (unsigned)(R * K + C) * 2u; voffB[i] = (unsigned)(Rb * K + C) * 2u; }
  const size_t kstep = (size_t)(BK * 2);
  const size_t hstep = (size_t)HALF * K * 2;
  const size_t tstep = 2 * hstep;
  const unsigned ldsw = (unsigned)wid * 1024u;
  const int aoff = lds_byte(wr * 64 + fr, fq * 8), boff = lds_byte(wc * 32 + fr, fq * 8);
#define PG8_SA(b, h) (((b) * 2 + (h)) * HTB)
#define PG8_SB(b, h) ((4 + (b) * 2 + (h)) * HTB)
#define PG8_STAGE(bufoff, gbase, voff) do { _Pragma("unroll") for (int _i = 0; _i < 2; ++_i) \
        __builtin_amdgcn_global_load_lds((const unsigned*)((const char*)(gbase) + (voff)[_i]), (LAS unsigned*)(lds + (bufoff) + ldsw + _i * 8192), 16, 0, 0); } while (0)
#define PG8_LDA(dst, b, h) do { _Pragma("unroll") for (int m = 0; m < 4; ++m) _Pragma("unroll") for (int k = 0; k < 2; ++k) dst[m][k] = *(const LAS bf16x8*)(lds + PG8_SA(b, h) + aoff + m * 2048 + k * 1024); } while (0)
#define PG8_LDB(dst, b, h) do { _Pragma("unroll") for (int n = 0; n < 2; ++n) _Pragma("unroll") for (int k = 0; k < 2; ++k) dst[n][k] = *(const LAS bf16x8*)(lds + PG8_SB(b, h) + boff + n * 2048 + k * 1024); } while (0)
#define PG8_MMA(ai, bj, At, Bt) do { __builtin_amdgcn_s_setprio(1); _Pragma("unroll") for (int m = 0; m < 4; ++m) _Pragma("unroll") for (int n = 0; n < 2; ++n) _Pragma("unroll") for (int k = 0; k < 2; ++k) \
        acc[ai][bj][m][n] = __builtin_amdgcn_mfma_f32_16x16x32_bf16(Bt[n][k], At[m][k], acc[ai][bj][m][n], 0, 0, 0); __builtin_amdgcn_s_setprio(0); } while (0)
#define PG8_WAIT_V(n) asm volatile("s_waitcnt vmcnt(" #n ")" ::: "memory")
#define PG8_WAIT_L(n) asm volatile("s_waitcnt lgkmcnt(" #n ")" ::: "memory")
#define PG8_BAR __builtin_amdgcn_s_barrier()
#define PG8_SCHED __builtin_amdgcn_sched_barrier(0)
  Unit cur, nxt; int ui = 0;
  if (!S.next(0, cur)) return;
  f32x4 acc[2][2][4][2];
#pragma unroll
  for (int a = 0; a < 2; ++a)
#pragma unroll
    for (int b = 0; b < 2; ++b)
#pragma unroll
      for (int m = 0; m < 4; ++m)
#pragma unroll
        for (int n = 0; n < 2; ++n) acc[a][b][m][n] = (f32x4){0.f, 0.f, 0.f, 0.f};
  bf16x8 At[4][2], B0[2][2], B1[2][2];
  const char* cA = (const char*)g.A + (size_t)cur.pm * tstep; const char* cB = (const char*)g.Bt + (size_t)cur.pn * tstep;
  S.a_ready(cur);
  if constexpr (SP2) {
    PG8_STAGE(PG8_SB(0, 0), cB, voffB); PG8_STAGE(PG8_SB(0, 1), cB + hstep, voffB); PG8_STAGE(PG8_SA(0, 0), cA, voffA); PG8_STAGE(PG8_SA(0, 1), cA + hstep, voffA);
    if (wr == 1) PG8_BAR;
    PG8_WAIT_V(2); PG8_BAR;
    PG8_STAGE(PG8_SB(1, 0), cB + kstep, voffB); PG8_STAGE(PG8_SA(1, 0), cA + kstep, voffA); PG8_STAGE(PG8_SB(1, 1), cB + hstep + kstep, voffB);
    PG8_WAIT_V(6); PG8_BAR;
  } else {
    PG8_STAGE(PG8_SB(0, 0), cB, voffB); PG8_STAGE(PG8_SA(0, 0), cA, voffA); PG8_STAGE(PG8_SB(0, 1), cB + hstep, voffB); PG8_STAGE(PG8_SA(0, 1), cA + hstep, voffA);
    if (wr == 1) PG8_BAR;
    PG8_WAIT_V(4); PG8_BAR;
    PG8_STAGE(PG8_SB(1, 0), cB + kstep, voffB); PG8_STAGE(PG8_SA(1, 0), cA + kstep, voffA); PG8_STAGE(PG8_SB(1, 1), cB + hstep + kstep, voffB);
    PG8_WAIT_V(6); PG8_BAR;
  }
  for (;;) {
    const bool has_next = S.next(ui + 1, nxt);
    const char* nA = has_next ? (const char*)g.A + (size_t)nxt.pm * tstep : cA; const char* nB = has_next ? (const char*)g.Bt + (size_t)nxt.pn * tstep : cB;
#pragma unroll 1
    for (int t = 0; t < nt; t += 2) {
      const bool last = (t == nt - 2);
      const char* a1 = cA + (size_t)(t + 1) * kstep;
      const char* a2 = last ? nA : cA + (size_t)(t + 2) * kstep; const char* b2 = last ? nB : cB + (size_t)(t + 2) * kstep;
      const char* a3 = a2 + kstep; const char* b3 = b2 + kstep;
      if (last && has_next) S.a_ready(nxt);
      if constexpr (SP2) {
        PG8_LDB(B0, 0, 0); PG8_LDB(B1, 0, 1); PG8_SCHED; PG8_LDA(At, 0, 0); PG8_STAGE(PG8_SA(1, 1), a1 + hstep, voffA);
        PG8_WAIT_V(8); PG8_WAIT_L(0); PG8_BAR; PG8_MMA(0, 0, At, B0); PG8_MMA(0, 1, At, B1); PG8_BAR; PG8_SCHED;
        PG8_LDA(At, 0, 1); PG8_STAGE(PG8_SB(0, 0), b2, voffB); PG8_STAGE(PG8_SB(0, 1), b2 + hstep, voffB); PG8_STAGE(PG8_SA(0, 0), a2, voffA);
        PG8_WAIT_V(8); PG8_WAIT_L(0); PG8_BAR; PG8_MMA(1, 0, At, B0); PG8_MMA(1, 1, At, B1); PG8_BAR; PG8_SCHED;
        PG8_LDB(B0, 1, 0); PG8_LDB(B1, 1, 1); PG8_SCHED; PG8_LDA(At, 1, 0); PG8_STAGE(PG8_SA(0, 1), a2 + hstep, voffA);
        PG8_WAIT_V(8); PG8_WAIT_L(0); PG8_BAR; PG8_MMA(0, 0, At, B0); PG8_MMA(0, 1, At, B1); PG8_BAR; PG8_SCHED;
        PG8_LDA(At, 1, 1); PG8_STAGE(PG8_SB(1, 0), b3, voffB); PG8_STAGE(PG8_SB(1, 1), b3 + hstep, voffB); PG8_STAGE(PG8_SA(1, 0), a3, voffA);
        PG8_WAIT_V(8); PG8_WAIT_L(0); PG8_BAR; PG8_MMA(1, 0, At, B0); PG8_MMA(1, 1, At, B1); PG8_BAR; PG8_SCHED;
      } else {
        PG8_LDB(B0, 0, 0); PG8_SCHED; PG8_LDA(At, 0, 0); PG8_STAGE(PG8_SA(1, 1), a1 + hstep, voffA);
        PG8_WAIT_L(8); PG8_BAR; PG8_WAIT_L(0); PG8_MMA(0, 0, At, B0); PG8_BAR; PG8_SCHED;
        PG8_LDB(B1, 0, 1); PG8_STAGE(PG8_SB(0, 0), b2, voffB);
        PG8_BAR; PG8_WAIT_L(0); PG8_MMA(0, 1, At, B1); PG8_BAR;
        PG8_LDA(At, 0, 1); PG8_STAGE(PG8_SA(0, 0), a2, voffA);
        PG8_BAR; PG8_WAIT_L(0); PG8_MMA(1, 0, At, B0); PG8_BAR; PG8_SCHED;
        PG8_STAGE(PG8_SB(0, 1), b2 + hstep, voffB);
        PG8_WAIT_V(6); PG8_BAR; PG8_MMA(1, 1, At, B1); PG8_BAR;
        PG8_LDB(B0, 1, 0); PG8_SCHED; PG8_LDA(At, 1, 0); PG8_STAGE(PG8_SA(0, 1), a2 + hstep, voffA);
        PG8_WAIT_L(8); PG8_BAR; PG8_WAIT_L(0); PG8_MMA(0, 0, At, B0); PG8_BAR; PG8_SCHED;
        PG8_LDB(B1, 1, 1); PG8_STAGE(PG8_SB(1, 0), b3, voffB);
        PG8_BAR; PG8_WAIT_L(0); PG8_MMA(0, 1, At, B1); PG8_BAR;
        PG8_LDA(At, 1, 1); PG8_STAGE(PG8_SA(1, 0), a3, voffA);
        PG8_BAR; PG8_WAIT_L(0); PG8_MMA(1, 0, At, B0); PG8_BAR; PG8_SCHED;
        PG8_STAGE(PG8_SB(1, 1), b3 + hstep, voffB);
        PG8_WAIT_V(6); PG8_BAR; PG8_MMA(1, 1, At, B1); PG8_BAR;
      }
    }
    if constexpr (ALIGN_EPI) { if (wr == 0) PG8_BAR; }
    if constexpr (!Epi::AFTER_DRAIN) { E(acc, cur, wr, wc, fr, fq); S.done(cur); }
    if (!has_next) break;
#pragma unroll
    for (int a = 0; a < 2; ++a)
#pragma unroll
      for (int b = 0; b < 2; ++b)
#pragma unroll
        for (int m = 0; m < 4; ++m)
#pragma unroll
          for (int n = 0; n < 2; ++n) acc[a][b][m][n] = (f32x4){0.f, 0.f, 0.f, 0.f};
    cur = nxt; cA = nA; cB = nB; ++ui;
    if constexpr (ALIGN_EPI) { if (wr == 1) PG8_BAR; }
  }
  PG8_WAIT_V(0);
  if constexpr (!ALIGN_EPI) { if (wr == 0) PG8_BAR; }
  PG8_BAR;
#undef PG8_SA
#undef PG8_SB
#undef PG8_STAGE
#undef PG8_LDA
#undef PG8_LDB
#undef PG8_MMA
#undef PG8_WAIT_V
#undef PG8_WAIT_L
#undef PG8_BAR
#undef PG8_SCHED
}
}

template <class Epi>
__device__ __forceinline__ void run_gemm(unsigned char* lds, const bf16_t* A, const bf16_t* Bt, int N, int K, const Epi& E) {
  pg8::Gemm g{A, Bt, MTOK, N, K}; pg8::StaticOrder S; S.init(MTOK, N, (int)gridDim.x, (int)blockIdx.x);
  pg8::gemm_phase<Epi, pg8::StaticOrder, true, true>((LAS unsigned char*)lds, g, S, E);
  __syncthreads();
}

template <class F>
__device__ __forceinline__ void cvt_tile(F src, bf16_t* dst, int ldd, int n0, int k0, float* tile) {
  const int tid = otid();
#pragma unroll
  for (int i = 0; i < 8; ++i) { const int k = i * 8 + (tid >> 6), n = tid & 63; tile[k * 65 + n] = src(k0 + k, n0 + n); }
  __syncthreads();
  { const int n = tid >> 3, kc = (tid & 7) * 8; const float* s = tile + kc * 65 + n;
    u32x4 o; o.x = cvt_pk_bf16(s[0], s[65]); o.y = cvt_pk_bf16(s[2 * 65], s[3 * 65]); o.z = cvt_pk_bf16(s[4 * 65], s[5 * 65]); o.w = cvt_pk_bf16(s[6 * 65], s[7 * 65]);
    *(u32x4*)(dst + (size_t)(n0 + n) * ldd + k0 + kc) = o; }
  __syncthreads();
}

__device__ __forceinline__ void phase0(const Params& p, unsigned char* lds) {
  float* tile = (float*)lds;
  const int tid = otid();
  constexpr int N_ADA = DEPTH * 18 * 8;
  constexpr int T_GU = 88 * 16, T_D = 16 * 44, T_IN = 52 * 16, T_MLA = 20 * 6, T_OUT = 16 * 16;
  constexpr int T_LAYER = 2 * T_GU + 2 * T_D + T_IN + T_MLA + T_OUT;
  constexpr int NITEMS = N_ADA + DEPTH * T_LAYER;
  for (int it = blockIdx.x; it < NITEMS; it += gridDim.x) {
    if (it < N_ADA) {
      const int l = it / 144, r = it % 144, cb = r / 8, ks = r % 8;
      __syncthreads();
      for (int e = tid; e < 16 * 128; e += 512) { const int b = e >> 7, k = e & 127; const float v = p.c[b * DM + ks * 128 + k]; tile[e] = v / (1.f + __expf(-v)); }
      __syncthreads();
      const int j = cb * 512 + tid;
      const float* w = p.ada_w + (size_t)l * DM * MODW + (size_t)(ks * 128) * MODW + j;
      float acc[16];
#pragma unroll
      for (int b = 0; b < 16; ++b) acc[b] = 0.f;
      for (int k = 0; k < 128; ++k) { const float wv = w[(size_t)k * MODW];
#pragma unroll
        for (int b = 0; b < 16; ++b) acc[b] += tile[b * 128 + k] * wv; }
      float* dstp = (float*)(p.ws + WS_ADAP) + ((size_t)(ks * DEPTH + l) * 16) * MODW + j;
#pragma unroll
      for (int b = 0; b < 16; ++b) dstp[(size_t)b * MODW] = acc[b];
      __syncthreads();
      continue;
    }
    int r = it - N_ADA; const int l = r / T_LAYER; r -= l * T_LAYER;
    unsigned char* wl = p.ws + WS_W + (size_t)l * WL_STRIDE;
    if (r < 2 * T_GU) {
      const int f = r / T_GU; r -= f * T_GU; const int nt = r / 16, kt = r % 16, n0 = nt * 64;
      const int pn = n0 >> 8, bj = (n0 >> 7) & 1, i0 = n0 & 127, scol0 = bj * DFF + pn * 128 + i0 - n0;
      const float* W = (f ? p.ffn2_gu : p.ffn1_gu) + (size_t)l * DM * NGU;
      cvt_tile([=](int k, int n) { return W[(size_t)k * NGU + n + scol0]; }, (bf16_t*)(wl + (f ? WO_GU2 : WO_GU1)), DM, n0, kt * 64, tile);
      continue;
    }
    r -= 2 * T_GU;
    if (r < 2 * T_D) {
      const int f = r / T_D; r -= f * T_D; const int nt = r / 44, kt = r % 44;
      const float* W = (f ? p.ffn2_down : p.ffn1_down) + (size_t)l * DFF * DM;
      cvt_tile([=](int k, int n) { return W[(size_t)k * DM + n]; }, (bf16_t*)(wl + (f ? WO_D2 : WO_D1)), DFF, nt * 64, kt * 64, tile);
      continue;
    }
    r -= 2 * T_D;
    if (r < T_IN) {
      const int nt = r / 16, kt = r % 16;
      const float* W = p.w_in + (size_t)l * DM * INW;
      cvt_tile([=](int k, int n) { return n < INW ? W[(size_t)k * INW + n] : 0.f; }, (bf16_t*)(wl + WO_IN), DM, nt * 64, kt * 64, tile);
      continue;
    }
    r -= T_IN;
    if (r < T_MLA) {
      const int nt = r / 6, kt = r % 6;
      const float* Wq = p.w_uq + (size_t)l * 256 * 480; const float* Wkv = p.w_ukv + (size_t)l * 128 * 640;
      cvt_tile([=](int k, int n) { float v = 0.f; if (n < 480) { if (k < 256) v = Wq[(size_t)k * 480 + n]; } else if (n < 1120) { if (k >= 256) v = Wkv[(size_t)(k - 256) * 640 + (n - 480)]; } return v; },
               (bf16_t*)(wl + WO_MLA), MLA_K, nt * 64, kt * 64, tile);
      continue;
    }
    r -= T_MLA;
    { const int nt = r / 16, kt = r % 16;
      const float* W = p.w_out + (size_t)l * DM * DM;
      cvt_tile([=](int k, int n) { return W[(size_t)k * DM + n]; }, (bf16_t*)(wl + WO_OUT), DM, nt * 64, kt * 64, tile); }
  }
}
__device__ __forceinline__ void phase_mod_reduce(const Params& p) {
  float* mod = (float*)(p.ws + WS_MOD); const float* part = (const float*)(p.ws + WS_ADAP);
  constexpr int TOT = DEPTH * 16 * MODW;
  for (int e = blockIdx.x * 512 + otid(); e < TOT; e += gridDim.x * 512) {
    const int l = e / (16 * MODW), j = e % MODW;
    float s = p.ada_b[l * MODW + j];
#pragma unroll
    for (int ks = 0; ks < 8; ++ks) s += part[(size_t)ks * TOT + e];
    mod[e] = s;
  }
}

__device__ __forceinline__ void phase_norm(const float* src, const float* gain, const float* shift, const float* scale, bf16_t* dst) {
  const int tid_ = otid(), lane = tid_ & 63, gw = blockIdx.x * 8 + (tid_ >> 6), NGW = gridDim.x * 8;
  for (int m = gw; m < MTOK; m += NGW) {
    const f32x4* xr = (const f32x4*)(src + (size_t)m * DM) + lane;
    f32x4 v[4]; float s = 0.f;
#pragma unroll
    for (int j = 0; j < 4; ++j) { v[j] = xr[64 * j]; s += (v[j].x * v[j].x + v[j].y * v[j].y) + (v[j].z * v[j].z + v[j].w * v[j].w); }
    const float rs = 1.f / sqrtf(wave_sum(s) * (1.f / DM) + RMS_EPS);
    const int b = m / SEQ;
    const f32x4* gp = (const f32x4*)gain + lane; const f32x4* shp = (const f32x4*)(shift + (size_t)b * MODW) + lane; const f32x4* scp = (const f32x4*)(scale + (size_t)b * MODW) + lane;
    u64* o8 = (u64*)(dst + (size_t)m * DM) + lane;
#pragma unroll
    for (int j = 0; j < 4; ++j) { const f32x4 g = gp[64 * j], sh = shp[64 * j], sc = scp[64 * j];
      const f32x4 y = (v[j] * rs) * g * (sc + 1.f) + sh;
      o8[64 * j] = (u64)cvt_pk_bf16(y.x, y.y) | ((u64)cvt_pk_bf16(y.z, y.w) << 32); }
  }
}
__device__ __forceinline__ void phase_final_norm(float* h, const float* gain) {
  const int tid_ = otid(), lane = tid_ & 63, gw = blockIdx.x * 8 + (tid_ >> 6), NGW = gridDim.x * 8;
  for (int m = gw; m < MTOK; m += NGW) {
    f32x4* xr = (f32x4*)(h + (size_t)m * DM) + lane;
    f32x4 v[4]; float s = 0.f;
#pragma unroll
    for (int j = 0; j < 4; ++j) { v[j] = xr[64 * j]; s += (v[j].x * v[j].x + v[j].y * v[j].y) + (v[j].z * v[j].z + v[j].w * v[j].w); }
    const float rs = 1.f / sqrtf(wave_sum(s) * (1.f / DM) + RMS_EPS);
    const f32x4* gp = (const f32x4*)gain + lane;
#pragma unroll
    for (int j = 0; j < 4; ++j) xr[64 * j] = (v[j] * rs) * gp[64 * j];
  }
}

__device__ __forceinline__ void phase_prep(const Params& p, int l) {
  const int tid_ = otid(), lane = tid_ & 63, gw = blockIdx.x * 8 + (tid_ >> 6), NGW = gridDim.x * 8;
  bf16_t* proj = (bf16_t*)(p.ws + WS_BIG); bf16_t* mlaa = (bf16_t*)(p.ws + WS_MLAA); bf16_t* krope = (bf16_t*)(p.ws + WS_KROPE); bf16_t* ikn = (bf16_t*)(p.ws + WS_IKN);
  const float* qn = p.q_norm + l * 256; const float* kvn = p.kv_norm + l * 128; const float* ikg = p.ik_norm + l * 64;
  const float inv = rope_inv(lane & 15);
  for (int m = gw; m < MTOK; m += NGW) {
    bf16_t* pr = proj + (size_t)m * INWP;
    float sn, cs; sincos_big((float)p.pos[m] * inv, sn, cs);
    {
      const u32x2 w = *(const u32x2*)(pr + OFF_CQ + 4 * lane);
      const float a0 = bflo(w.x), a1 = bfhi(w.x), a2 = bflo(w.y), a3 = bfhi(w.y);
      const float rs = 1.f / sqrtf(wave_sum(a0 * a0 + a1 * a1 + a2 * a2 + a3 * a3) * (1.f / 256) + RMS_EPS);
      const f32x4 g = *(const f32x4*)(qn + 4 * lane);
      u32x2 o; o.x = cvt_pk_bf16(a0 * rs * g.x, a1 * rs * g.y); o.y = cvt_pk_bf16(a2 * rs * g.z, a3 * rs * g.w);
      *(u32x2*)(mlaa + (size_t)m * MLA_K + 4 * lane) = o; }
    {
      const unsigned w = *(const unsigned*)(pr + OFF_CKV + 2 * lane);
      const float a0 = bflo(w), a1 = bfhi(w);
      const float rs = 1.f / sqrtf(wave_sum(a0 * a0 + a1 * a1) * (1.f / 128) + RMS_EPS);
      const f32x2 g = *(const f32x2*)(kvn + 2 * lane);
      *(unsigned*)(mlaa + (size_t)m * MLA_K + 256 + 2 * lane) = cvt_pk_bf16(a0 * rs * g.x, a1 * rs * g.y); }
    if (lane < 16) {
      const float x1 = bf2f(pr[OFF_KR + lane]), x2 = bf2f(pr[OFF_KR + 16 + lane]);
      krope[(size_t)m * 32 + lane] = f2bf(x1 * cs - x2 * sn); krope[(size_t)m * 32 + 16 + lane] = f2bf(x2 * cs + x1 * sn); }
#pragma unroll
    for (int j = 0; j < 2; ++j) {
      const int pp = lane + 64 * j, hd = pp >> 4, i = pp & 15; bf16_t* q = pr + OFF_IQ + hd * 64;
      const float x1 = bf2f(q[i]), x2 = bf2f(q[16 + i]);
      q[i] = f2bf(x1 * cs - x2 * sn); q[16 + i] = f2bf(x2 * cs + x1 * sn); }
    {
      const float a = bf2f(pr[OFF_IK + lane]);
      const float rs = 1.f / sqrtf(wave_sum(a * a) * (1.f / 64) + RMS_EPS);
      const float y = a * rs * ikg[lane];
      const float pa = __shfl_xor(y, 16);
      float o = y;
      if (lane < 16) o = y * cs - pa * sn; else if (lane < 32) o = y * cs + pa * sn;
      ikn[(size_t)m * 64 + lane] = f2bf(o); }
  }
}
__device__ __forceinline__ void phase_qrope(const Params& p) {
  const int tid_ = otid(), lane = tid_ & 63, gw = blockIdx.x * 8 + (tid_ >> 6), NGW = gridDim.x * 8;
  bf16_t* mlao = (bf16_t*)(p.ws + WS_MLAO);
  const float inv = rope_inv(lane & 15);
  for (int m = gw; m < MTOK; m += NGW) {
    float sn, cs; sincos_big((float)p.pos[m] * inv, sn, cs);
#pragma unroll
    for (int j = 0; j < 2; ++j) { const int pp = lane + 64 * j;
      if (pp < 80) { const int hd = pp >> 4, i = pp & 15; bf16_t* q = mlao + (size_t)m * MLA_N + hd * 96 + 64;
        const float x1 = bf2f(q[i]), x2 = bf2f(q[16 + i]);
        q[i] = f2bf(x1 * cs - x2 * sn); q[16 + i] = f2bf(x2 * cs + x1 * sn); } }
  }
}

constexpr int SC_STRIDE = 2112;
__device__ __forceinline__ int wave_count(int c) { int t = 0;
#pragma unroll
  for (int b = 0; b < 6; ++b) t += (int)__popcll(__ballot((c >> b) & 1)) << b;
  return t; }
__device__ __forceinline__ unsigned fkey(float v) { const unsigned u = __builtin_bit_cast(unsigned, v + 0.0f); return (u & 0x80000000u) ? ~u : (u | 0x80000000u); }
__device__ __forceinline__ void phase_indexer(const Params& p, unsigned char* lds) {
  float* sc = (float*)lds;
  const int tid = otid(), lane = tid & 63, wave = __builtin_amdgcn_readfirstlane(tid >> 6), fr = lane & 15, fq = lane >> 4;
  const bf16_t* proj = (const bf16_t*)(p.ws + WS_BIG); const bf16_t* ikn = (const bf16_t*)(p.ws + WS_IKN); u64* mask = (u64*)(p.ws + WS_MASK);
  constexpr int NITEMS = BATCH * (SEQ / 16);
  for (int it = blockIdx.x; it < NITEMS; it += gridDim.x) {
    const int b = it % BATCH, qg = (SEQ / 16 - 1) - it / BATCH, t0 = qg * 16;
    const size_t rowb = (size_t)b * SEQ;
    if (t0 + 16 <= 256) {
      if (lane < 32) { mask[(rowb + t0 + 2 * wave) * 32 + lane] = ~0ull; mask[(rowb + t0 + 2 * wave + 1) * 32 + lane] = ~0ull; }
      continue;
    }
    __syncthreads();
    {
      const bf16_t* qrow = proj + (rowb + t0 + fr) * INWP;
      bf16x8 qf[8][2];
#pragma unroll
      for (int h = 0; h < 8; ++h)
#pragma unroll
        for (int s = 0; s < 2; ++s) qf[h][s] = *(const bf16x8*)(qrow + OFF_IQ + h * 64 + s * 32 + fq * 8);
      float wq[8];
      { const u32x4 w = *(const u32x4*)(qrow + OFF_IW); const float cw = 0.04419417382415922f;
        wq[0] = bflo(w.x) * cw; wq[1] = bfhi(w.x) * cw; wq[2] = bflo(w.y) * cw; wq[3] = bfhi(w.y) * cw; wq[4] = bflo(w.z) * cw; wq[5] = bfhi(w.z) * cw; wq[6] = bflo(w.w) * cw; wq[7] = bfhi(w.w) * cw; }
      const int nkt = qg + 1;
      for (int kt = wave; kt < nkt; kt += 8) {
        const bf16_t* krow = ikn + (rowb + kt * 16 + fr) * 64 + fq * 8;
        const bf16x8 k0 = *(const bf16x8*)krow, k1 = *(const bf16x8*)(krow + 32);
        f32x4 s4 = (f32x4){0.f, 0.f, 0.f, 0.f};
#pragma unroll
        for (int h = 0; h < 8; ++h) {
          f32x4 a = (f32x4){0.f, 0.f, 0.f, 0.f};
          a = __builtin_amdgcn_mfma_f32_16x16x32_bf16(k0, qf[h][0], a, 0, 0, 0);
          a = __builtin_amdgcn_mfma_f32_16x16x32_bf16(k1, qf[h][1], a, 0, 0, 0);
#pragma unroll
          for (int j = 0; j < 4; ++j) s4[j] += wq[h] * fmaxf(a[j], 0.f);
        }
        { const int c0 = kt * 16 + fq * 4; float* dp = sc + fr * SC_STRIDE + c0 + (c0 >> 5);
          dp[0] = s4[0]; dp[1] = s4[1]; dp[2] = s4[2]; dp[3] = s4[3]; }
      }
    }
    __syncthreads();
    for (int rr = 0; rr < 2; ++rr) {
      const int r = 2 * wave + rr, t = t0 + r;
      unsigned key[32];
#pragma unroll
      for (int j = 0; j < 32; ++j) { const int idx = lane * 32 + j; const float v = sc[r * SC_STRIDE + lane * 33 + j]; key[j] = (idx <= t) ? fkey(v) : 0u; }
      unsigned T = 0u;
#pragma unroll 1
      for (int bit = 31; bit >= 0; --bit) {
        const unsigned cand = T | (1u << bit);
        int c = 0;
#pragma unroll
        for (int j = 0; j < 32; ++j) asm volatile("v_cmp_ge_u32 vcc, %1, %2\n\tv_addc_co_u32 %0, vcc, 0, %0, vcc" : "+v"(c) : "v"(key[j]), "v"(cand) : "vcc");
        if (wave_count(c) >= 256) T = cand;
      }
      int cgt = 0, ceql = 0;
#pragma unroll
      for (int j = 0; j < 32; ++j) {
        asm volatile("v_cmp_gt_u32 vcc, %1, %2\n\tv_addc_co_u32 %0, vcc, 0, %0, vcc" : "+v"(cgt) : "v"(key[j]), "v"(T) : "vcc");
        asm volatile("v_cmp_eq_u32 vcc, %1, %2\n\tv_addc_co_u32 %0, vcc, 0, %0, vcc" : "+v"(ceql) : "v"(key[j]), "v"(T) : "vcc"); }
      cgt = wave_count(cgt); const int ceq = wave_count(ceql);
      const int need = 256 - cgt;
      int cutoff = 4096;
      if (ceq > need) {
        int incl = ceql;
#pragma unroll
        for (int o = 1; o < 64; o <<= 1) { const int v = __shfl_up(incl, o); if (lane >= o) incl += v; }
        const int excl = incl - ceql;
        int mycut = 4096;
        if (excl < need && incl >= need) { int k = need - excl;
#pragma unroll
          for (int j = 0; j < 32; ++j) { if (key[j] == T) { --k; if (k == 0) mycut = lane * 32 + j; } } }
#pragma unroll
        for (int o = 1; o < 64; o <<= 1) mycut = min(mycut, __shfl_xor(mycut, o));
        cutoff = mycut;
      }
      unsigned W = 0u;
#pragma unroll
      for (int j = 0; j < 32; ++j) { const int idx = lane * 32 + j; W |= ((key[j] > T || (key[j] == T && idx <= cutoff)) ? 1u : 0u) << j; __builtin_amdgcn_sched_barrier(0); }
      ((unsigned*)mask)[(rowb + t) * 64 + lane] = W;
    }
  }
  __syncthreads();
}

constexpr int KROW = 208, VROW = 144;
constexpr int AT_K = 0, AT_V = 64 * KROW, AT_TAB = AT_V + 64 * VROW, AT_END = AT_TAB + 2048 * 4;
__device__ __forceinline__ s16x4 vtr(const LAS unsigned char* ptr) { return __builtin_bit_cast(s16x4, __builtin_amdgcn_ds_read_tr16_b64_v4i16((LAS s16x4*)ptr)); }

template <int KS, int TYPE>
__device__ __forceinline__ void attn_item(const Params& p, unsigned char* lds, int b, int head, int qb) {
  const int tid = otid(), lane = tid & 63, wave = __builtin_amdgcn_readfirstlane(tid >> 6), fr = lane & 15, fq = lane >> 4;
  const bf16_t* proj = (const bf16_t*)(p.ws + WS_BIG); const bf16_t* mlao = (const bf16_t*)(p.ws + WS_MLAO);
  const bf16_t* Qp; const bf16_t* Kp; const bf16_t* Vp; int qpitch, kpitch; float scale;
  const size_t rowb = (size_t)b * SEQ;
  if (TYPE == 0) { Qp = proj + OFF_QA + head * 64; Kp = proj + OFF_KA + head * 64; Vp = proj + OFF_VA + head * 64; qpitch = kpitch = INWP; scale = 0.125f; }
  else if (TYPE == 1) { const int hb = head - 6; Qp = mlao + hb * 96; Kp = mlao + 480 + hb * 128; Vp = Kp + 64; qpitch = kpitch = MLA_N; scale = 0.10206207261596575f; }
  else { const int hc = head - 11; Qp = proj + OFF_QC + hc * 64; Kp = proj + OFF_KC + hc * 64; Vp = proj + OFF_VC + hc * 64; qpitch = kpitch = INWP; scale = 0.125f; }
  const bf16_t* K2p = (const bf16_t*)(p.ws + WS_KROPE);
  const u64* mask = (const u64*)(p.ws + WS_MASK);
  float* tab = (float*)(lds + AT_TAB);
  LAS unsigned char* l3 = (LAS unsigned char*)lds;

  __syncthreads();
  if (TYPE != 1) {
    const int col = (TYPE == 0) ? head : (head - 11 + 6);
    for (int d = tid; d < 2048; d += 512) {
      float v = p.rel_bias[t5_bucket(d) * 11 + col];
      if (TYPE == 0) { const int mult = (d <= 128) + ((d & 3) == 0 && d <= 512) + ((d & 15) == 0);
        v = (mult == 0) ? NEGV : v + (mult == 1 ? 0.f : (mult == 2 ? 0.6931471805599453f : 1.0986122886681098f)); }
      tab[d] = v;
    }
  }
  const int q0 = qb * 256 + wave * 32;
  bf16x8 qf[2][KS];
#pragma unroll
  for (int u = 0; u < 2; ++u)
#pragma unroll
    for (int s = 0; s < KS; ++s) qf[u][s] = *(const bf16x8*)(Qp + (rowb + q0 + u * 16 + fr) * qpitch + s * 32 + fq * 8);
  f32x4 o[4][2]; float mrow[2], lrow[2];
#pragma unroll
  for (int u = 0; u < 2; ++u) { mrow[u] = NEGV; lrow[u] = 0.f;
#pragma unroll
    for (int dt = 0; dt < 4; ++dt) o[dt][u] = (f32x4){0.f, 0.f, 0.f, 0.f}; }

  const int nkt = (qb + 1) * 4;
  const int lkey = tid >> 3, lch = tid & 7;
  u32x4 kreg, vreg, k2reg; u64 mreg[2] = {0ull, 0ull};
  auto prefetch = [&](int kt) {
    const size_t r = rowb + kt * 64 + lkey;
    kreg = *(const u32x4*)(Kp + r * kpitch + lch * 8);
    vreg = *(const u32x4*)(Vp + r * kpitch + lch * 8);
    if (KS == 3) { if (tid < 256) k2reg = *(const u32x4*)(K2p + (rowb + kt * 64 + (tid >> 2)) * 32 + (tid & 3) * 8); }
    if (TYPE == 2) { mreg[0] = mask[(rowb + q0 + fr) * 32 + kt]; mreg[1] = mask[(rowb + q0 + 16 + fr) * 32 + kt]; }
  };
  prefetch(0);
  for (int kt = 0; kt < nkt; ++kt) {
    __syncthreads();
    *(u32x4*)(lds + AT_K + lkey * KROW + lch * 16) = kreg;
    *(u32x4*)(lds + AT_V + lkey * VROW + lch * 16) = vreg;
    if (KS == 3) { if (tid < 256) *(u32x4*)(lds + AT_K + (tid >> 2) * KROW + 128 + (tid & 3) * 16) = k2reg; }
    const u64 mcur0 = mreg[0], mcur1 = mreg[1];
    __syncthreads();
    if (kt + 1 < nkt) prefetch(kt + 1);
    const int kbase = kt * 64;
    if (kbase > q0 + 31) continue;
    f32x4 s[4][2];
#pragma unroll
    for (int k16 = 0; k16 < 4; ++k16) {
      s[k16][0] = (f32x4){0.f, 0.f, 0.f, 0.f}; s[k16][1] = (f32x4){0.f, 0.f, 0.f, 0.f};
#pragma unroll
      for (int ss = 0; ss < KS; ++ss) {
        const bf16x8 kf = *(const LAS bf16x8*)(l3 + AT_K + (k16 * 16 + fr) * KROW + ss * 64 + fq * 16);
        s[k16][0] = __builtin_amdgcn_mfma_f32_16x16x32_bf16(kf, qf[0][ss], s[k16][0], 0, 0, 0);
        s[k16][1] = __builtin_amdgcn_mfma_f32_16x16x32_bf16(kf, qf[1][ss], s[k16][1], 0, 0, 0);
      }
    }
    bf16x8 pb[2][2];
#pragma unroll
    for (int u = 0; u < 2; ++u) {
      const int qpos = q0 + u * 16 + fr;
      const u64 mw = u ? mcur1 : mcur0;
      float mx = NEGV;
#pragma unroll
      for (int k16 = 0; k16 < 4; ++k16)
#pragma unroll
        for (int j = 0; j < 4; ++j) {
          const int kl = k16 * 16 + fq * 4 + j, dist = qpos - (kbase + kl);
          float v = s[k16][u][j] * scale;
          if (TYPE != 1) v += tab[dist < 0 ? 0 : dist];
          bool ok = dist >= 0;
          if (TYPE == 2) ok = ok && ((mw >> kl) & 1ull);
          v = ok ? v : NEGV;
          s[k16][u][j] = v; mx = fmaxf(mx, v);
        }
      mx = fmaxf(mx, __shfl_xor(mx, 16)); mx = fmaxf(mx, __shfl_xor(mx, 32));
      const float mnew = fmaxf(mrow[u], mx), alpha = __expf(mrow[u] - mnew);
      mrow[u] = mnew;
      float ps = 0.f;
#pragma unroll
      for (int k16 = 0; k16 < 4; ++k16)
#pragma unroll
        for (int j = 0; j < 4; ++j) { const float e = __expf(s[k16][u][j] - mnew); s[k16][u][j] = e; ps += e; }
      lrow[u] = lrow[u] * alpha + ps;
#pragma unroll
      for (int dt = 0; dt < 4; ++dt) o[dt][u] = o[dt][u] * alpha;
#pragma unroll
      for (int kc = 0; kc < 2; ++kc) {
        u32x4 w; w.x = cvt_pk_bf16(s[2 * kc][u][0], s[2 * kc][u][1]); w.y = cvt_pk_bf16(s[2 * kc][u][2], s[2 * kc][u][3]);
        w.z = cvt_pk_bf16(s[2 * kc + 1][u][0], s[2 * kc + 1][u][1]); w.w = cvt_pk_bf16(s[2 * kc + 1][u][2], s[2 * kc + 1][u][3]);
        pb[u][kc] = __builtin_bit_cast(bf16x8, w);
      }
    }
#pragma unroll
    for (int kc = 0; kc < 2; ++kc)
#pragma unroll
      for (int dt = 0; dt < 4; ++dt) {
        const LAS unsigned char* vb = l3 + AT_V + (kc * 32 + 4 * fq + (fr >> 2)) * VROW + (dt * 16 + 4 * (fr & 3)) * 2;
        const s16x4 v0 = vtr(vb), v1 = vtr(vb + 16 * VROW);
        bf16x8 vf; vf[0] = v0[0]; vf[1] = v0[1]; vf[2] = v0[2]; vf[3] = v0[3]; vf[4] = v1[0]; vf[5] = v1[1]; vf[6] = v1[2]; vf[7] = v1[3];
        o[dt][0] = __builtin_amdgcn_mfma_f32_16x16x32_bf16(vf, pb[0][kc], o[dt][0], 0, 0, 0);
        o[dt][1] = __builtin_amdgcn_mfma_f32_16x16x32_bf16(vf, pb[1][kc], o[dt][1], 0, 0, 0);
      }
  }
  bf16_t* outp = (bf16_t*)(p.ws + WS_NB);
#pragma unroll
  for (int u = 0; u < 2; ++u) {
    float l = lrow[u]; l += __shfl_xor(l, 16); l += __shfl_xor(l, 32);
    const float il = 1.f / l;
    bf16_t* orow = outp + (rowb + q0 + u * 16 + fr) * DM + head * 64 + fq * 4;
#pragma unroll
    for (int dt = 0; dt < 4; ++dt) { u32x2 w; w.x = cvt_pk_bf16(o[dt][u][0] * il, o[dt][u][1] * il); w.y = cvt_pk_bf16(o[dt][u][2] * il, o[dt][u][3] * il);
      *(u32x2*)(orow + dt * 16) = w; }
  }
}
__device__ __forceinline__ void phase_attn(const Params& p, unsigned char* lds) {
  constexpr int NITEMS = BATCH * 16 * 8;
  for (int it = blockIdx.x; it < NITEMS; it += gridDim.x) {
    const int r = it >> 8, c = it & 255;
    const int qb = (r & 1) ? (r >> 1) : 7 - (r >> 1), b = c >> 4, head = ((c & 15) + 2 * r) & 15;
    if (head < 6) attn_item<2, 0>(p, lds, b, head, qb);
    else if (head < 11) attn_item<3, 1>(p, lds, b, head, qb);
    else attn_item<2, 2>(p, lds, b, head, qb);
  }
  __syncthreads();
}

#define XB_TMO      128
#define XB_XCNT(j)  (256  + 64 * (j))
#define XB_XSUB(j)  (1280 + 64 * (j))
#define XB_XGEN(j)  (2304 + 64 * (j))
#define XB_TOP      3328
#define XB_TOPGEN   3392
#define XCD_BAR_WORDS 3456
#define XB_SPIN_CAP (1u << 18)
__device__ __forceinline__ unsigned xb_ld(unsigned* p)              { return __hip_atomic_load(p, __ATOMIC_RELAXED, __HIP_MEMORY_SCOPE_AGENT); }
__device__ __forceinline__ unsigned xb_add(unsigned* p, unsigned v) { return __hip_atomic_fetch_add(p, v, __ATOMIC_RELAXED, __HIP_MEMORY_SCOPE_AGENT); }
__device__ __forceinline__ unsigned xb_xcc_id() { return (unsigned)__builtin_amdgcn_s_getreg((3 << 11) | 20) & 0xFu; }
#define XB_SPIN(cond, bar) do { unsigned _sp = 0; while (cond) { __builtin_amdgcn_s_sleep(1); \
    if ((++_sp & 255u) == 0u) { if (xb_ld(&(bar)[XB_TMO])) break; if (_sp > XB_SPIN_CAP) { atomicAdd(&(bar)[XB_TMO], 1u); break; } } } } while (0)
struct XcdBarrier { unsigned* bar; unsigned x; volatile LAS unsigned* st; };
__device__ __forceinline__ XcdBarrier xcd_barrier_post(unsigned* bar, volatile LAS unsigned* st) {
  XcdBarrier b; b.bar = bar; b.x = xb_xcc_id(); b.st = st;
  if (threadIdx.x == 0) (void)xb_add(&bar[XB_XCNT(b.x)], 1u);
  return b;
}
__device__ __forceinline__ void xcd_barrier_complete(unsigned* bar, unsigned x, unsigned& nloc, unsigned& nx) {
  const unsigned G = gridDim.x * gridDim.y * gridDim.z;
  unsigned sum, cnt, mine, sp = 0u;
  for (;;) {
    sum = 0u; cnt = 0u; mine = 0u;
#pragma unroll
    for (unsigned j = 0; j < 16; ++j) { const unsigned c = xb_ld(&bar[XB_XCNT(j)]); sum += c; cnt += (c > 0u) ? 1u : 0u; mine = (j == x) ? c : mine; }
    if (sum == G) break;
    __builtin_amdgcn_s_sleep(1);
    if ((++sp & 255u) == 0u) { if (xb_ld(&bar[XB_TMO])) break; if (sp > XB_SPIN_CAP) { atomicAdd(&bar[XB_TMO], 1u); break; } }
  }
  nloc = mine > 0u ? mine : 1u; nx = cnt > 0u ? cnt : 1u;
}
__device__ __forceinline__ void xcd_barrier(const XcdBarrier& b) {
  asm volatile("s_waitcnt vmcnt(0)" ::: "memory");
  __syncthreads();
  if (threadIdx.x == 0) {
    unsigned* bar = b.bar;
    __builtin_amdgcn_s_waitcnt(0);
    unsigned nloc = b.st[0], nx = b.st[1];
    if (nloc == 0u) { xcd_barrier_complete(bar, b.x, nloc, nx); b.st[0] = nloc; b.st[1] = nx; }
    const unsigned old = xb_add(&bar[XB_XSUB(b.x)], 1u);
    const unsigned gen = old / nloc;
    if (old + 1u == (gen + 1u) * nloc) {
      __builtin_amdgcn_fence(__ATOMIC_RELEASE, "agent");
      asm volatile("s_waitcnt vmcnt(0)" ::: "memory");
      const unsigned og = xb_add(&bar[XB_TOP], 1u);
      const unsigned tg = og / nx;
      if (og + 1u == (tg + 1u) * nx) xb_add(&bar[XB_TOPGEN], 1u);
      else XB_SPIN(xb_ld(&bar[XB_TOPGEN]) == tg, bar);
      __builtin_amdgcn_fence(__ATOMIC_ACQUIRE, "agent");
      xb_add(&bar[XB_XGEN(b.x)], 1u);
      asm volatile("s_waitcnt vmcnt(0)" ::: "memory");
    } else {
      XB_SPIN(xb_ld(&bar[XB_XGEN(b.x)]) == gen, bar);
      __builtin_amdgcn_fence(__ATOMIC_ACQUIRE, "agent");
      asm volatile("s_waitcnt vmcnt(0)" ::: "memory");
    }
  }
  __syncthreads();
}

#ifndef PHMASK
#define PHMASK 0xFFFFu
#endif
#ifndef DUPMASK
#define DUPMASK 0u
#endif
typedef const Params __attribute__((address_space(4)))* cparams_t;
__device__ __forceinline__ cparams_t kparams() { cparams_t q = (cparams_t)__builtin_amdgcn_kernarg_segment_ptr(); asm volatile("" : "+s"(q)); return q; }
__global__ void __launch_bounds__(512) mega(Params p_unused) {
#if defined(__HIP_DEVICE_COMPILE__)
  extern __shared__ __attribute__((aligned(16))) unsigned char lds[];
  cg::grid_group grid = cg::this_grid();
  { volatile LAS unsigned* st = (volatile LAS unsigned*)((LAS unsigned char*)lds + (LDS_BYTES - 16)); if (threadIdx.x < 2) st[threadIdx.x] = 0u; }
  __syncthreads();
  XcdBarrier xbar = xcd_barrier_post((unsigned*)((*kparams()).ws + WS_BAR), (volatile LAS unsigned*)((LAS unsigned char*)lds + (LDS_BYTES - 16)));
  int nsteps = 2 + 13 * DEPTH + 1;
  asm volatile("" : "+s"(nsteps));
#pragma unroll 1
  for (int step = 0; step < nsteps; ++step) {
    const Params p = *kparams();
    if (step == 0) { if (PHMASK & 1u) { for (int rep = 0; rep < ((DUPMASK & 16u) ? 2 : 1); ++rep) phase0(p, lds); } }
    else if (step == 1) { if (PHMASK & 1u) phase_mod_reduce(p); }
    else if (step == nsteps - 1) { if (PHMASK & 2u) phase_final_norm(p.out, p.final_norm); }
    else {
      const int l = (step - 2) / 13, sub = (step - 2) % 13;
      unsigned char* wl = p.ws + WS_W + (size_t)l * WL_STRIDE;
      const float* mod = (const float*)(p.ws + WS_MOD) + (size_t)l * 16 * MODW;
      const float* hin = (l == 0) ? p.x : p.out;
      bf16_t* NB = (bf16_t*)(p.ws + WS_NB); bf16_t* BIG = (bf16_t*)(p.ws + WS_BIG);
      if (sub == 0 || sub == 3 || sub == 10) {
        const float* src = (sub == 0) ? hin : p.out;
        const float* gain = ((sub == 0) ? p.norm_ffn1 : (sub == 3) ? p.norm_mix : p.norm_ffn2) + l * DM;
        const int mo = (sub == 0) ? 0 : (sub == 3) ? 3 : 6;
        if (PHMASK & 4u) { for (int rep = 0; rep < ((DUPMASK & 32u) ? 2 : 1); ++rep) phase_norm(src, gain, mod + mo * DM, mod + (mo + 1) * DM, NB); }
      } else if (sub == 5) { if (PHMASK & 8u) phase_prep(p, l); }
      else if (sub == 7) { if (PHMASK & 16u) { phase_qrope(p); for (int rep = 0; rep < ((DUPMASK & 1u) ? 2 : 1); ++rep) phase_indexer(p, lds); } }
      else if (sub == 8) { if (PHMASK & 32u) { for (int rep = 0; rep < ((DUPMASK & 2u) ? 2 : 1); ++rep) phase_attn(p, lds); } }
      else {
        const bf16_t* A = NB; const bf16_t* Bt; int N = DM, K = DM; pg8::EpiDyn E{};
        if (sub == 1 || sub == 11) { Bt = (const bf16_t*)(wl + (sub == 1 ? WO_GU1 : WO_GU2)); N = NGU; E.type = 1; E.O = BIG; }
        else if (sub == 2 || sub == 12) { A = BIG; Bt = (const bf16_t*)(wl + (sub == 2 ? WO_D1 : WO_D2)); K = DFF; E.type = 2; E.src = (sub == 2) ? hin : p.out; E.dst = p.out; E.gate = mod + (sub == 2 ? 2 : 8) * DM; E.coef = 0.5f; }
        else if (sub == 4) { Bt = (const bf16_t*)(wl + WO_IN); N = INWP; E.type = 0; E.O = BIG; E.ldc = INWP; }
        else if (sub == 6) { A = (const bf16_t*)(p.ws + WS_MLAA); Bt = (const bf16_t*)(wl + WO_MLA); N = MLA_N; K = MLA_K; E.type = 0; E.O = (bf16_t*)(p.ws + WS_MLAO); E.ldc = MLA_N; }
        else { Bt = (const bf16_t*)(wl + WO_OUT); E.type = 2; E.src = p.out; E.dst = p.out; E.gate = mod + 5 * DM; E.coef = 1.0f; }
        if (PHMASK & 64u) { const int nrep = (((DUPMASK & 4u) && E.type == 1) || ((DUPMASK & 8u) && sub == 4)) ? 2 : 1;
#pragma unroll 1
          for (int rep = 0; rep < nrep; ++rep) run_gemm(lds, A, Bt, N, K, E); }
      }
    }
    if (step == 0) grid.sync(); else xcd_barrier(xbar);
    if (DUPMASK & 64u) xcd_barrier(xbar);
  }
#endif
}

extern "C" void kernel_launch(void* const* d_in, const int* in_sizes, int n_in, void* d_out, int out_size, void* d_ws, size_t ws_size, hipStream_t stream) {
  static int grid_blocks = 0;
  if (!grid_blocks) {
    int dev = 0, cus = 0, per_cu = 0;
    (void)hipGetDevice(&dev);
    (void)hipDeviceGetAttribute(&cus, hipDeviceAttributeMultiprocessorCount, dev);
    (void)hipFuncSetAttribute((const void*)mega, hipFuncAttributeMaxDynamicSharedMemorySize, LDS_BYTES);
    (void)hipOccupancyMaxActiveBlocksPerMultiprocessor(&per_cu, (const void*)mega, 512, LDS_BYTES);
    if (per_cu < 1) per_cu = 1;
    grid_blocks = cus * per_cu;
    if (ws_size < WS_END) fprintf(stderr, "kernel_launch: workspace too small: %zu < %zu\n", ws_size, (size_t)WS_END);
  }
  Params p{};
  p.x = (const float*)d_in[0]; p.c = (const float*)d_in[1]; p.pos = (const int*)d_in[2]; p.rel_bias = (const float*)d_in[3]; p.ada_w = (const float*)d_in[4]; p.ada_b = (const float*)d_in[5];
  p.norm_ffn1 = (const float*)d_in[6]; p.ffn1_gu = (const float*)d_in[7]; p.ffn1_down = (const float*)d_in[8]; p.norm_mix = (const float*)d_in[9]; p.w_in = (const float*)d_in[10];
  p.q_norm = (const float*)d_in[11]; p.w_uq = (const float*)d_in[12]; p.kv_norm = (const float*)d_in[13]; p.w_ukv = (const float*)d_in[14]; p.ik_norm = (const float*)d_in[15]; p.w_out = (const float*)d_in[16];
  p.norm_ffn2 = (const float*)d_in[17]; p.ffn2_gu = (const float*)d_in[18]; p.ffn2_down = (const float*)d_in[19]; p.final_norm = (const float*)d_in[20];
  p.out = (float*)d_out; p.ws = (unsigned char*)d_ws;
  (void)hipMemsetAsync((unsigned char*)d_ws + WS_BAR, 0, 16384, stream);
  void* args[] = {&p};
  hipError_t e = hipLaunchCooperativeKernel((void*)mega, dim3(grid_blocks), dim3(512), args, LDS_BYTES, stream);
  if (e != hipSuccess) fprintf(stderr, "cooperative launch failed: %s (grid %d)\n", hipGetErrorString(e), grid_blocks);
}
```

```cpp
#include <hip/hip_runtime.h>
#include <hip/hip_cooperative_groups.h>
#include <cstdio>
#include <cstdint>
namespace cg = cooperative_groups;

#define LAS __attribute__((address_space(3)))
typedef unsigned short bf16_t;
typedef short bf16x8 __attribute__((ext_vector_type(8)));
typedef short s16x4 __attribute__((ext_vector_type(4)));
typedef float f32x4 __attribute__((ext_vector_type(4)));
typedef float f32x2 __attribute__((ext_vector_type(2)));
typedef unsigned u32x4 __attribute__((ext_vector_type(4)));
typedef unsigned u32x2 __attribute__((ext_vector_type(2)));
typedef unsigned long long u64;

constexpr int BATCH = 16, SEQ = 2048, DM = 1024, MTOK = BATCH * SEQ, DFF = 2816, NGU = 2 * DFF, INW = 3112, INWP = 3328, NMOD = 9, DEPTH = 2;
constexpr int OFF_QA = 0, OFF_KA = 384, OFF_VA = 768, OFF_CQ = 1152, OFF_CKV = 1408, OFF_KR = 1536, OFF_QC = 1568, OFF_KC = 1888, OFF_VC = 2208, OFF_IQ = 2528, OFF_IK = 3040, OFF_IW = 3104;
constexpr int MLA_K = 384, MLA_N = 1280;
constexpr int MODW = NMOD * DM;
constexpr float RMS_EPS = 1e-6f;
constexpr float NEGV = -1e30f;

constexpr size_t MiB = 1ull << 20;
constexpr size_t WS_NB = 0;
constexpr size_t WS_BIG = 64 * MiB;
constexpr size_t WS_MLAA = 272 * MiB;
constexpr size_t WS_MLAO = 296 * MiB;
constexpr size_t WS_KROPE = 376 * MiB;
constexpr size_t WS_IKN = 378 * MiB;
constexpr size_t WS_MASK = 382 * MiB;
constexpr size_t WS_MOD = 390 * MiB;
constexpr size_t WS_ADAP = 392 * MiB;
constexpr size_t WS_W = 402 * MiB;
constexpr size_t WL_STRIDE = 43 * MiB;
constexpr size_t WO_GU1 = 0, WO_D1 = 11 * MiB, WO_IN = 11 * MiB + 5632 * 1024, WO_MLA = WO_IN + (size_t)INWP * 1024 * 2, WO_OUT = WO_MLA + 1 * MiB, WO_GU2 = WO_OUT + 2 * MiB, WO_D2 = WO_GU2 + 11 * MiB;
static_assert(WO_D2 + 5632 * 1024 <= WL_STRIDE, "weights map");
constexpr size_t WS_BAR = WS_W + 2 * WL_STRIDE;
constexpr size_t WS_SSQ = WS_BAR + 1 * MiB;
constexpr size_t WS_CV = WS_SSQ + 1 * MiB;
constexpr size_t CV_STRIDE = 16 * 5632;
constexpr size_t WS_END = WS_CV + 4 * MiB;

constexpr int LDS_BYTES = 143360;

struct Params {
  const float* x; const float* c; const int* pos; const float* rel_bias; const float* ada_w; const float* ada_b;
  const float* norm_ffn1; const float* ffn1_gu; const float* ffn1_down; const float* norm_mix; const float* w_in;
  const float* q_norm; const float* w_uq; const float* kv_norm; const float* w_ukv; const float* ik_norm; const float* w_out;
  const float* norm_ffn2; const float* ffn2_gu; const float* ffn2_down; const float* final_norm;
  float* out; unsigned char* ws;
};

__device__ __forceinline__ unsigned cvt_pk_bf16(float lo, float hi) { unsigned r; asm volatile("v_cvt_pk_bf16_f32 %0, %1, %2" : "=v"(r) : "v"(lo), "v"(hi)); return r; }
__device__ __forceinline__ float bf2f(unsigned short h) { return __builtin_bit_cast(float, (unsigned)h << 16); }
__device__ __forceinline__ float bflo(unsigned w) { return __builtin_bit_cast(float, w << 16); }
__device__ __forceinline__ float bfhi(unsigned w) { return __builtin_bit_cast(float, w & 0xffff0000u); }
__device__ __forceinline__ unsigned short f2bf(float f) { return (unsigned short)(cvt_pk_bf16(f, 0.f) & 0xffffu); }
__device__ __forceinline__ int otid() { int t = threadIdx.x; asm volatile("" : "+v"(t)); return t; }
__device__ __forceinline__ float wave_sum(float v) {
#pragma unroll
  for (int o = 1; o < 64; o <<= 1) v += __shfl_xor(v, o);
  return v;
}
__device__ __forceinline__ int t5_bucket(int n) {
  if (n < 16) return n;
  int b = 16;
  b += (n >= 19); b += (n >= 21); b += (n >= 24); b += (n >= 27); b += (n >= 31); b += (n >= 35); b += (n >= 40); b += (n >= 46);
  b += (n >= 52); b += (n >= 59); b += (n >= 67); b += (n >= 77); b += (n >= 87); b += (n >= 99); b += (n >= 113);
  return b;
}
__device__ __forceinline__ void sincos_big(float ang, float& s, float& c) {
  double rev = (double)ang * 0.15915494309189535;
  rev -= __builtin_floor(rev);
  float fr = (float)rev;
  s = __builtin_amdgcn_sinf(fr); c = __builtin_amdgcn_cosf(fr);
}
__device__ __forceinline__ float rope_inv(int i) { return __builtin_amdgcn_exp2f(-(float)i * (13.287712379549449f / 16.f)); }

typedef const Params __attribute__((address_space(4)))* cparams_t;
__device__ __forceinline__ cparams_t kparams() { cparams_t q = (cparams_t)__builtin_amdgcn_kernarg_segment_ptr(); asm volatile("" : "+s"(q)); return q; }
namespace pg8 {
constexpr int BM = 256, BK = 64, HALF = 128, HTB = HALF * BK * 2, STAGE_BYTES = 8 * HTB, NXCD = 8, WGM = 8;
__host__ __device__ __forceinline__ int lds_byte(int r, int c) { const int st = (r >> 4) * 2 + (c >> 5), rr = r & 15, cc = c & 31, ob = rr * 64 + cc * 2; return st * 1024 + (ob ^ (((ob >> 9) & 1) << 5)); }
__host__ __device__ __forceinline__ void stage_rc(int b, int& R, int& C) { const int st = b / 1024, sb = b % 1024, swz = sb ^ (((sb >> 9) & 1) << 5); R = (st >> 1) * 16 + swz / 64; C = (st & 1) * 32 + (swz % 64) / 2; }
__host__ __device__ __forceinline__ int perm32(int rho) { const int n = rho >> 4, i = rho & 15; return 8 * (i >> 2) + 4 * n + (i & 3); }
struct Unit { int pm, pn; };
struct Gemm { const bf16_t* A; const bf16_t* Bt; int M, N, K; };
struct StaticOrder {
  int nM, nN, nwg, G, c;
  __host__ __device__ void init(int M, int N, int G_, int c_) { nM = M / BM; nN = N / BM; nwg = nM * nN; G = G_; c = c_; }
  __host__ __device__ bool next(int i, Unit& u) const {
    const long L = (long)i * G + c; if (L >= nwg) return false;
    int wgid = (int)L; { const int q = nwg / NXCD, r = nwg % NXCD, xcd = wgid % NXCD, off = wgid / NXCD; wgid = (xcd < r ? xcd * (q + 1) : r * (q + 1) + (xcd - r) * q) + off; }
    const int nig = WGM * nN, gid = wgid / nig, fm = gid * WGM, gsz = (nM - fm) < WGM ? (nM - fm) : WGM;
    u.pm = fm + ((wgid % nig) % gsz); u.pn = (wgid % nig) / gsz; return true;
  }
  __device__ __forceinline__ void a_ready(const Unit&) const {}
  __device__ __forceinline__ void done(const Unit&) const {}
};

__device__ __forceinline__ float silu_mul(float g, float uu) { return g * __builtin_amdgcn_rcpf(1.f + __expf(-g)) * uu; }
struct EpiDyn {
  static constexpr bool PERM = true, AFTER_DRAIN = false;
  int sub, l;
  __device__ __forceinline__ void operator()(const f32x4 (&acc)[2][2][4][2], const Unit& u, int wr, int wc, int fr, int fq) const {
#if defined(__HIP_DEVICE_COMPILE__)
    const Params p = *kparams();
    unsigned char* wsb = p.ws;
    const float* mod = (const float*)(wsb + WS_MOD) + (size_t)l * 16 * MODW;
    bf16_t* NBp = (bf16_t*)(wsb + WS_NB); bf16_t* BIGp = (bf16_t*)(wsb + WS_BIG); bf16_t* HID2p = (bf16_t*)(wsb + WS_BIG + 64 * MiB);
    float* ssqb = (float*)(wsb + WS_SSQ); const float* cvl = (const float*)(wsb + WS_CV) + (size_t)l * 3 * CV_STRIDE;
    const bool isgu = (sub == 1 || sub == 11), isdn = (sub == 2 || sub == 12), isres = isdn || sub == 9, lastd = (sub == 12 && l + 1 >= DEPTH);
    const int type = isgu ? 1 : isres ? 2 : 0;
    bf16_t* O = (sub == 1 || sub == 4) ? BIGp : (sub == 11) ? HID2p : (bf16_t*)(wsb + WS_MLAO);
    const int ldc = (sub == 4) ? INWP : MLA_N, ncv = 5632;
    const float* ssq = (sub == 6) ? (const float*)nullptr : (const float*)ssqb;
    const float* cv = cvl + ((sub == 1) ? 0 : (sub == 4) ? 1 : 2) * CV_STRIDE;
    const float* src = (sub == 2 && l == 0) ? p.x : (const float*)p.out; float* dst = p.out;
    const float* gate = mod + ((sub == 2) ? 2 : (sub == 12) ? 8 : 5) * DM; const float coef = isdn ? 0.5f : 1.0f;
    bf16_t* nbo = lastd ? (bf16_t*)nullptr : (sub == 9) ? BIGp : NBp;
    const float* gain_n = (sub == 2) ? p.norm_mix + l * DM : (sub == 9) ? p.norm_ffn2 + l * DM : p.norm_ffn1 + (lastd ? 0 : (l + 1)) * DM;
    const float* scale_n = (sub == 2) ? mod + 4 * DM : (sub == 9) ? mod + 7 * DM : mod + 16 * MODW + 1 * DM;
    float* ssq_o = ssqb;
    extern __shared__ __attribute__((aligned(16))) unsigned char lds_epi[];
    LAS float* ps = (LAS float*)((LAS unsigned char*)lds_epi + 131072);
    const int row0 = u.pm * BM + wr * 64 + fr, b = u.pm >> 3;
    if (type == 0) {
      const int col0 = u.pn * BM + wc * 32 + 8 * fq;
      f32x4 cvv[2][2];
#pragma unroll
      for (int bj = 0; bj < 2; ++bj)
#pragma unroll
        for (int n = 0; n < 2; ++n) cvv[bj][n] = ssq ? *(const f32x4*)(cv + (size_t)b * ncv + col0 + bj * HALF + 4 * n) : (f32x4){0.f, 0.f, 0.f, 0.f};
#pragma unroll
      for (int ai = 0; ai < 2; ++ai)
#pragma unroll
        for (int m = 0; m < 4; ++m) { const int row = row0 + ai * HALF + m * 16; bf16_t* rowp = O + (size_t)row * ldc + col0;
          float rs = 1.f;
          if (ssq) { const f32x4 q = *(const f32x4*)(ssq + (size_t)row * 4); rs = __builtin_amdgcn_rsqf(((q[0] + q[1]) + (q[2] + q[3])) * (1.f / DM) + RMS_EPS); }
#pragma unroll
          for (int bj = 0; bj < 2; ++bj) { const f32x4 v0 = acc[ai][bj][m][0] * rs + cvv[bj][0], v1 = acc[ai][bj][m][1] * rs + cvv[bj][1];
            u32x4 w; w.x = cvt_pk_bf16(v0[0], v0[1]); w.y = cvt_pk_bf16(v0[2], v0[3]); w.z = cvt_pk_bf16(v1[0], v1[1]); w.w = cvt_pk_bf16(v1[2], v1[3]);
            *(u32x4*)(rowp + bj * HALF) = w; } }
    } else if (type == 1) {
      const int col0 = u.pn * HALF + wc * 32 + 8 * fq, ccol = u.pn * BM + wc * 32 + 8 * fq;
      f32x4 cvv[2][2];
#pragma unroll
      for (int bj = 0; bj < 2; ++bj)
#pragma unroll
        for (int n = 0; n < 2; ++n) cvv[bj][n] = *(const f32x4*)(cv + (size_t)b * ncv + ccol + bj * HALF + 4 * n);
#pragma unroll
      for (int ai = 0; ai < 2; ++ai)
#pragma unroll
        for (int m = 0; m < 4; ++m) { const int row = row0 + ai * HALF + m * 16; bf16_t* rowp = O + (size_t)row * DFF + col0;
          const f32x4 q = *(const f32x4*)(ssq + (size_t)row * 4); const float rs = __builtin_amdgcn_rsqf(((q[0] + q[1]) + (q[2] + q[3])) * (1.f / DM) + RMS_EPS);
          const f32x4 g0 = acc[ai][0][m][0] * rs + cvv[0][0], g1 = acc[ai][0][m][1] * rs + cvv[0][1], u0 = acc[ai][1][m][0] * rs + cvv[1][0], u1 = acc[ai][1][m][1] * rs + cvv[1][1];
          u32x4 w; w.x = cvt_pk_bf16(silu_mul(g0[0], u0[0]), silu_mul(g0[1], u0[1])); w.y = cvt_pk_bf16(silu_mul(g0[2], u0[2]), silu_mul(g0[3], u0[3]));
          w.z = cvt_pk_bf16(silu_mul(g1[0], u1[0]), silu_mul(g1[1], u1[1])); w.w = cvt_pk_bf16(silu_mul(g1[2], u1[2]), silu_mul(g1[3], u1[3]));
          *(u32x4*)rowp = w; }
    } else {
      const int col0 = u.pn * BM + wc * 32 + 8 * fq;
      const float* gp = gate + (size_t)b * MODW + col0;
      f32x4 gv[2][2], gn[2][2];
#pragma unroll
      for (int bj = 0; bj < 2; ++bj)
#pragma unroll
        for (int n = 0; n < 2; ++n) { gv[bj][n] = *(const f32x4*)(gp + bj * HALF + 4 * n) * coef;
          gn[bj][n] = nbo ? *(const f32x4*)(gain_n + col0 + bj * HALF + 4 * n) * (*(const f32x4*)(scale_n + (size_t)b * MODW + col0 + bj * HALF + 4 * n) + 1.f) : (f32x4){0.f, 0.f, 0.f, 0.f}; }
#pragma unroll
      for (int ai = 0; ai < 2; ++ai)
#pragma unroll
        for (int m = 0; m < 4; ++m) { const size_t ro = (size_t)(row0 + ai * HALF + m * 16) * DM + col0; float ss = 0.f;
#pragma unroll
          for (int bj = 0; bj < 2; ++bj) { f32x4 hn[2];
#pragma unroll
            for (int n = 0; n < 2; ++n) { const f32x4 sv = *(const f32x4*)(src + ro + bj * HALF + 4 * n); hn[n] = sv + gv[bj][n] * acc[ai][bj][m][n];
              *(f32x4*)(dst + ro + bj * HALF + 4 * n) = hn[n]; ss += (hn[n][0] * hn[n][0] + hn[n][1] * hn[n][1]) + (hn[n][2] * hn[n][2] + hn[n][3] * hn[n][3]); }
            if (nbo) { const f32x4 y0 = hn[0] * gn[bj][0], y1 = hn[1] * gn[bj][1];
              u32x4 w; w.x = cvt_pk_bf16(y0[0], y0[1]); w.y = cvt_pk_bf16(y0[2], y0[3]); w.z = cvt_pk_bf16(y1[0], y1[1]); w.w = cvt_pk_bf16(y1[2], y1[3]);
              *(u32x4*)(nbo + ro + bj * HALF) = w; } }
          if (nbo) { ss += __shfl_xor(ss, 16); ss += __shfl_xor(ss, 32); if (fq == 0) ps[wc * 256 + ai * HALF + wr * 64 + m * 16 + fr] = ss; } }
      if (nbo) {
        asm volatile("s_waitcnt lgkmcnt(0)" ::: "memory"); __builtin_amdgcn_s_barrier();
        const int tid = (wr * 4 + wc) * 64 + fq * 16 + fr;
        if (tid < 256) { const float tot = (ps[tid] + ps[256 + tid]) + (ps[512 + tid] + ps[768 + tid]); ssq_o[(size_t)(u.pm * BM + tid) * 4 + u.pn] = tot; }
      }
    }
#endif
  }
};

template <class Epi, class Sched, bool ALIGN_EPI = false, bool SP2 = false>
__device__ __forceinline__ void gemm_phase(LAS unsigned char* lds, const Gemm g, const Sched S, const Epi E) {
  const int tid = otid(), wid = __builtin_amdgcn_readfirstlane(tid >> 6), lane = tid & 63, wr = wid >> 2, wc = wid & 3, fr = lane & 15, fq = lane >> 4;
  const int K = g.K, nt = K / BK;
  unsigned voffA[2], voffB[2];
#pragma unroll
  for (int i = 0; i < 2; ++i) { int R, C; stage_rc(tid * 16 + i * 8192, R, C); const int Rb = Epi::PERM ? ((R & ~31) + perm32(R & 31)) : R;
    voffA[i] = (unsigned)(R * K + C) * 2u; voffB[i] = (unsigned)(Rb * K + C) * 2u; }
  const size_t kstep = (size_t)(BK * 2);
  const size_t hstep = (size_t)HALF * K * 2;
  const size_t tstep = 2 * hstep;
  const unsigned ldsw = (unsigned)wid * 1024u;
  const int aoff = lds_byte(wr * 64 + fr, fq * 8), boff = lds_byte(wc * 32 + fr, fq * 8);
#define PG8_SA(b, h) (((b) * 2 + (h)) * HTB)
#define PG8_SB(b, h) ((4 + (b) * 2 + (h)) * HTB)
#define PG8_STAGE(bufoff, gbase, voff) do { _Pragma("unroll") for (int _i = 0; _i < 2; ++_i) \
        __builtin_amdgcn_global_load_lds((const unsigned*)((const char*)(gbase) + (voff)[_i]), (LAS unsigned*)(lds + (bufoff) + ldsw + _i * 8192), 16, 0, 0); } while (0)
#define PG8_LDA(dst, b, h) do { _Pragma("unroll") for (int m = 0; m < 4; ++m) _Pragma("unroll") for (int k = 0; k < 2; ++k) dst[m][k] = *(const LAS bf16x8*)(lds + PG8_SA(b, h) + aoff + m * 2048 + k * 1024); } while (0)
#define PG8_LDB(dst, b, h) do { _Pragma("unroll") for (int n = 0; n < 2; ++n) _Pragma("unroll") for (int k = 0; k < 2; ++k) dst[n][k] = *(const LAS bf16x8*)(lds + PG8_SB(b, h) + boff + n * 2048 + k * 1024); } while (0)
#define PG8_MMA(ai, bj, At, Bt) do { __builtin_amdgcn_s_setprio(1); _Pragma("unroll") for (int m = 0; m < 4; ++m) _Pragma("unroll") for (int n = 0; n < 2; ++n) _Pragma("unroll") for (int k = 0; k < 2; ++k) \
        acc[ai][bj][m][n] = __builtin_amdgcn_mfma_f32_16x16x32_bf16(Bt[n][k], At[m][k], acc[ai][bj][m][n], 0, 0, 0); __builtin_amdgcn_s_setprio(0); } while (0)
#define PG8_WAIT_V(n) asm volatile("s_waitcnt vmcnt(" #n ")" ::: "memory")
#define PG8_WAIT_L(n) asm volatile("s_waitcnt lgkmcnt(" #n ")" ::: "memory")
#define PG8_BAR __builtin_amdgcn_s_barrier()
#define PG8_SCHED __builtin_amdgcn_sched_barrier(0)
  Unit cur, nxt; int ui = 0;
  if (!S.next(0, cur)) return;
  f32x4 acc[2][2][4][2];
#pragma unroll
  for (int a = 0; a < 2; ++a)
#pragma unroll
    for (int b = 0; b < 2; ++b)
#pragma unroll
      for (int m = 0; m < 4; ++m)
#pragma unroll
        for (int n = 0; n < 2; ++n) acc[a][b][m][n] = (f32x4){0.f, 0.f, 0.f, 0.f};
  bf16x8 At[4][2], B0[2][2], B1[2][2];
  const char* cA = (const char*)g.A + (size_t)cur.pm * tstep; const char* cB = (const char*)g.Bt + (size_t)cur.pn * tstep;
  S.a_ready(cur);
  if constexpr (SP2) {
    PG8_STAGE(PG8_SB(0, 0), cB, voffB); PG8_STAGE(PG8_SB(0, 1), cB + hstep, voffB); PG8_STAGE(PG8_SA(0, 0), cA, voffA); PG8_STAGE(PG8_SA(0, 1), cA + hstep, voffA);
    if (wr == 1) PG8_BAR;
    PG8_WAIT_V(2); PG8_BAR;
    PG8_STAGE(PG8_SB(1, 0), cB + kstep, voffB); PG8_STAGE(PG8_SA(1, 0), cA + kstep, voffA); PG8_STAGE(PG8_SB(1, 1), cB + hstep + kstep, voffB);
    PG8_WAIT_V(6); PG8_BAR;
  } else {
    PG8_STAGE(PG8_SB(0, 0), cB, voffB); PG8_STAGE(PG8_SA(0, 0), cA, voffA); PG8_STAGE(PG8_SB(0, 1), cB + hstep, voffB); PG8_STAGE(PG8_SA(0, 1), cA + hstep, voffA);
    if (wr == 1) PG8_BAR;
    PG8_WAIT_V(4); PG8_BAR;
    PG8_STAGE(PG8_SB(1, 0), cB + kstep, voffB); PG8_STAGE(PG8_SA(1, 0), cA + kstep, voffA); PG8_STAGE(PG8_SB(1, 1), cB + hstep + kstep, voffB);
    PG8_WAIT_V(6); PG8_BAR;
  }
  for (;;) {
    const bool has_next = S.next(ui + 1, nxt);
    const char* nA = has_next ? (const char*)g.A + (size_t)nxt.pm * tstep : cA; const char* nB = has_next ? (const char*)g.Bt + (size_t)nxt.pn * tstep : cB;
#pragma unroll 1
    for (int t = 0; t < nt; t += 2) {
      const bool last = (t == nt - 2);
      const char* a1 = cA + (size_t)(t + 1) * kstep;
      const char* a2 = last ? nA : cA + (size_t)(t + 2) * kstep; const char* b2 = last ? nB : cB + (size_t)(t + 2) * kstep;
      const char* a3 = a2 + kstep; const char* b3 = b2 + kstep;
      if (last && has_next) S.a_ready(nxt);
      if constexpr (SP2) {
        PG8_LDB(B0, 0, 0); PG8_LDB(B1, 0, 1); PG8_SCHED; PG8_LDA(At, 0, 0); PG8_STAGE(PG8_SA(1, 1), a1 + hstep, voffA);
        PG8_WAIT_V(8); PG8_WAIT_L(0); PG8_BAR; PG8_MMA(0, 0, At, B0); PG8_MMA(0, 1, At, B1); PG8_BAR; PG8_SCHED;
        PG8_LDA(At, 0, 1); PG8_STAGE(PG8_SB(0, 0), b2, voffB); PG8_STAGE(PG8_SB(0, 1), b2 + hstep, voffB); PG8_STAGE(PG8_SA(0, 0), a2, voffA);
        PG8_WAIT_V(8); PG8_WAIT_L(0); PG8_BAR; PG8_MMA(1, 0, At, B0); PG8_MMA(1, 1, At, B1); PG8_BAR; PG8_SCHED;
        PG8_LDB(B0, 1, 0); PG8_LDB(B1, 1, 1); PG8_SCHED; PG8_LDA(At, 1, 0); PG8_STAGE(PG8_SA(0, 1), a2 + hstep, voffA);
        PG8_WAIT_V(8); PG8_WAIT_L(0); PG8_BAR; PG8_MMA(0, 0, At, B0); PG8_MMA(0, 1, At, B1); PG8_BAR; PG8_SCHED;
        PG8_LDA(At, 1, 1); PG8_STAGE(PG8_SB(1, 0), b3, voffB); PG8_STAGE(PG8_SB(1, 1), b3 + hstep, voffB); PG8_STAGE(PG8_SA(1, 0), a3, voffA);
        PG8_WAIT_V(8); PG8_WAIT_L(0); PG8_BAR; PG8_MMA(1, 0, At, B0); PG8_MMA(1, 1, At, B1); PG8_BAR; PG8_SCHED;
      } else {
        PG8_LDB(B0, 0, 0); PG8_SCHED; PG8_LDA(At, 0, 0); PG8_STAGE(PG8_SA(1, 1), a1 + hstep, voffA);
        PG8_WAIT_L(8); PG8_BAR; PG8_WAIT_L(0); PG8_MMA(0, 0, At, B0); PG8_BAR; PG8_SCHED;
        PG8_LDB(B1, 0, 1); PG8_STAGE(PG8_SB(0, 0), b2, voffB);
        PG8_BAR; PG8_WAIT_L(0); PG8_MMA(0, 1, At, B1); PG8_BAR;
        PG8_LDA(At, 0, 1); PG8_STAGE(PG8_SA(0, 0), a2, voffA);
        PG8_BAR; PG8_WAIT_L(0); PG8_MMA(1, 0, At, B0); PG8_BAR; PG8_SCHED;
        PG8_STAGE(PG8_SB(0, 1), b2 + hstep, voffB);
        PG8_WAIT_V(6); PG8_BAR; PG8_MMA(1, 1, At, B1); PG8_BAR;
        PG8_LDB(B0, 1, 0); PG8_SCHED; PG8_LDA(At, 1, 0); PG8_STAGE(PG8_SA(0, 1), a2 + hstep, voffA);
        PG8_WAIT_L(8); PG8_BAR; PG8_WAIT_L(0); PG8_MMA(0, 0, At, B0); PG8_BAR; PG8_SCHED;
        PG8_LDB(B1, 1, 1); PG8_STAGE(PG8_SB(1, 0), b3, voffB);
        PG8_BAR; PG8_WAIT_L(0); PG8_MMA(0, 1, At, B1); PG8_BAR;
        PG8_LDA(At, 1, 1); PG8_STAGE(PG8_SA(1, 0), a3, voffA);
        PG8_BAR; PG8_WAIT_L(0); PG8_MMA(1, 0, At, B0); PG8_BAR; PG8_SCHED;
        PG8_STAGE(PG8_SB(1, 1), b3 + hstep, voffB);
        PG8_WAIT_V(6); PG8_BAR; PG8_MMA(1, 1, At, B1); PG8_BAR;
      }
    }
    if constexpr (ALIGN_EPI) { if (wr == 0) PG8_BAR; }
    if constexpr (!Epi::AFTER_DRAIN) { E(acc, cur, wr, wc, fr, fq); S.done(cur); }
    if (!has_next) break;
#pragma unroll
    for (int a = 0; a < 2; ++a)
#pragma unroll
      for (int b = 0; b < 2; ++b)
#pragma unroll
        for (int m = 0; m < 4; ++m)
#pragma unroll
          for (int n = 0; n < 2; ++n) acc[a][b][m][n] = (f32x4){0.f, 0.f, 0.f, 0.f};
    cur = nxt; cA = nA; cB = nB; ++ui;
    if constexpr (ALIGN_EPI) { if (wr == 1) PG8_BAR; }
  }
  PG8_WAIT_V(0);
  if constexpr (!ALIGN_EPI) { if (wr == 0) PG8_BAR; }
  PG8_BAR;
#undef PG8_SA
#undef PG8_SB
#undef PG8_STAGE
#undef PG8_LDA
#undef PG8_LDB
#undef PG8_MMA
#undef PG8_WAIT_V
#undef PG8_WAIT_L
#undef PG8_BAR
#undef PG8_SCHED
}
}

template <class Epi>
__device__ __forceinline__ void run_gemm(unsigned char* lds, const bf16_t* A, const bf16_t* Bt, int N, int K, const Epi E) {
  pg8::Gemm g{A, Bt, MTOK, N, K}; pg8::StaticOrder S; S.init(MTOK, N, (int)gridDim.x, (int)blockIdx.x);
  pg8::gemm_phase<Epi, pg8::StaticOrder, true, true>((LAS unsigned char*)lds, g, S, E);
  __syncthreads();
}

template <class F>
__device__ __forceinline__ void cvt_tile(F src, bf16_t* dst, int ldd, int n0, int k0, float* tile) {
  const int tid = otid();
  float v[8];
#pragma unroll
  for (int i = 0; i < 8; ++i) { const int k = i * 8 + (tid >> 6), n = tid & 63; v[i] = src(k0 + k, n0 + n); }
#pragma unroll
  for (int i = 0; i < 8; ++i) { const int k = i * 8 + (tid >> 6), n = tid & 63; tile[k * 65 + n] = v[i]; }
  __syncthreads();
  { const int n = tid >> 3, kc = (tid & 7) * 8; const float* s = tile + kc * 65 + n;
    u32x4 o; o.x = cvt_pk_bf16(s[0], s[65]); o.y = cvt_pk_bf16(s[2 * 65], s[3 * 65]); o.z = cvt_pk_bf16(s[4 * 65], s[5 * 65]); o.w = cvt_pk_bf16(s[6 * 65], s[7 * 65]);
    *(u32x4*)(dst + (size_t)(n0 + n) * ldd + k0 + kc) = o; }
  __syncthreads();
}

__device__ __forceinline__ void phase0(const Params& p, unsigned char* lds) {
  float* tile = (float*)lds;
  const int tid = otid();
  constexpr int N_ADA = DEPTH * 18 * 8;
  constexpr int T_GU = 88 * 16, T_D = 16 * 44, T_IN = 52 * 16, T_MLA = 20 * 6, T_OUT = 16 * 16;
  constexpr int T_LAYER = 2 * T_GU + 2 * T_D + T_IN + T_MLA + T_OUT;
  constexpr int NITEMS = N_ADA + DEPTH * T_LAYER;
  for (int it = blockIdx.x; it < NITEMS; it += gridDim.x) {
    if (it < N_ADA) {
      const int l = it / 144, r = it % 144, cb = r / 8, ks = r % 8;
      __syncthreads();
      for (int e = tid; e < 16 * 128; e += 512) { const int b = e >> 7, k = e & 127; const float v = p.c[b * DM + ks * 128 + k]; tile[e] = v / (1.f + __expf(-v)); }
      __syncthreads();
      const int j = cb * 512 + tid;
      const float* w = p.ada_w + (size_t)l * DM * MODW + (size_t)(ks * 128) * MODW + j;
      float acc[16];
#pragma unroll
      for (int b = 0; b < 16; ++b) acc[b] = 0.f;
#pragma unroll 1
      for (int k0 = 0; k0 < 128; k0 += 16) { float wv[16];
#pragma unroll
        for (int kk = 0; kk < 16; ++kk) wv[kk] = w[(size_t)(k0 + kk) * MODW];
#pragma unroll
        for (int kk = 0; kk < 16; ++kk)
#pragma unroll
          for (int b = 0; b < 16; ++b) acc[b] += tile[b * 128 + k0 + kk] * wv[kk]; }
      float* dstp = (float*)(p.ws + WS_ADAP) + ((size_t)(ks * DEPTH + l) * 16) * MODW + j;
#pragma unroll
      for (int b = 0; b < 16; ++b) dstp[(size_t)b * MODW] = acc[b];
      __syncthreads();
      continue;
    }
    int r = it - N_ADA; const int l = r / T_LAYER; r -= l * T_LAYER;
    unsigned char* wl = p.ws + WS_W + (size_t)l * WL_STRIDE;
    if (r < 2 * T_GU) {
      const int f = r / T_GU; r -= f * T_GU; const int nt = r / 16, kt = r % 16, n0 = nt * 64;
      const int pn = n0 >> 8, bj = (n0 >> 7) & 1, i0 = n0 & 127, scol0 = bj * DFF + pn * 128 + i0 - n0;
      const float* W = (f ? p.ffn2_gu : p.ffn1_gu) + (size_t)l * DM * NGU;
      cvt_tile([=](int k, int n) { return W[(size_t)k * NGU + n + scol0]; }, (bf16_t*)(wl + (f ? WO_GU2 : WO_GU1)), DM, n0, kt * 64, tile);
      continue;
    }
    r -= 2 * T_GU;
    if (r < 2 * T_D) {
      const int f = r / T_D; r -= f * T_D; const int nt = r / 44, kt = r % 44;
      const float* W = (f ? p.ffn2_down : p.ffn1_down) + (size_t)l * DFF * DM;
      cvt_tile([=](int k, int n) { return W[(size_t)k * DM + n]; }, (bf16_t*)(wl + (f ? WO_D2 : WO_D1)), DFF, nt * 64, kt * 64, tile);
      continue;
    }
    r -= 2 * T_D;
    if (r < T_IN) {
      const int nt = r / 16, kt = r % 16;
      const float* W = p.w_in + (size_t)l * DM * INW;
      cvt_tile([=](int k, int n) { return n < INW ? W[(size_t)k * INW + n] : 0.f; }, (bf16_t*)(wl + WO_IN), DM, nt * 64, kt * 64, tile);
      continue;
    }
    r -= T_IN;
    if (r < T_MLA) {
      const int nt = r / 6, kt = r % 6;
      const float* Wq = p.w_uq + (size_t)l * 256 * 480; const float* Wkv = p.w_ukv + (size_t)l * 128 * 640;
      cvt_tile([=](int k, int n) { float v = 0.f; if (n < 480) { if (k < 256) v = Wq[(size_t)k * 480 + n]; } else if (n < 1120) { if (k >= 256) v = Wkv[(size_t)(k - 256) * 640 + (n - 480)]; } return v; },
               (bf16_t*)(wl + WO_MLA), MLA_K, nt * 64, kt * 64, tile);
      continue;
    }
    r -= T_MLA;
    { const int nt = r / 16, kt = r % 16;
      const float* W = p.w_out + (size_t)l * DM * DM;
      cvt_tile([=](int k, int n) { return W[(size_t)k * DM + n]; }, (bf16_t*)(wl + WO_OUT), DM, nt * 64, kt * 64, tile); }
  }
}
__device__ __forceinline__ void phase_mod_reduce(const Params& p) {
  float* mod = (float*)(p.ws + WS_MOD); const float* part = (const float*)(p.ws + WS_ADAP);
  constexpr int TOT = DEPTH * 16 * MODW;
  for (int e = blockIdx.x * 512 + otid(); e < TOT; e += gridDim.x * 512) {
    const int l = e / (16 * MODW), j = e % MODW;
    float s = p.ada_b[l * MODW + j];
#pragma unroll
    for (int ks = 0; ks < 8; ++ks) s += part[(size_t)ks * TOT + e];
    mod[e] = s;
  }
}

__device__ __forceinline__ void phase_norm(const float* src, const float* gain, const float* shift, const float* scale, bf16_t* dst) {
  const int tid_ = otid(), lane = tid_ & 63, gw = blockIdx.x * 8 + (tid_ >> 6), NGW = gridDim.x * 8;
  for (int m = gw; m < MTOK; m += NGW) {
    const f32x4* xr = (const f32x4*)(src + (size_t)m * DM) + lane;
    f32x4 v[4]; float s = 0.f;
#pragma unroll
    for (int j = 0; j < 4; ++j) { v[j] = xr[64 * j]; s += (v[j].x * v[j].x + v[j].y * v[j].y) + (v[j].z * v[j].z + v[j].w * v[j].w); }
    const float rs = 1.f / sqrtf(wave_sum(s) * (1.f / DM) + RMS_EPS);
    const int b = m / SEQ;
    const f32x4* gp = (const f32x4*)gain + lane; const f32x4* shp = (const f32x4*)(shift + (size_t)b * MODW) + lane; const f32x4* scp = (const f32x4*)(scale + (size_t)b * MODW) + lane;
    u64* o8 = (u64*)(dst + (size_t)m * DM) + lane;
#pragma unroll
    for (int j = 0; j < 4; ++j) { const f32x4 g = gp[64 * j], sh = shp[64 * j], sc = scp[64 * j];
      const f32x4 y = (v[j] * rs) * g * (sc + 1.f) + sh;
      o8[64 * j] = (u64)cvt_pk_bf16(y.x, y.y) | ((u64)cvt_pk_bf16(y.z, y.w) << 32); }
  }
}
__device__ __forceinline__ void phase_final_norm(float* h, const float* gain) {
  const int tid_ = otid(), lane = tid_ & 63, gw = blockIdx.x * 8 + (tid_ >> 6), NGW = gridDim.x * 8;
  for (int m = gw; m < MTOK; m += NGW) {
    f32x4* xr = (f32x4*)(h + (size_t)m * DM) + lane;
    f32x4 v[4]; float s = 0.f;
#pragma unroll
    for (int j = 0; j < 4; ++j) { v[j] = xr[64 * j]; s += (v[j].x * v[j].x + v[j].y * v[j].y) + (v[j].z * v[j].z + v[j].w * v[j].w); }
    const float rs = 1.f / sqrtf(wave_sum(s) * (1.f / DM) + RMS_EPS);
    const f32x4* gp = (const f32x4*)gain + lane;
#pragma unroll
    for (int j = 0; j < 4; ++j) xr[64 * j] = (v[j] * rs) * gp[64 * j];
  }
}

__device__ __forceinline__ void phase_cvec(const Params& p) {
  const int tid_ = otid(), lane = tid_ & 63, fr = lane & 15, fq = lane >> 4, gw = blockIdx.x * 8 + (tid_ >> 6), NGW = gridDim.x * 8;
  constexpr int G_GU = NGU / 16, G_IN = INWP / 16, G_L = 2 * G_GU + G_IN;
  for (int it = gw; it < DEPTH * G_L; it += NGW) {
    const int l = it / G_L; int r = it % G_L; int g, ncols; size_t wo;
    if (r < G_GU) { g = 0; wo = WO_GU1; ncols = NGU; } else if (r < G_GU + G_IN) { r -= G_GU; g = 1; wo = WO_IN; ncols = INWP; } else { r -= G_GU + G_IN; g = 2; wo = WO_GU2; ncols = NGU; }
    const bf16_t* wt = (const bf16_t*)(p.ws + WS_W + (size_t)l * WL_STRIDE + wo) + (size_t)(r * 16 + fr) * DM + fq * 8;
    const float* sh = (const float*)(p.ws + WS_MOD) + ((size_t)l * 16 + fr) * MODW + (g * 3) * DM + fq * 8;
    f32x4 acc = (f32x4){0.f, 0.f, 0.f, 0.f};
#pragma unroll 4
    for (int s = 0; s < 32; ++s) {
      const bf16x8 wf = *(const bf16x8*)(wt + s * 32);
      const f32x4 a0 = *(const f32x4*)(sh + s * 32), a1 = *(const f32x4*)(sh + s * 32 + 4);
      u32x4 w; w.x = cvt_pk_bf16(a0[0], a0[1]); w.y = cvt_pk_bf16(a0[2], a0[3]); w.z = cvt_pk_bf16(a1[0], a1[1]); w.w = cvt_pk_bf16(a1[2], a1[3]);
      acc = __builtin_amdgcn_mfma_f32_16x16x32_bf16(wf, __builtin_bit_cast(bf16x8, w), acc, 0, 0, 0);
    }
    float* cvp = (float*)(p.ws + WS_CV) + ((size_t)(l * 3 + g) * 16 + fr) * 5632 + r * 16 + fq * 4;
    *(f32x4*)cvp = acc;
  }
}
__device__ __forceinline__ void phase_norm0(const float* src, const float* gain, const float* scale, bf16_t* dst, float* ssq) {
  const int tid_ = otid(), lane = tid_ & 63, gw = blockIdx.x * 8 + (tid_ >> 6), NGW = gridDim.x * 8;
  for (int m = gw; m < MTOK; m += NGW) {
    const f32x4* xr = (const f32x4*)(src + (size_t)m * DM) + lane;
    f32x4 v[4]; float s = 0.f;
#pragma unroll
    for (int j = 0; j < 4; ++j) { v[j] = xr[64 * j]; s += (v[j].x * v[j].x + v[j].y * v[j].y) + (v[j].z * v[j].z + v[j].w * v[j].w); }
    s = wave_sum(s);
    const int b = m / SEQ;
    const f32x4* gp = (const f32x4*)gain + lane; const f32x4* scp = (const f32x4*)(scale + (size_t)b * MODW) + lane;
    u64* o8 = (u64*)(dst + (size_t)m * DM) + lane;
#pragma unroll
    for (int j = 0; j < 4; ++j) { const f32x4 y = v[j] * gp[64 * j] * (scp[64 * j] + 1.f);
      o8[64 * j] = (u64)cvt_pk_bf16(y.x, y.y) | ((u64)cvt_pk_bf16(y.z, y.w) << 32); }
    if (lane == 0) *(f32x4*)(ssq + (size_t)m * 4) = (f32x4){s, 0.f, 0.f, 0.f};
  }
}

__device__ __forceinline__ float sumsq8(u32x4 w) { float a = 0.f;
  a += bflo(w.x) * bflo(w.x); a += bfhi(w.x) * bfhi(w.x); a += bflo(w.y) * bflo(w.y); a += bfhi(w.y) * bfhi(w.y);
  a += bflo(w.z) * bflo(w.z); a += bfhi(w.z) * bfhi(w.z); a += bflo(w.w) * bflo(w.w); a += bfhi(w.w) * bfhi(w.w); return a; }
__device__ __forceinline__ float group8_sum(float v) { v += __shfl_xor(v, 1); v += __shfl_xor(v, 2); v += __shfl_xor(v, 4); return v; }
constexpr size_t WS_KMAX = WS_BAR + 14336;
__device__ __forceinline__ void phase_prep(const Params& p, int l) {
  const int tid_ = otid(), lane = tid_ & 63, gw = blockIdx.x * 8 + (tid_ >> 6), NGW = gridDim.x * 8;
  bf16_t* proj = (bf16_t*)(p.ws + WS_BIG); bf16_t* mlaa = (bf16_t*)(p.ws + WS_MLAA); bf16_t* krope = (bf16_t*)(p.ws + WS_KROPE); bf16_t* ikn = (bf16_t*)(p.ws + WS_IKN);
  const float* qn = p.q_norm + l * 256; const float* kvn = p.kv_norm + l * 128; const float* ikg = p.ik_norm + l * 64;
  const float inv = rope_inv(lane & 15);
  unsigned* kmaxp = (unsigned*)(p.ws + WS_KMAX) + l * 256;
  for (int base = gw * 16; base < MTOK; base += NGW * 16) {
   float kA = 0.f, kC = 0.f;
   for (int ti = 0; ti < 16; ++ti) {
    const int m = base + ti;
    bf16_t* pr = proj + (size_t)m * INWP;
    float sn, cs; sincos_big((float)p.pos[m] * inv, sn, cs);
    {
      const u32x4 wa = *(const u32x4*)(pr + OFF_KA + (lane < 48 ? lane : 0) * 8), wc = *(const u32x4*)(pr + OFF_KC + (lane < 40 ? lane : 0) * 8);
      kA = fmaxf(kA, group8_sum(sumsq8(wa))); kC = fmaxf(kC, group8_sum(sumsq8(wc))); }
    {
      const u32x2 w = *(const u32x2*)(pr + OFF_CQ + 4 * lane);
      const float a0 = bflo(w.x), a1 = bfhi(w.x), a2 = bflo(w.y), a3 = bfhi(w.y);
      const float rs = 1.f / sqrtf(wave_sum(a0 * a0 + a1 * a1 + a2 * a2 + a3 * a3) * (1.f / 256) + RMS_EPS);
      const f32x4 g = *(const f32x4*)(qn + 4 * lane);
      u32x2 o; o.x = cvt_pk_bf16(a0 * rs * g.x, a1 * rs * g.y); o.y = cvt_pk_bf16(a2 * rs * g.z, a3 * rs * g.w);
      *(u32x2*)(mlaa + (size_t)m * MLA_K + 4 * lane) = o; }
    {
      const unsigned w = *(const unsigned*)(pr + OFF_CKV + 2 * lane);
      const float a0 = bflo(w), a1 = bfhi(w);
      const float rs = 1.f / sqrtf(wave_sum(a0 * a0 + a1 * a1) * (1.f / 128) + RMS_EPS);
      const f32x2 g = *(const f32x2*)(kvn + 2 * lane);
      *(unsigned*)(mlaa + (size_t)m * MLA_K + 256 + 2 * lane) = cvt_pk_bf16(a0 * rs * g.x, a1 * rs * g.y); }
    if (lane < 16) {
      const float x1 = bf2f(pr[OFF_KR + lane]), x2 = bf2f(pr[OFF_KR + 16 + lane]);
      krope[(size_t)m * 32 + lane] = f2bf(x1 * cs - x2 * sn); krope[(size_t)m * 32 + 16 + lane] = f2bf(x2 * cs + x1 * sn); }
#pragma unroll
    for (int j = 0; j < 2; ++j) {
      const int pp = lane + 64 * j, hd = pp >> 4, i = pp & 15; bf16_t* q = pr + OFF_IQ + hd * 64;
      const float x1 = bf2f(q[i]), x2 = bf2f(q[16 + i]);
      q[i] = f2bf(x1 * cs - x2 * sn); q[16 + i] = f2bf(x2 * cs + x1 * sn); }
    {
      const float a = bf2f(pr[OFF_IK + lane]);
      const float rs = 1.f / sqrtf(wave_sum(a * a) * (1.f / 64) + RMS_EPS);
      const float y = a * rs * ikg[lane];
      const float pa = __shfl_xor(y, 16);
      float o = y;
      if (lane < 16) o = y * cs - pa * sn; else if (lane < 32) o = y * cs + pa * sn;
      ikn[(size_t)m * 64 + lane] = f2bf(o); }
   }
   const int bb = base / SEQ;
   if ((lane & 7) == 0) {
     if (lane < 48) __hip_atomic_fetch_max(kmaxp + bb * 16 + (lane >> 3), __builtin_bit_cast(unsigned, kA), __ATOMIC_RELAXED, __HIP_MEMORY_SCOPE_AGENT);
     if (lane < 40) __hip_atomic_fetch_max(kmaxp + bb * 16 + 11 + (lane >> 3), __builtin_bit_cast(unsigned, kC), __ATOMIC_RELAXED, __HIP_MEMORY_SCOPE_AGENT);
   }
  }
}
__device__ __forceinline__ void phase_qrope(const Params& p, int l) {
  const int tid_ = otid(), lane = tid_ & 63, gw = blockIdx.x * 8 + (tid_ >> 6), NGW = gridDim.x * 8;
  bf16_t* mlao = (bf16_t*)(p.ws + WS_MLAO); const bf16_t* krope = (const bf16_t*)(p.ws + WS_KROPE);
  unsigned* kmaxp = (unsigned*)(p.ws + WS_KMAX) + l * 256;
  const float inv = rope_inv(lane & 15);
  for (int base = gw * 16; base < MTOK; base += NGW * 16) {
   float kM = 0.f;
   for (int ti = 0; ti < 16; ++ti) {
    const int m = base + ti;
    float sn, cs; sincos_big((float)p.pos[m] * inv, sn, cs);
    {
      const int ll = lane < 40 ? lane : 0;
      const u32x4 wn = *(const u32x4*)(mlao + (size_t)m * MLA_N + 480 + (ll >> 3) * 128 + (ll & 7) * 8), wr = *(const u32x4*)(krope + (size_t)m * 32 + (lane & 3) * 8);
      float r2 = sumsq8(wr); r2 += __shfl_xor(r2, 1); r2 += __shfl_xor(r2, 2);
      kM = fmaxf(kM, group8_sum(sumsq8(wn)) + r2); }
#pragma unroll
    for (int j = 0; j < 2; ++j) { const int pp = lane + 64 * j;
      if (pp < 80) { const int hd = pp >> 4, i = pp & 15; bf16_t* q = mlao + (size_t)m * MLA_N + hd * 96 + 64;
        const float x1 = bf2f(q[i]), x2 = bf2f(q[16 + i]);
        q[i] = f2bf(x1 * cs - x2 * sn); q[16 + i] = f2bf(x2 * cs + x1 * sn); } }
   }
   const int bb = base / SEQ;
   if ((lane & 7) == 0 && lane < 40) __hip_atomic_fetch_max(kmaxp + bb * 16 + 6 + (lane >> 3), __builtin_bit_cast(unsigned, kM), __ATOMIC_RELAXED, __HIP_MEMORY_SCOPE_AGENT);
  }
}

constexpr int SC_STRIDE = 2117;
__device__ __forceinline__ int wave_count(int c) { int t = 0;
#pragma unroll
  for (int b = 0; b < 6; ++b) t += (int)__popcll(__ballot((c >> b) & 1)) << b;
  return t; }
__device__ __forceinline__ unsigned fkey(float v) { const unsigned u = __builtin_bit_cast(unsigned, v + 0.0f); return (u & 0x80000000u) ? ~u : (u | 0x80000000u); }
#define DEF_WCOUNT(NAME, OP) \
__device__ __forceinline__ int NAME(const unsigned (&key)[32], unsigned thr) { \
  int cnt = 0; const unsigned m = __builtin_amdgcn_readfirstlane(thr); \
  _Pragma("unroll") for (int j = 0; j < 32; j += 4) { u64 a, b, c, d; int ta, tb, tc, td; \
    asm volatile("v_cmp_" OP "_u32 %[a], %[k0], %[m]\n\tv_cmp_" OP "_u32 %[b], %[k1], %[m]\n\tv_cmp_" OP "_u32 %[c], %[k2], %[m]\n\tv_cmp_" OP "_u32 %[d], %[k3], %[m]\n\t" \
                 "s_bcnt1_i32_b64 %[ta], %[a]\n\ts_bcnt1_i32_b64 %[tb], %[b]\n\ts_bcnt1_i32_b64 %[tc], %[c]\n\ts_bcnt1_i32_b64 %[td], %[d]\n\t" \
                 "s_add_i32 %[ta], %[ta], %[tb]\n\ts_add_i32 %[tc], %[tc], %[td]\n\ts_add_i32 %[cnt], %[cnt], %[ta]\n\ts_add_i32 %[cnt], %[cnt], %[tc]" \
      : [cnt] "+s"(cnt), [a] "=&s"(a), [b] "=&s"(b), [c] "=&s"(c), [d] "=&s"(d), [ta] "=&s"(ta), [tb] "=&s"(tb), [tc] "=&s"(tc), [td] "=&s"(td) \
      : [k0] "v"(key[j]), [k1] "v"(key[j + 1]), [k2] "v"(key[j + 2]), [k3] "v"(key[j + 3]), [m] "s"(m) : "scc"); } \
  return cnt; }
DEF_WCOUNT(wcount_ge, "ge")
DEF_WCOUNT(wcount_gt, "gt")
DEF_WCOUNT(wcount_eq, "eq")
__device__ __forceinline__ float unfkey(unsigned k) { const unsigned u = (k & 0x80000000u) ? (k & 0x7fffffffu) : ~k; return __builtin_bit_cast(float, u); }
__device__ __forceinline__ void phase_indexer(const Params& p, unsigned char* lds) {
  float* sc = (float*)lds;
  const int tid = otid(), lane = tid & 63, wave = __builtin_amdgcn_readfirstlane(tid >> 6), fr = lane & 15, fq = lane >> 4;
  const bf16_t* proj = (const bf16_t*)(p.ws + WS_BIG); const bf16_t* ikn = (const bf16_t*)(p.ws + WS_IKN); u64* mask = (u64*)(p.ws + WS_MASK);
  constexpr int NITEMS = BATCH * (SEQ / 16);
  for (int it = blockIdx.x; it < NITEMS; it += gridDim.x) {
    const int b = it % BATCH, qg = (SEQ / 16 - 1) - it / BATCH, t0 = qg * 16;
    const size_t rowb = (size_t)b * SEQ;
    if (t0 + 16 <= 256) {
      if (lane < 32) { mask[(rowb + t0 + 2 * wave) * 32 + lane] = ~0ull; mask[(rowb + t0 + 2 * wave + 1) * 32 + lane] = ~0ull; }
      continue;
    }
    __syncthreads();
    {
      const bf16_t* qrow = proj + (rowb + t0 + fr) * INWP;
      bf16x8 qf[8][2];
#pragma unroll
      for (int h = 0; h < 8; ++h)
#pragma unroll
        for (int s = 0; s < 2; ++s) qf[h][s] = *(const bf16x8*)(qrow + OFF_IQ + h * 64 + s * 32 + fq * 8);
      float wq[8];
      { const u32x4 w = *(const u32x4*)(qrow + OFF_IW); const float cw = 0.04419417382415922f;
        wq[0] = bflo(w.x) * cw; wq[1] = bfhi(w.x) * cw; wq[2] = bflo(w.y) * cw; wq[3] = bfhi(w.y) * cw; wq[4] = bflo(w.z) * cw; wq[5] = bfhi(w.z) * cw; wq[6] = bflo(w.w) * cw; wq[7] = bfhi(w.w) * cw; }
      const int nkt = qg + 1;
      bf16x8 ka[4][2], kb[4][2];
#define IDX_LOAD(X, base) do { _Pragma("unroll") for (int g = 0; g < 4; ++g) { int kk = (base) + 8 * g; kk = (kk < nkt) ? kk : 0; \
          const bf16_t* krow = ikn + (rowb + kk * 16 + fr) * 64 + fq * 8; X[g][0] = *(const bf16x8*)krow; X[g][1] = *(const bf16x8*)(krow + 32); } } while (0)
#define IDX_COMP(X, base) do { _Pragma("unroll") for (int g = 0; g < 4; ++g) { const int kk = (base) + 8 * g; if (kk < nkt) { \
          f32x4 a[8]; \
          _Pragma("unroll") for (int h = 0; h < 8; ++h) a[h] = __builtin_amdgcn_mfma_f32_16x16x32_bf16(X[g][0], qf[h][0], (f32x4){0.f, 0.f, 0.f, 0.f}, 0, 0, 0); \
          _Pragma("unroll") for (int h = 0; h < 8; ++h) a[h] = __builtin_amdgcn_mfma_f32_16x16x32_bf16(X[g][1], qf[h][1], a[h], 0, 0, 0); \
          f32x4 s4 = (f32x4){0.f, 0.f, 0.f, 0.f}; \
          _Pragma("unroll") for (int h = 0; h < 8; ++h) _Pragma("unroll") for (int jj = 0; jj < 4; ++jj) s4[jj] = __builtin_fmaf(wq[h], __builtin_amdgcn_fmed3f(a[h][jj], 0.f, __builtin_inff()), s4[jj]); \
          const int c0 = kk * 16 + fq * 4; float* dp = sc + fr * SC_STRIDE + c0 + (c0 >> 5); dp[0] = s4[0]; dp[1] = s4[1]; dp[2] = s4[2]; dp[3] = s4[3]; } } } while (0)
      int kt = wave;
      IDX_LOAD(ka, kt);
#pragma unroll 1
      while (kt < nkt) {
        IDX_LOAD(kb, kt + 32);
        IDX_COMP(ka, kt);
        kt += 32;
        if (kt >= nkt) break;
        IDX_LOAD(ka, kt + 32);
        IDX_COMP(kb, kt);
        kt += 32;
      }
#undef IDX_LOAD
#undef IDX_COMP
    }
    __syncthreads();
    for (int rr = 0; rr < 2; ++rr) {
      const int r = 2 * wave + rr, t = t0 + r;
      unsigned key[32];
      float kv[32];
#pragma unroll
      for (int j = 0; j < 32; ++j) kv[j] = sc[r * SC_STRIDE + lane * 33 + j];
#pragma unroll
      for (int j = 0; j < 32; ++j) asm volatile("" : "+v"(kv[j]));
#pragma unroll
      for (int j = 0; j < 32; ++j) { const int idx = lane * 32 + j; key[j] = (idx <= t) ? fkey(kv[j]) : 0u; }
      unsigned kmx = 0u, kmn = 0xffffffffu;
#pragma unroll
      for (int j = 0; j < 32; ++j) { kmx = max(kmx, key[j]); kmn = min(kmn, key[j] ? key[j] : 0xffffffffu); }
#pragma unroll
      for (int o = 1; o < 64; o <<= 1) { kmx = max(kmx, (unsigned)__shfl_xor((int)kmx, o)); kmn = min(kmn, (unsigned)__shfl_xor((int)kmn, o)); }
      unsigned lo = kmn, hi = kmx + 1u; int clo = t + 1, chi = 0;
#pragma unroll 1
      for (int itn = 0; itn < 128; ++itn) {
        if (clo == 256 || hi - lo <= 1u) break;
        unsigned mid;
        if (itn % 3 == 2) mid = lo + ((hi - lo) >> 1);
        else { const float flo = unfkey(lo), fhi = unfkey(hi - 1u); const int gap = clo - chi;
          const float off = (gap <= 8) ? 0.5f : fminf((float)gap * 0.125f, 16.f);
          const float tgt = 256.f + (((clo - 256) > (256 - chi)) ? off : -off);
          const float fm = flo + (fhi - flo) * (((float)clo - tgt) / (float)gap);
          mid = fkey(fm); }
        mid = max(lo + 1u, min(mid, hi - 1u));
        const int c = wcount_ge(key, mid);
        if (c >= 256) { lo = mid; clo = c; } else { hi = mid; chi = c; }
      }
      const unsigned T = lo;
      const int cgt = wcount_gt(key, T), ceq = wcount_eq(key, T);
      const int need = 256 - cgt;
      int cutoff = 4096;
      if (ceq > need) {
        int ceql = 0;
#pragma unroll
        for (int j = 0; j < 32; ++j) ceql += (key[j] == T) ? 1 : 0;
        int incl = ceql;
#pragma unroll
        for (int o = 1; o < 64; o <<= 1) { const int v = __shfl_up(incl, o); if (lane >= o) incl += v; }
        const int excl = incl - ceql;
        int mycut = 4096;
        if (excl < need && incl >= need) { int k = need - excl;
#pragma unroll
          for (int j = 0; j < 32; ++j) { if (key[j] == T) { --k; if (k == 0) mycut = lane * 32 + j; } } }
#pragma unroll
        for (int o = 1; o < 64; o <<= 1) mycut = min(mycut, __shfl_xor(mycut, o));
        cutoff = mycut;
      }
      unsigned W = 0u;
#pragma unroll
      for (int j = 0; j < 32; ++j) { const int idx = lane * 32 + j; W |= ((key[j] > T || (key[j] == T && idx <= cutoff)) ? 1u : 0u) << j; __builtin_amdgcn_sched_barrier(0); }
      ((unsigned*)mask)[(rowb + t) * 64 + lane] = W;
    }
  }
  __syncthreads();
}

constexpr int KROW = 208, VROW = 144;
constexpr int AT_BUF = 64 * KROW + 64 * VROW;
constexpr int AT_VOFF = 64 * KROW, AT_TAB = 2 * AT_BUF, TAB_PAD = 96, AT_END = AT_TAB + (2048 + TAB_PAD) * 4;
constexpr float LOG2E = 1.4426950408889634f;
__device__ __forceinline__ s16x4 vtr(const LAS unsigned char* ptr) { return __builtin_bit_cast(s16x4, __builtin_amdgcn_ds_read_tr16_b64_v4i16((LAS s16x4*)ptr)); }

template <int KS, int TYPE>
__device__ __forceinline__ void attn_item(const Params& p, unsigned char* lds, int b, int head, int qb, int l) {
  const int tid = otid(), lane = tid & 63, wave = __builtin_amdgcn_readfirstlane(tid >> 6), fr = lane & 15, fq = lane >> 4;
  const bf16_t* proj = (const bf16_t*)(p.ws + WS_BIG); const bf16_t* mlao = (const bf16_t*)(p.ws + WS_MLAO);
  const bf16_t* Qp; const bf16_t* Kp; const bf16_t* Vp; int qpitch, kpitch; float c2;
  const size_t rowb = (size_t)b * SEQ;
  if (TYPE == 0) { Qp = proj + OFF_QA + head * 64; Kp = proj + OFF_KA + head * 64; Vp = proj + OFF_VA + head * 64; qpitch = kpitch = INWP; c2 = 0.125f * LOG2E; }
  else if (TYPE == 1) { const int hb = head - 6; Qp = mlao + hb * 96; Kp = mlao + 480 + hb * 128; Vp = Kp + 64; qpitch = kpitch = MLA_N; c2 = 0.10206207261596575f * LOG2E; }
  else { const int hc = head - 11; Qp = proj + OFF_QC + hc * 64; Kp = proj + OFF_KC + hc * 64; Vp = proj + OFF_VC + hc * 64; qpitch = kpitch = INWP; c2 = 0.125f * LOG2E; }
  const bf16_t* K2p = (const bf16_t*)(p.ws + WS_KROPE);
  const u64* mask = (const u64*)(p.ws + WS_MASK);
  float* tab = (float*)(lds + AT_TAB);
  LAS unsigned char* l3 = (LAS unsigned char*)lds;

  __syncthreads();
  if (TYPE != 1) {
    const int col = (TYPE == 0) ? head : (head - 11 + 6);
    for (int e = tid; e < 2048 + TAB_PAD; e += 512) {
      const int d = e - TAB_PAD; float v = NEGV;
      if (d >= 0) { v = p.rel_bias[t5_bucket(d) * 11 + col];
        if (TYPE == 0) { const int mult = (d <= 128) + ((d & 3) == 0 && d <= 512) + ((d & 15) == 0);
          v = (mult == 0) ? NEGV : v + (mult == 1 ? 0.f : (mult == 2 ? 0.6931471805599453f : 1.0986122886681098f)); }
        v = (v <= -1e29f) ? NEGV : v * LOG2E; }
      tab[e] = v;
    }
  }
  const int q0 = qb * 256 + wave * 32;
  bf16x8 qf[2][KS];
#pragma unroll
  for (int u = 0; u < 2; ++u)
#pragma unroll
    for (int s = 0; s < KS; ++s) qf[u][s] = *(const bf16x8*)(Qp + (rowb + q0 + u * 16 + fr) * qpitch + s * 32 + fq * 8);
  float tabmax = 0.f;
  if (TYPE != 1) { const int col = (TYPE == 0) ? head : (head - 11 + 6);
    float tv = p.rel_bias[(lane & 31) * 11 + col];
#pragma unroll
    for (int o_ = 1; o_ < 32; o_ <<= 1) tv = fmaxf(tv, __shfl_xor(tv, o_));
    tabmax = tv * LOG2E + (TYPE == 0 ? 1.5849625007211563f : 0.f); }
  const float kmax = sqrtf(__builtin_bit_cast(float, ((const unsigned*)(p.ws + WS_KMAX))[l * 256 + b * 16 + head]));
  f32x4 o[4][2]; float sinit[2], lrow[2];
#pragma unroll
  for (int u = 0; u < 2; ++u) {
    float q2 = 0.f;
#pragma unroll
    for (int s_ = 0; s_ < KS; ++s_) q2 += sumsq8(__builtin_bit_cast(u32x4, qf[u][s_]));
    q2 += __shfl_xor(q2, 16); q2 += __shfl_xor(q2, 32);
    sinit[u] = -(sqrtf(q2) * kmax * 1.0001f + tabmax / c2 + 1e-3f);
    lrow[u] = 0.f;
#pragma unroll
    for (int dt = 0; dt < 4; ++dt) o[dt][u] = (f32x4){0.f, 0.f, 0.f, 0.f}; }

  const int nkt = (qb + 1) * 4;
  const int lkey = tid >> 3, lch = tid & 7;
  u32x4 kreg, vreg, k2reg; u64 mreg[2] = {0ull, 0ull};
#define AT_PREFETCH(kt_) do { const size_t r_ = rowb + (kt_) * 64 + lkey; \
    kreg = *(const u32x4*)(Kp + r_ * kpitch + lch * 8); vreg = *(const u32x4*)(Vp + r_ * kpitch + lch * 8); \
    if (KS == 3) { if (tid < 256) k2reg = *(const u32x4*)(K2p + (rowb + (kt_) * 64 + (tid >> 2)) * 32 + (tid & 3) * 8); } \
    if (TYPE == 2) { mreg[0] = mask[(rowb + q0 + fr) * 32 + (kt_)]; mreg[1] = mask[(rowb + q0 + 16 + fr) * 32 + (kt_)]; } } while (0)
#define AT_STORE(bufo_) do { *(u32x4*)(lds + (bufo_) + lkey * KROW + lch * 16) = kreg; *(u32x4*)(lds + (bufo_) + AT_VOFF + lkey * VROW + lch * 16) = vreg; \
    if (KS == 3) { if (tid < 256) *(u32x4*)(lds + (bufo_) + (tid >> 2) * KROW + 128 + (tid & 3) * 16) = k2reg; } } while (0)
  AT_PREFETCH(0);
  AT_STORE(0);
  __syncthreads();
  float tvfar[4] = {0.f, 0.f, 0.f, 0.f};
  if (TYPE != 1) { const float bfar = tab[TAB_PAD + (TYPE == 0 ? 2032 : 2047)];
#pragma unroll
    for (int j = 0; j < 4; ++j) tvfar[j] = (TYPE == 2 || ((fr - 4 * fq - j) & 15) == 0) ? bfar : NEGV; }
#pragma unroll 1
  for (int kt = 0; kt < nkt; ++kt) {
    const int bufo = (kt & 1) * AT_BUF;
    const u64 mcur0 = mreg[0], mcur1 = mreg[1];
    if (kt + 1 < nkt) AT_PREFETCH(kt + 1);
    const int kbase = kt * 64;
    if (kbase <= q0 + 31) {
      bf16x8 kf[4][KS];
#pragma unroll
      for (int k16 = 0; k16 < 4; ++k16)
#pragma unroll
        for (int ss = 0; ss < KS; ++ss) kf[k16][ss] = *(const LAS bf16x8*)(l3 + bufo + (k16 * 16 + fr) * KROW + ss * 64 + fq * 16);
      float tv[2][16];
      if (TYPE != 1) {
        if (q0 - kbase - 63 >= (TYPE == 0 ? 513 : 113)) {
#pragma unroll
          for (int u = 0; u < 2; ++u)
#pragma unroll
            for (int k16 = 0; k16 < 4; ++k16)
#pragma unroll
              for (int j = 0; j < 4; ++j) tv[u][k16 * 4 + j] = tvfar[j];
        } else {
#pragma unroll
          for (int u = 0; u < 2; ++u) { const float* tp = tab + (q0 + u * 16 + fr - kbase + TAB_PAD - fq * 4);
#pragma unroll
            for (int k16 = 0; k16 < 4; ++k16)
#pragma unroll
              for (int j = 0; j < 4; ++j) tv[u][k16 * 4 + j] = tp[-(k16 * 16 + j)]; }
        }
      }
      __builtin_amdgcn_sched_barrier(0);
      f32x4 s[4][2];
#pragma unroll
      for (int k16 = 0; k16 < 4; ++k16) {
        s[k16][0] = (f32x4){sinit[0], sinit[0], sinit[0], sinit[0]}; s[k16][1] = (f32x4){sinit[1], sinit[1], sinit[1], sinit[1]};
#pragma unroll
        for (int ss = 0; ss < KS; ++ss) {
          s[k16][0] = __builtin_amdgcn_mfma_f32_16x16x32_bf16(kf[k16][ss], qf[0][ss], s[k16][0], 0, 0, 0);
          s[k16][1] = __builtin_amdgcn_mfma_f32_16x16x32_bf16(kf[k16][ss], qf[1][ss], s[k16][1], 0, 0, 0);
        }
      }
      __builtin_amdgcn_sched_barrier(0);
      s16x4 vv[2][4][2];
#pragma unroll
      for (int kc = 0; kc < 2; ++kc)
#pragma unroll
        for (int dt = 0; dt < 4; ++dt) {
          const LAS unsigned char* vb = l3 + bufo + AT_VOFF + (kc * 32 + 4 * fq + (fr >> 2)) * VROW + (dt * 16 + 4 * (fr & 3)) * 2;
          vv[kc][dt][0] = vtr(vb); vv[kc][dt][1] = vtr(vb + 16 * VROW);
        }
      __builtin_amdgcn_sched_barrier(0);
      const bool diag = (kbase + 63 > q0);
      bf16x8 pb[2][2];
#pragma unroll
      for (int u = 0; u < 2; ++u) {
        const int qpos = q0 + u * 16 + fr;
        unsigned wlo = 0u, whi = 0u;
        if (TYPE == 2) { const u64 mw = u ? mcur1 : mcur0; wlo = (unsigned)mw >> (fq * 4); whi = (unsigned)(mw >> 32) >> (fq * 4); }
        float ps = 0.f;
#pragma unroll
        for (int k16 = 0; k16 < 4; ++k16)
#pragma unroll
          for (int j = 0; j < 4; ++j) {
            float v;
            if (TYPE != 1) v = __builtin_fmaf(s[k16][u][j], c2, tv[u][k16 * 4 + j]);
            else { v = s[k16][u][j] * c2; if (diag) v = (kbase + k16 * 16 + fq * 4 + j > qpos) ? NEGV : v; }
            float e = __builtin_amdgcn_exp2f(v);
            if (TYPE == 2) { unsigned sel; asm("v_bfe_i32 %0, %1, %2, 1" : "=v"(sel) : "v"((k16 < 2) ? wlo : whi), "n"((k16 & 1) * 16 + j));
              e = __builtin_bit_cast(float, __builtin_bit_cast(unsigned, e) & sel); }
            s[k16][u][j] = e; ps += e;
          }
        lrow[u] += ps;
#pragma unroll
        for (int kc = 0; kc < 2; ++kc) {
          u32x4 w; w.x = cvt_pk_bf16(s[2 * kc][u][0], s[2 * kc][u][1]); w.y = cvt_pk_bf16(s[2 * kc][u][2], s[2 * kc][u][3]);
          w.z = cvt_pk_bf16(s[2 * kc + 1][u][0], s[2 * kc + 1][u][1]); w.w = cvt_pk_bf16(s[2 * kc + 1][u][2], s[2 * kc + 1][u][3]);
          pb[u][kc] = __builtin_bit_cast(bf16x8, w);
        }
      }
#pragma unroll
      for (int kc = 0; kc < 2; ++kc)
#pragma unroll
        for (int dt = 0; dt < 4; ++dt) {
          const bf16x8 vf = __builtin_shufflevector(vv[kc][dt][0], vv[kc][dt][1], 0, 1, 2, 3, 4, 5, 6, 7);
          o[dt][0] = __builtin_amdgcn_mfma_f32_16x16x32_bf16(vf, pb[0][kc], o[dt][0], 0, 0, 0);
          o[dt][1] = __builtin_amdgcn_mfma_f32_16x16x32_bf16(vf, pb[1][kc], o[dt][1], 0, 0, 0);
        }
    }
    if (kt + 1 < nkt) AT_STORE(AT_BUF - bufo);
    __syncthreads();
  }
#undef AT_PREFETCH
#undef AT_STORE
  bf16_t* outp = (bf16_t*)(p.ws + WS_NB);
#pragma unroll
  for (int u = 0; u < 2; ++u) {
    float l = lrow[u]; l += __shfl_xor(l, 16); l += __shfl_xor(l, 32);
    const float il = 1.f / l;
    bf16_t* orow = outp + (rowb + q0 + u * 16 + fr) * DM + head * 64 + fq * 4;
#pragma unroll
    for (int dt = 0; dt < 4; ++dt) { u32x2 w; w.x = cvt_pk_bf16(o[dt][u][0] * il, o[dt][u][1] * il); w.y = cvt_pk_bf16(o[dt][u][2] * il, o[dt][u][3] * il);
      *(u32x2*)(orow + dt * 16) = w; }
  }
}
__device__ __forceinline__ void phase_attn(const Params& p, unsigned char* lds, int l) {
  constexpr int NITEMS = BATCH * 16 * 8;
  for (int it = blockIdx.x; it < NITEMS; it += gridDim.x) {
    const int r = it >> 8, c = it & 255;
    const int qb = (r & 1) ? (r >> 1) : 7 - (r >> 1), b = c >> 4, head = ((c & 15) + 2 * r) & 15;
    if (head < 6) attn_item<2, 0>(p, lds, b, head, qb, l);
    else if (head < 11) attn_item<3, 1>(p, lds, b, head, qb, l);
    else attn_item<2, 2>(p, lds, b, head, qb, l);
  }
  __syncthreads();
}

#define XB_TMO      128
#define XB_XCNT(j)  (256  + 64 * (j))
#define XB_XSUB(j)  (1280 + 64 * (j))
#define XB_XGEN(j)  (2304 + 64 * (j))
#define XB_TOP      3328
#define XB_TOPGEN   3392
#define XCD_BAR_WORDS 3456
#define XB_SPIN_CAP (1u << 18)
__device__ __forceinline__ unsigned xb_ld(unsigned* p)              { return __hip_atomic_load(p, __ATOMIC_RELAXED, __HIP_MEMORY_SCOPE_AGENT); }
__device__ __forceinline__ unsigned xb_add(unsigned* p, unsigned v) { return __hip_atomic_fetch_add(p, v, __ATOMIC_RELAXED, __HIP_MEMORY_SCOPE_AGENT); }
__device__ __forceinline__ unsigned xb_xcc_id() { return (unsigned)__builtin_amdgcn_s_getreg((3 << 11) | 20) & 0xFu; }
#define XB_SPIN(cond, bar) do { unsigned _sp = 0; while (cond) { __builtin_amdgcn_s_sleep(1); \
    if ((++_sp & 255u) == 0u) { if (xb_ld(&(bar)[XB_TMO])) break; if (_sp > XB_SPIN_CAP) { atomicAdd(&(bar)[XB_TMO], 1u); break; } } } } while (0)
struct XcdBarrier { unsigned* bar; unsigned x; volatile LAS unsigned* st; };
__device__ __forceinline__ XcdBarrier xcd_barrier_post(unsigned* bar, volatile LAS unsigned* st) {
  XcdBarrier b; b.bar = bar; b.x = xb_xcc_id(); b.st = st;
  if (threadIdx.x == 0) (void)xb_add(&bar[XB_XCNT(b.x)], 1u);
  return b;
}
__device__ __forceinline__ void xcd_barrier_complete(unsigned* bar, unsigned x, unsigned& nloc, unsigned& nx) {
  const unsigned G = gridDim.x * gridDim.y * gridDim.z;
  unsigned sum, cnt, mine, sp = 0u;
  for (;;) {
    sum = 0u; cnt = 0u; mine = 0u;
#pragma unroll
    for (unsigned j = 0; j < 16; ++j) { const unsigned c = xb_ld(&bar[XB_XCNT(j)]); sum += c; cnt += (c > 0u) ? 1u : 0u; mine = (j == x) ? c : mine; }
    if (sum == G) break;
    __builtin_amdgcn_s_sleep(1);
    if ((++sp & 255u) == 0u) { if (xb_ld(&bar[XB_TMO])) break; if (sp > XB_SPIN_CAP) { atomicAdd(&bar[XB_TMO], 1u); break; } }
  }
  nloc = mine > 0u ? mine : 1u; nx = cnt > 0u ? cnt : 1u;
}
__device__ __forceinline__ void xcd_barrier(const XcdBarrier& b) {
  asm volatile("s_waitcnt vmcnt(0)" ::: "memory");
  __syncthreads();
  if (threadIdx.x == 0) {
    unsigned* bar = b.bar;
    __builtin_amdgcn_s_waitcnt(0);
    unsigned nloc = b.st[0], nx = b.st[1];
    if (nloc == 0u) { xcd_barrier_complete(bar, b.x, nloc, nx); b.st[0] = nloc; b.st[1] = nx; }
    const unsigned old = xb_add(&bar[XB_XSUB(b.x)], 1u);
    const unsigned gen = old / nloc;
    if (old + 1u == (gen + 1u) * nloc) {
      __builtin_amdgcn_fence(__ATOMIC_RELEASE, "agent");
      asm volatile("s_waitcnt vmcnt(0)" ::: "memory");
      const unsigned og = xb_add(&bar[XB_TOP], 1u);
      const unsigned tg = og / nx;
      if (og + 1u == (tg + 1u) * nx) xb_add(&bar[XB_TOPGEN], 1u);
      else XB_SPIN(xb_ld(&bar[XB_TOPGEN]) == tg, bar);
      __builtin_amdgcn_fence(__ATOMIC_ACQUIRE, "agent");
      xb_add(&bar[XB_XGEN(b.x)], 1u);
      asm volatile("s_waitcnt vmcnt(0)" ::: "memory");
    } else {
      XB_SPIN(xb_ld(&bar[XB_XGEN(b.x)]) == gen, bar);
      __builtin_amdgcn_fence(__ATOMIC_ACQUIRE, "agent");
      asm volatile("s_waitcnt vmcnt(0)" ::: "memory");
    }
  }
  __syncthreads();
}

#ifndef PHMASK
#define PHMASK 0xFFFFu
#endif
#ifndef DUPMASK
#define DUPMASK 0u
#endif
__global__ void __launch_bounds__(512) mega(Params p_unused) {
#if defined(__HIP_DEVICE_COMPILE__)
  extern __shared__ __attribute__((aligned(16))) unsigned char lds[];
  cg::grid_group grid = cg::this_grid();
  { volatile LAS unsigned* st = (volatile LAS unsigned*)((LAS unsigned char*)lds + (LDS_BYTES - 16)); if (threadIdx.x < 2) st[threadIdx.x] = 0u; }
  __syncthreads();
  XcdBarrier xbar = xcd_barrier_post((unsigned*)((*kparams()).ws + WS_BAR), (volatile LAS unsigned*)((LAS unsigned char*)lds + (LDS_BYTES - 16)));
  int nsteps = 3 + 10 * DEPTH + 1;
  asm volatile("" : "+s"(nsteps));
#pragma unroll 1
  for (int step = 0; step < nsteps; ++step) {
    const Params p = *kparams();
    if (step == 0) { phase0(p, lds); }
    else if (step == 1) { phase_mod_reduce(p); }
    else if (step == 2) { phase_cvec(p); phase_norm0(p.x, p.norm_ffn1, (const float*)(p.ws + WS_MOD) + 1 * DM, (bf16_t*)(p.ws + WS_NB), (float*)(p.ws + WS_SSQ)); }
    else if (step == nsteps - 1) { phase_final_norm(p.out, p.final_norm); }
    else {
      const int l = (step - 3) / 10, si = (step - 3) % 10, sub = si + 1 + (si >= 2) + (si >= 8);
      unsigned char* wl = p.ws + WS_W + (size_t)l * WL_STRIDE;
      const float* mod = (const float*)(p.ws + WS_MOD) + (size_t)l * 16 * MODW;
      const float* hin = (l == 0) ? p.x : p.out;
      bf16_t* NB = (bf16_t*)(p.ws + WS_NB); bf16_t* BIG = (bf16_t*)(p.ws + WS_BIG); bf16_t* HID2 = (bf16_t*)(p.ws + WS_BIG + 64 * MiB);
      float* ssq = (float*)(p.ws + WS_SSQ); const float* cvl = (const float*)(p.ws + WS_CV) + (size_t)l * 3 * CV_STRIDE;
      if (sub == 5) { phase_prep(p, l); }
      else if (sub == 7) { phase_qrope(p, l); phase_indexer(p, lds); }
      else if (sub == 8) { phase_attn(p, lds, l); }
      else {
        const bool isgu = (sub == 1 || sub == 11), isdn = (sub == 2 || sub == 12);
        const bf16_t* A = (sub == 2 || sub == 11) ? BIG : (sub == 12) ? HID2 : (sub == 6) ? (const bf16_t*)(p.ws + WS_MLAA) : NB;
        const size_t wo = (sub == 1) ? WO_GU1 : (sub == 11) ? WO_GU2 : (sub == 2) ? WO_D1 : (sub == 12) ? WO_D2 : (sub == 4) ? WO_IN : (sub == 6) ? WO_MLA : WO_OUT;
        const bf16_t* Bt = (const bf16_t*)(wl + wo);
        const int N = isgu ? NGU : (sub == 4) ? INWP : (sub == 6) ? MLA_N : DM, K = isdn ? DFF : (sub == 6) ? MLA_K : DM;
        pg8::EpiDyn E; E.sub = sub; E.l = l;
        run_gemm(lds, A, Bt, N, K, E);
      }
    }
    if (step == 0) grid.sync(); else xcd_barrier(xbar);
  }
#endif
}

extern "C" void kernel_launch(void* const* d_in, const int* in_sizes, int n_in, void* d_out, int out_size, void* d_ws, size_t ws_size, hipStream_t stream) {
  static int grid_blocks = 0;
  if (!grid_blocks) {
    int dev = 0, cus = 0, per_cu = 0;
    (void)hipGetDevice(&dev);
    (void)hipDeviceGetAttribute(&cus, hipDeviceAttributeMultiprocessorCount, dev);
    (void)hipFuncSetAttribute((const void*)mega, hipFuncAttributeMaxDynamicSharedMemorySize, LDS_BYTES);
    (void)hipOccupancyMaxActiveBlocksPerMultiprocessor(&per_cu, (const void*)mega, 512, LDS_BYTES);
    if (per_cu < 1) per_cu = 1;
    grid_blocks = cus * per_cu;
    if (ws_size < WS_END) fprintf(stderr, "kernel_launch: workspace too small: %zu < %zu\n", ws_size, (size_t)WS_END);
  }
  Params p{};
  p.x = (const float*)d_in[0]; p.c = (const float*)d_in[1]; p.pos = (const int*)d_in[2]; p.rel_bias = (const float*)d_in[3]; p.ada_w = (const float*)d_in[4]; p.ada_b = (const float*)d_in[5];
  p.norm_ffn1 = (const float*)d_in[6]; p.ffn1_gu = (const float*)d_in[7]; p.ffn1_down = (const float*)d_in[8]; p.norm_mix = (const float*)d_in[9]; p.w_in = (const float*)d_in[10];
  p.q_norm = (const float*)d_in[11]; p.w_uq = (const float*)d_in[12]; p.kv_norm = (const float*)d_in[13]; p.w_ukv = (const float*)d_in[14]; p.ik_norm = (const float*)d_in[15]; p.w_out = (const float*)d_in[16];
  p.norm_ffn2 = (const float*)d_in[17]; p.ffn2_gu = (const float*)d_in[18]; p.ffn2_down = (const float*)d_in[19]; p.final_norm = (const float*)d_in[20];
  p.out = (float*)d_out; p.ws = (unsigned char*)d_ws;
  (void)hipMemsetAsync((unsigned char*)d_ws + WS_BAR, 0, 16384, stream);
  void* args[] = {&p};
  hipError_t e = hipLaunchCooperativeKernel((void*)mega, dim3(grid_blocks), dim3(512), args, LDS_BYTES, stream);
  if (e != hipSuccess) fprintf(stderr, "cooperative launch failed: %s (grid %d)\n", hipGetErrorString(e), grid_blocks);
}
```

```cpp
#include <hip/hip_runtime.h>
#include <hip/hip_cooperative_groups.h>
#include <cstdio>
#include <cstdint>
namespace cg = cooperative_groups;

#define LAS __attribute__((address_space(3)))
typedef unsigned short bf16_t;
typedef short bf16x8 __attribute__((ext_vector_type(8)));
typedef short s16x4 __attribute__((ext_vector_type(4)));
typedef float f32x4 __attribute__((ext_vector_type(4)));
typedef float f32x2 __attribute__((ext_vector_type(2)));
typedef unsigned u32x4 __attribute__((ext_vector_type(4)));
typedef unsigned u32x2 __attribute__((ext_vector_type(2)));
typedef unsigned long long u64;

constexpr int BATCH = 16, SEQ = 2048, DM = 1024, MTOK = BATCH * SEQ, DFF = 2816, NGU = 2 * DFF, INW = 3112, INWP = 3328, NMOD = 9, DEPTH = 2;
constexpr int OFF_QA = 0, OFF_KA = 384, OFF_VA = 768, OFF_CQ = 1152, OFF_CKV = 1408, OFF_KR = 1536, OFF_QC = 1568, OFF_KC = 1888, OFF_VC = 2208, OFF_IQ = 2528, OFF_IK = 3040, OFF_IW = 3104;
constexpr int MLA_K = 384, MLA_N = 1280;
constexpr int MODW = NMOD * DM;
constexpr float RMS_EPS = 1e-6f;
constexpr float NEGV = -1e30f;

constexpr size_t MiB = 1ull << 20;
constexpr size_t WS_NB = 0;
constexpr size_t WS_BIG = 64 * MiB;
constexpr size_t WS_MLAA = 272 * MiB;
constexpr size_t WS_MLAO = 296 * MiB;
constexpr size_t WS_KROPE = 376 * MiB;
constexpr size_t WS_IKN = 378 * MiB;
constexpr size_t WS_MASK = 382 * MiB;
constexpr size_t WS_MOD = 390 * MiB;
constexpr size_t WS_ADAP = 392 * MiB;
constexpr size_t WS_W = 402 * MiB;
constexpr size_t WL_STRIDE = 43 * MiB;
constexpr size_t WO_GU1 = 0, WO_D1 = 11 * MiB, WO_IN = 11 * MiB + 5632 * 1024, WO_MLA = WO_IN + (size_t)INWP * 1024 * 2, WO_OUT = WO_MLA + 1 * MiB, WO_GU2 = WO_OUT + 2 * MiB, WO_D2 = WO_GU2 + 11 * MiB;
static_assert(WO_D2 + 5632 * 1024 <= WL_STRIDE, "weights map");
constexpr size_t WS_BAR = WS_W + 2 * WL_STRIDE;
constexpr size_t WS_SSQ = WS_BAR + 1 * MiB;
constexpr size_t WS_CV = WS_SSQ + 1 * MiB;
constexpr size_t CV_STRIDE = 16 * 5632;
constexpr size_t WS_END = WS_CV + 4 * MiB;

constexpr int LDS_BYTES = 143360;

struct Params {
  const float* x; const float* c; const int* pos; const float* rel_bias; const float* ada_w; const float* ada_b;
  const float* norm_ffn1; const float* ffn1_gu; const float* ffn1_down; const float* norm_mix; const float* w_in;
  const float* q_norm; const float* w_uq; const float* kv_norm; const float* w_ukv; const float* ik_norm; const float* w_out;
  const float* norm_ffn2; const float* ffn2_gu; const float* ffn2_down; const float* final_norm;
  float* out; unsigned char* ws;
};

__device__ __forceinline__ unsigned cvt_pk_bf16(float lo, float hi) { unsigned r; asm volatile("v_cvt_pk_bf16_f32 %0, %1, %2" : "=v"(r) : "v"(lo), "v"(hi)); return r; }
__device__ __forceinline__ float bf2f(unsigned short h) { return __builtin_bit_cast(float, (unsigned)h << 16); }
__device__ __forceinline__ float bflo(unsigned w) { return __builtin_bit_cast(float, w << 16); }
__device__ __forceinline__ float bfhi(unsigned w) { return __builtin_bit_cast(float, w & 0xffff0000u); }
__device__ __forceinline__ unsigned short f2bf(float f) { return (unsigned short)(cvt_pk_bf16(f, 0.f) & 0xffffu); }
__device__ __forceinline__ int otid() { int t = threadIdx.x; asm volatile("" : "+v"(t)); return t; }
__device__ __forceinline__ float wave_sum(float v) {
#pragma unroll
  for (int o = 1; o < 64; o <<= 1) v += __shfl_xor(v, o);
  return v;
}
__device__ __forceinline__ int t5_bucket(int n) {
  if (n < 16) return n;
  int b = 16;
  b += (n >= 19); b += (n >= 21); b += (n >= 24); b += (n >= 27); b += (n >= 31); b += (n >= 35); b += (n >= 40); b += (n >= 46);
  b += (n >= 52); b += (n >= 59); b += (n >= 67); b += (n >= 77); b += (n >= 87); b += (n >= 99); b += (n >= 113);
  return b;
}
__device__ __forceinline__ void sincos_big(float ang, float& s, float& c) {
  double rev = (double)ang * 0.15915494309189535;
  rev -= __builtin_floor(rev);
  float fr = (float)rev;
  s = __builtin_amdgcn_sinf(fr); c = __builtin_amdgcn_cosf(fr);
}
__device__ __forceinline__ float rope_inv(int i) { return __builtin_amdgcn_exp2f(-(float)i * (13.287712379549449f / 16.f)); }

typedef const Params __attribute__((address_space(4)))* cparams_t;
__device__ __forceinline__ cparams_t kparams() { cparams_t q = (cparams_t)__builtin_amdgcn_kernarg_segment_ptr(); asm volatile("" : "+s"(q)); return q; }
namespace pg8 {
constexpr int BM = 256, BK = 64, HALF = 128, HTB = HALF * BK * 2, STAGE_BYTES = 8 * HTB, NXCD = 8, WGM = 8;
__host__ __device__ __forceinline__ int lds_byte(int r, int c) { const int st = (r >> 4) * 2 + (c >> 5), rr = r & 15, cc = c & 31, ob = rr * 64 + cc * 2; return st * 1024 + (ob ^ (((ob >> 9) & 1) << 5)); }
__host__ __device__ __forceinline__ void stage_rc(int b, int& R, int& C) { const int st = b / 1024, sb = b % 1024, swz = sb ^ (((sb >> 9) & 1) << 5); R = (st >> 1) * 16 + swz / 64; C = (st & 1) * 32 + (swz % 64) / 2; }
__host__ __device__ __forceinline__ int perm32(int rho) { const int n = rho >> 4, i = rho & 15; return 8 * (i >> 2) + 4 * n + (i & 3); }
struct Unit { int pm, pn; };
struct Gemm { const bf16_t* A; const bf16_t* Bt; int M, N, K; };
struct StaticOrder {
  int nM, nN, nwg, G, c;
  __host__ __device__ void init(int M, int N, int G_, int c_) { nM = M / BM; nN = N / BM; nwg = nM * nN; G = G_; c = c_; }
  __host__ __device__ bool next(int i, Unit& u) const {
    const long L = (long)i * G + c; if (L >= nwg) return false;
    int wgid = (int)L; { const int q = nwg / NXCD, r = nwg % NXCD, xcd = wgid % NXCD, off = wgid / NXCD; wgid = (xcd < r ? xcd * (q + 1) : r * (q + 1) + (xcd - r) * q) + off; }
    const int nig = WGM * nN, gid = wgid / nig, fm = gid * WGM, gsz = (nM - fm) < WGM ? (nM - fm) : WGM;
    u.pm = fm + ((wgid % nig) % gsz); u.pn = (wgid % nig) / gsz; return true;
  }
  __device__ __forceinline__ void a_ready(const Unit&) const {}
  __device__ __forceinline__ void done(const Unit&) const {}
};

__device__ __forceinline__ float silu_mul(float g, float uu) { return g * __builtin_amdgcn_rcpf(1.f + __expf(-g)) * uu; }
struct EpiDyn {
  static constexpr bool PERM = true, AFTER_DRAIN = false;
  int sub, l;
  __device__ __forceinline__ void operator()(const f32x4 (&acc)[2][2][4][2], const Unit& u, int wr, int wc, int fr, int fq) const {
#if defined(__HIP_DEVICE_COMPILE__)
    const Params p = *kparams();
    unsigned char* wsb = p.ws;
    const float* mod = (const float*)(wsb + WS_MOD) + (size_t)l * 16 * MODW;
    bf16_t* NBp = (bf16_t*)(wsb + WS_NB); bf16_t* BIGp = (bf16_t*)(wsb + WS_BIG); bf16_t* HID2p = (bf16_t*)(wsb + WS_BIG + 64 * MiB);
    float* ssqb = (float*)(wsb + WS_SSQ); const float* cvl = (const float*)(wsb + WS_CV) + (size_t)l * 3 * CV_STRIDE;
    const bool isgu = (sub == 1 || sub == 11), isdn = (sub == 2 || sub == 12), isres = isdn || sub == 9, lastd = (sub == 12 && l + 1 >= DEPTH);
    const int type = isgu ? 1 : isres ? 2 : 0;
    bf16_t* O = (sub == 1 || sub == 4) ? BIGp : (sub == 11) ? HID2p : (bf16_t*)(wsb + WS_MLAO);
    const int ldc = (sub == 4) ? INWP : MLA_N, ncv = 5632;
    const float* ssq = (sub == 6) ? (const float*)nullptr : (const float*)ssqb;
    const float* cv = cvl + ((sub == 1) ? 0 : (sub == 4) ? 1 : 2) * CV_STRIDE;
    const float* src = (sub == 2 && l == 0) ? p.x : (const float*)p.out; float* dst = p.out;
    const float* gate = mod + ((sub == 2) ? 2 : (sub == 12) ? 8 : 5) * DM; const float coef = isdn ? 0.5f : 1.0f;
    bf16_t* nbo = lastd ? (bf16_t*)nullptr : (sub == 9) ? BIGp : NBp;
    const float* gain_n = (sub == 2) ? p.norm_mix + l * DM : (sub == 9) ? p.norm_ffn2 + l * DM : p.norm_ffn1 + (lastd ? 0 : (l + 1)) * DM;
    const float* scale_n = (sub == 2) ? mod + 4 * DM : (sub == 9) ? mod + 7 * DM : mod + 16 * MODW + 1 * DM;
    float* ssq_o = ssqb;
    extern __shared__ __attribute__((aligned(16))) unsigned char lds_epi[];
    LAS float* ps = (LAS float*)((LAS unsigned char*)lds_epi + 131072);
    const int row0 = u.pm * BM + wr * 64 + fr, b = u.pm >> 3;
    if (type == 0) {
      const int col0 = u.pn * BM + wc * 32 + 8 * fq;
      f32x4 cvv[2][2];
#pragma unroll
      for (int bj = 0; bj < 2; ++bj)
#pragma unroll
        for (int n = 0; n < 2; ++n) cvv[bj][n] = ssq ? *(const f32x4*)(cv + (size_t)b * ncv + col0 + bj * HALF + 4 * n) : (f32x4){0.f, 0.f, 0.f, 0.f};
#pragma unroll
      for (int ai = 0; ai < 2; ++ai)
#pragma unroll
        for (int m = 0; m < 4; ++m) { const int row = row0 + ai * HALF + m * 16; bf16_t* rowp = O + (size_t)row * ldc + col0;
          float rs = 1.f;
          if (ssq) { const f32x4 q = *(const f32x4*)(ssq + (size_t)row * 4); rs = __builtin_amdgcn_rsqf(((q[0] + q[1]) + (q[2] + q[3])) * (1.f / DM) + RMS_EPS); }
#pragma unroll
          for (int bj = 0; bj < 2; ++bj) { const f32x4 v0 = acc[ai][bj][m][0] * rs + cvv[bj][0], v1 = acc[ai][bj][m][1] * rs + cvv[bj][1];
            u32x4 w; w.x = cvt_pk_bf16(v0[0], v0[1]); w.y = cvt_pk_bf16(v0[2], v0[3]); w.z = cvt_pk_bf16(v1[0], v1[1]); w.w = cvt_pk_bf16(v1[2], v1[3]);
            *(u32x4*)(rowp + bj * HALF) = w; } }
    } else if (type == 1) {
      const int col0 = u.pn * HALF + wc * 32 + 8 * fq, ccol = u.pn * BM + wc * 32 + 8 * fq;
      f32x4 cvv[2][2];
#pragma unroll
      for (int bj = 0; bj < 2; ++bj)
#pragma unroll
        for (int n = 0; n < 2; ++n) cvv[bj][n] = *(const f32x4*)(cv + (size_t)b * ncv + ccol + bj * HALF + 4 * n);
#pragma unroll
      for (int ai = 0; ai < 2; ++ai)
#pragma unroll
        for (int m = 0; m < 4; ++m) { const int row = row0 + ai * HALF + m * 16; bf16_t* rowp = O + (size_t)row * DFF + col0;
          const f32x4 q = *(const f32x4*)(ssq + (size_t)row * 4); const float rs = __builtin_amdgcn_rsqf(((q[0] + q[1]) + (q[2] + q[3])) * (1.f / DM) + RMS_EPS);
          const f32x4 g0 = acc[ai][0][m][0] * rs + cvv[0][0], g1 = acc[ai][0][m][1] * rs + cvv[0][1], u0 = acc[ai][1][m][0] * rs + cvv[1][0], u1 = acc[ai][1][m][1] * rs + cvv[1][1];
          u32x4 w; w.x = cvt_pk_bf16(silu_mul(g0[0], u0[0]), silu_mul(g0[1], u0[1])); w.y = cvt_pk_bf16(silu_mul(g0[2], u0[2]), silu_mul(g0[3], u0[3]));
          w.z = cvt_pk_bf16(silu_mul(g1[0], u1[0]), silu_mul(g1[1], u1[1])); w.w = cvt_pk_bf16(silu_mul(g1[2], u1[2]), silu_mul(g1[3], u1[3]));
          *(u32x4*)rowp = w; }
    } else {
      const int col0 = u.pn * BM + wc * 32 + 8 * fq;
      const float* gp = gate + (size_t)b * MODW + col0;
      f32x4 gv[2][2], gn[2][2];
#pragma unroll
      for (int bj = 0; bj < 2; ++bj)
#pragma unroll
        for (int n = 0; n < 2; ++n) { gv[bj][n] = *(const f32x4*)(gp + bj * HALF + 4 * n) * coef;
          gn[bj][n] = nbo ? *(const f32x4*)(gain_n + col0 + bj * HALF + 4 * n) * (*(const f32x4*)(scale_n + (size_t)b * MODW + col0 + bj * HALF + 4 * n) + 1.f) : (f32x4){0.f, 0.f, 0.f, 0.f}; }
#pragma unroll
      for (int ai = 0; ai < 2; ++ai)
#pragma unroll
        for (int m = 0; m < 4; ++m) { const size_t ro = (size_t)(row0 + ai * HALF + m * 16) * DM + col0; float ss = 0.f;
#pragma unroll
          for (int bj = 0; bj < 2; ++bj) { f32x4 hn[2];
#pragma unroll
            for (int n = 0; n < 2; ++n) { const f32x4 sv = *(const f32x4*)(src + ro + bj * HALF + 4 * n); hn[n] = sv + gv[bj][n] * acc[ai][bj][m][n];
              *(f32x4*)(dst + ro + bj * HALF + 4 * n) = hn[n]; ss += (hn[n][0] * hn[n][0] + hn[n][1] * hn[n][1]) + (hn[n][2] * hn[n][2] + hn[n][3] * hn[n][3]); }
            if (nbo) { const f32x4 y0 = hn[0] * gn[bj][0], y1 = hn[1] * gn[bj][1];
              u32x4 w; w.x = cvt_pk_bf16(y0[0], y0[1]); w.y = cvt_pk_bf16(y0[2], y0[3]); w.z = cvt_pk_bf16(y1[0], y1[1]); w.w = cvt_pk_bf16(y1[2], y1[3]);
              *(u32x4*)(nbo + ro + bj * HALF) = w; } }
          if (nbo) { ss += __shfl_xor(ss, 16); ss += __shfl_xor(ss, 32); if (fq == 0) ps[wc * 256 + ai * HALF + wr * 64 + m * 16 + fr] = ss; } }
      if (nbo) {
        asm volatile("s_waitcnt lgkmcnt(0)" ::: "memory"); __builtin_amdgcn_s_barrier();
        const int tid = (wr * 4 + wc) * 64 + fq * 16 + fr;
        if (tid < 256) { const float tot = (ps[tid] + ps[256 + tid]) + (ps[512 + tid] + ps[768 + tid]); ssq_o[(size_t)(u.pm * BM + tid) * 4 + u.pn] = tot; }
      }
    }
#endif
  }
};

template <class Epi, class Sched, bool ALIGN_EPI = false, bool SP2 = false>
__device__ __forceinline__ void gemm_phase(LAS unsigned char* lds, const Gemm g, const Sched S, const Epi E) {
  const int tid = otid(), wid = __builtin_amdgcn_readfirstlane(tid >> 6), lane = tid & 63, wr = wid >> 2, wc = wid & 3, fr = lane & 15, fq = lane >> 4;
  const int K = g.K, nt = K / BK;
  unsigned voffA[2], voffB[2];
#pragma unroll
  for (int i = 0; i < 2; ++i) { int R, C; stage_rc(tid * 16 + i * 8192, R, C); const int Rb = Epi::PERM ? ((R & ~31) + perm32(R & 31)) : R;
    voffA[i] = (unsigned)(R * K + C) * 2u; voffB[i] = (unsigned)(Rb * K + C) * 2u; }
  const size_t kstep = (size_t)(BK * 2);
  const size_t hstep = (size_t)HALF * K * 2;
  const size_t tstep = 2 * hstep;
  const unsigned ldsw = (unsigned)wid * 1024u;
  const int aoff = lds_byte(wr * 64 + fr, fq * 8), boff = lds_byte(wc * 32 + fr, fq * 8);
#define PG8_SA(b, h) (((b) * 2 + (h)) * HTB)
#define PG8_SB(b, h) ((4 + (b) * 2 + (h)) * HTB)
#define PG8_STAGE(bufoff, gbase, voff) do { _Pragma("unroll") for (int _i = 0; _i < 2; ++_i) \
        __builtin_amdgcn_global_load_lds((const unsigned*)((const char*)(gbase) + (voff)[_i]), (LAS unsigned*)(lds + (bufoff) + ldsw + _i * 8192), 16, 0, 0); } while (0)
#define PG8_LDA(dst, b, h) do { _Pragma("unroll") for (int m = 0; m < 4; ++m) _Pragma("unroll") for (int k = 0; k < 2; ++k) dst[m][k] = *(const LAS bf16x8*)(lds + PG8_SA(b, h) + aoff + m * 2048 + k * 1024); } while (0)
#define PG8_LDB(dst, b, h) do { _Pragma("unroll") for (int n = 0; n < 2; ++n) _Pragma("unroll") for (int k = 0; k < 2; ++k) dst[n][k] = *(const LAS bf16x8*)(lds + PG8_SB(b, h) + boff + n * 2048 + k * 1024); } while (0)
#define PG8_MMA(ai, bj, At, Bt) do { __builtin_amdgcn_s_setprio(1); _Pragma("unroll") for (int m = 0; m < 4; ++m) _Pragma("unroll") for (int n = 0; n < 2; ++n) _Pragma("unroll") for (int k = 0; k < 2; ++k) \
        acc[ai][bj][m][n] = __builtin_amdgcn_mfma_f32_16x16x32_bf16(Bt[n][k], At[m][k], acc[ai][bj][m][n], 0, 0, 0); __builtin_amdgcn_s_setprio(0); } while (0)
#define PG8_WAIT_V(n) asm volatile("s_waitcnt vmcnt(" #n ")" ::: "memory")
#define PG8_WAIT_L(n) asm volatile("s_waitcnt lgkmcnt(" #n ")" ::: "memory")
#define PG8_BAR __builtin_amdgcn_s_barrier()
#define PG8_SCHED __builtin_amdgcn_sched_barrier(0)
  Unit cur, nxt; int ui = 0;
  if (!S.next(0, cur)) return;
  f32x4 acc[2][2][4][2];
#pragma unroll
  for (int a = 0; a < 2; ++a)
#pragma unroll
    for (int b = 0; b < 2; ++b)
#pragma unroll
      for (int m = 0; m < 4; ++m)
#pragma unroll
        for (int n = 0; n < 2; ++n) acc[a][b][m][n] = (f32x4){0.f, 0.f, 0.f, 0.f};
  bf16x8 At[4][2], B0[2][2], B1[2][2];
  const char* cA = (const char*)g.A + (size_t)cur.pm * tstep; const char* cB = (const char*)g.Bt + (size_t)cur.pn * tstep;
  S.a_ready(cur);
  if constexpr (SP2) {
    PG8_STAGE(PG8_SB(0, 0), cB, voffB); PG8_STAGE(PG8_SB(0, 1), cB + hstep, voffB); PG8_STAGE(PG8_SA(0, 0), cA, voffA); PG8_STAGE(PG8_SA(0, 1), cA + hstep, voffA);
    if (wr == 1) PG8_BAR;
    PG8_WAIT_V(2); PG8_BAR;
    PG8_STAGE(PG8_SB(1, 0), cB + kstep, voffB); PG8_STAGE(PG8_SA(1, 0), cA + kstep, voffA); PG8_STAGE(PG8_SB(1, 1), cB + hstep + kstep, voffB);
    PG8_WAIT_V(6); PG8_BAR;
  } else {
    PG8_STAGE(PG8_SB(0, 0), cB, voffB); PG8_STAGE(PG8_SA(0, 0), cA, voffA); PG8_STAGE(PG8_SB(0, 1), cB + hstep, voffB); PG8_STAGE(PG8_SA(0, 1), cA + hstep, voffA);
    if (wr == 1) PG8_BAR;
    PG8_WAIT_V(4); PG8_BAR;
    PG8_STAGE(PG8_SB(1, 0), cB + kstep, voffB); PG8_STAGE(PG8_SA(1, 0), cA + kstep, voffA); PG8_STAGE(PG8_SB(1, 1), cB + hstep + kstep, voffB);
    PG8_WAIT_V(6); PG8_BAR;
  }
  for (;;) {
    const bool has_next = S.next(ui + 1, nxt);
    const char* nA = has_next ? (const char*)g.A + (size_t)nxt.pm * tstep : cA; const char* nB = has_next ? (const char*)g.Bt + (size_t)nxt.pn * tstep : cB;
#pragma unroll 1
    for (int t = 0; t < nt; t += 2) {
      const bool last = (t == nt - 2);
      const char* a1 = cA + (size_t)(t + 1) * kstep;
      const char* a2 = last ? nA : cA + (size_t)(t + 2) * kstep; const char* b2 = last ? nB : cB + (size_t)(t + 2) * kstep;
      const char* a3 = a2 + kstep; const char* b3 = b2 + kstep;
      if (last && has_next) S.a_ready(nxt);
      if constexpr (SP2) {
        PG8_LDB(B0, 0, 0); PG8_LDB(B1, 0, 1); PG8_SCHED; PG8_LDA(At, 0, 0); PG8_STAGE(PG8_SA(1, 1), a1 + hstep, voffA);
        PG8_WAIT_V(8); PG8_WAIT_L(0); PG8_BAR; PG8_MMA(0, 0, At, B0); PG8_MMA(0, 1, At, B1); PG8_BAR; PG8_SCHED;
        PG8_LDA(At, 0, 1); PG8_STAGE(PG8_SB(0, 0), b2, voffB); PG8_STAGE(PG8_SB(0, 1), b2 + hstep, voffB); PG8_STAGE(PG8_SA(0, 0), a2, voffA);
        PG8_WAIT_V(8); PG8_WAIT_L(0); PG8_BAR; PG8_MMA(1, 0, At, B0); PG8_MMA(1, 1, At, B1); PG8_BAR; PG8_SCHED;
        PG8_LDB(B0, 1, 0); PG8_LDB(B1, 1, 1); PG8_SCHED; PG8_LDA(At, 1, 0); PG8_STAGE(PG8_SA(0, 1), a2 + hstep, voffA);
        PG8_WAIT_V(8); PG8_WAIT_L(0); PG8_BAR; PG8_MMA(0, 0, At, B0); PG8_MMA(0, 1, At, B1); PG8_BAR; PG8_SCHED;
        PG8_LDA(At, 1, 1); PG8_STAGE(PG8_SB(1, 0), b3, voffB); PG8_STAGE(PG8_SB(1, 1), b3 + hstep, voffB); PG8_STAGE(PG8_SA(1, 0), a3, voffA);
        PG8_WAIT_V(8); PG8_WAIT_L(0); PG8_BAR; PG8_MMA(1, 0, At, B0); PG8_MMA(1, 1, At, B1); PG8_BAR; PG8_SCHED;
      } else {
        PG8_LDB(B0, 0, 0); PG8_SCHED; PG8_LDA(At, 0, 0); PG8_STAGE(PG8_SA(1, 1), a1 + hstep, voffA);
        PG8_WAIT_L(8); PG8_BAR; PG8_WAIT_L(0); PG8_MMA(0, 0, At, B0); PG8_BAR; PG8_SCHED;
        PG8_LDB(B1, 0, 1); PG8_STAGE(PG8_SB(0, 0), b2, voffB);
        PG8_BAR; PG8_WAIT_L(0); PG8_MMA(0, 1, At, B1); PG8_BAR;
        PG8_LDA(At, 0, 1); PG8_STAGE(PG8_SA(0, 0), a2, voffA);
        PG8_BAR; PG8_WAIT_L(0); PG8_MMA(1, 0, At, B0); PG8_BAR; PG8_SCHED;
        PG8_STAGE(PG8_SB(0, 1), b2 + hstep, voffB);
        PG8_WAIT_V(6); PG8_BAR; PG8_MMA(1, 1, At, B1); PG8_BAR;
        PG8_LDB(B0, 1, 0); PG8_SCHED; PG8_LDA(At, 1, 0); PG8_STAGE(PG8_SA(0, 1), a2 + hstep, voffA);
        PG8_WAIT_L(8); PG8_BAR; PG8_WAIT_L(0); PG8_MMA(0, 0, At, B0); PG8_BAR; PG8_SCHED;
        PG8_LDB(B1, 1, 1); PG8_STAGE(PG8_SB(1, 0), b3, voffB);
        PG8_BAR; PG8_WAIT_L(0); PG8_MMA(0, 1, At, B1); PG8_BAR;
        PG8_LDA(At, 1, 1); PG8_STAGE(PG8_SA(1, 0), a3, voffA);
        PG8_BAR; PG8_WAIT_L(0); PG8_MMA(1, 0, At, B0); PG8_BAR; PG8_SCHED;
        PG8_STAGE(PG8_SB(1, 1), b3 + hstep, voffB);
        PG8_WAIT_V(6); PG8_BAR; PG8_MMA(1, 1, At, B1); PG8_BAR;
      }
    }
    if constexpr (ALIGN_EPI) { if (wr == 0) PG8_BAR; }
    if constexpr (!Epi::AFTER_DRAIN) { E(acc, cur, wr, wc, fr, fq); S.done(cur); }
    if (!has_next) break;
#pragma unroll
    for (int a = 0; a < 2; ++a)
#pragma unroll
      for (int b = 0; b < 2; ++b)
#pragma unroll
        for (int m = 0; m < 4; ++m)
#pragma unroll
          for (int n = 0; n < 2; ++n) acc[a][b][m][n] = (f32x4){0.f, 0.f, 0.f, 0.f};
    cur = nxt; cA = nA; cB = nB; ++ui;
    if constexpr (ALIGN_EPI) { if (wr == 1) PG8_BAR; }
  }
  PG8_WAIT_V(0);
  if constexpr (!ALIGN_EPI) { if (wr == 0) PG8_BAR; }
  PG8_BAR;
#undef PG8_SA
#undef PG8_SB
#undef PG8_STAGE
#undef PG8_LDA
#undef PG8_LDB
#undef PG8_MMA
#undef PG8_WAIT_V
#undef PG8_WAIT_L
#undef PG8_BAR
#undef PG8_SCHED
}
}

template <class Epi>
__device__ __forceinline__ void run_gemm(unsigned char* lds, const bf16_t* A, const bf16_t* Bt, int N, int K, const Epi E) {
  pg8::Gemm g{A, Bt, MTOK, N, K}; pg8::StaticOrder S; S.init(MTOK, N, (int)gridDim.x, (int)blockIdx.x);
  pg8::gemm_phase<Epi, pg8::StaticOrder, true, true>((LAS unsigned char*)lds, g, S, E);
  __syncthreads();
}

template <class F>
__device__ __forceinline__ void cvt_tile(F src, bf16_t* dst, int ldd, int n0, int k0, float* tile) {
  const int tid = otid();
  float v[8];
#pragma unroll
  for (int i = 0; i < 8; ++i) { const int k = i * 8 + (tid >> 6), n = tid & 63; v[i] = src(k0 + k, n0 + n); }
#pragma unroll
  for (int i = 0; i < 8; ++i) { const int k = i * 8 + (tid >> 6), n = tid & 63; tile[k * 65 + n] = v[i]; }
  __syncthreads();
  { const int n = tid >> 3, kc = (tid & 7) * 8; const float* s = tile + kc * 65 + n;
    u32x4 o; o.x = cvt_pk_bf16(s[0], s[65]); o.y = cvt_pk_bf16(s[2 * 65], s[3 * 65]); o.z = cvt_pk_bf16(s[4 * 65], s[5 * 65]); o.w = cvt_pk_bf16(s[6 * 65], s[7 * 65]);
    *(u32x4*)(dst + (size_t)(n0 + n) * ldd + k0 + kc) = o; }
  __syncthreads();
}

__device__ __forceinline__ void phase0(const Params& p, unsigned char* lds) {
  float* tile = (float*)lds;
  const int tid = otid();
  constexpr int N_ADA = DEPTH * 18 * 8;
  constexpr int T_GU = 88 * 16, T_D = 16 * 44, T_IN = 52 * 16, T_MLA = 20 * 6, T_OUT = 16 * 16;
  constexpr int T_LAYER = 2 * T_GU + 2 * T_D + T_IN + T_MLA + T_OUT;
  constexpr int NITEMS = N_ADA + DEPTH * T_LAYER;
  for (int it = blockIdx.x; it < NITEMS; it += gridDim.x) {
    if (it < N_ADA) {
      const int l = it / 144, r = it % 144, cb = r / 8, ks = r % 8;
      __syncthreads();
      for (int e = tid; e < 16 * 128; e += 512) { const int b = e >> 7, k = e & 127; const float v = p.c[b * DM + ks * 128 + k]; tile[e] = v / (1.f + __expf(-v)); }
      __syncthreads();
      const int j = cb * 512 + tid;
      const float* w = p.ada_w + (size_t)l * DM * MODW + (size_t)(ks * 128) * MODW + j;
      float acc[16];
#pragma unroll
      for (int b = 0; b < 16; ++b) acc[b] = 0.f;
#pragma unroll 1
      for (int k0 = 0; k0 < 128; k0 += 16) { float wv[16];
#pragma unroll
        for (int kk = 0; kk < 16; ++kk) wv[kk] = w[(size_t)(k0 + kk) * MODW];
#pragma unroll
        for (int kk = 0; kk < 16; ++kk)
#pragma unroll
          for (int b = 0; b < 16; ++b) acc[b] += tile[b * 128 + k0 + kk] * wv[kk]; }
      float* dstp = (float*)(p.ws + WS_ADAP) + ((size_t)(ks * DEPTH + l) * 16) * MODW + j;
#pragma unroll
      for (int b = 0; b < 16; ++b) dstp[(size_t)b * MODW] = acc[b];
      __syncthreads();
      continue;
    }
    int r = it - N_ADA; const int l = r / T_LAYER; r -= l * T_LAYER;
    unsigned char* wl = p.ws + WS_W + (size_t)l * WL_STRIDE;
    if (r < 2 * T_GU) {
      const int f = r / T_GU; r -= f * T_GU; const int nt = r / 16, kt = r % 16, n0 = nt * 64;
      const int pn = n0 >> 8, bj = (n0 >> 7) & 1, i0 = n0 & 127, scol0 = bj * DFF + pn * 128 + i0 - n0;
      const float* W = (f ? p.ffn2_gu : p.ffn1_gu) + (size_t)l * DM * NGU;
      cvt_tile([=](int k, int n) { return W[(size_t)k * NGU + n + scol0]; }, (bf16_t*)(wl + (f ? WO_GU2 : WO_GU1)), DM, n0, kt * 64, tile);
      continue;
    }
    r -= 2 * T_GU;
    if (r < 2 * T_D) {
      const int f = r / T_D; r -= f * T_D; const int nt = r / 44, kt = r % 44;
      const float* W = (f ? p.ffn2_down : p.ffn1_down) + (size_t)l * DFF * DM;
      cvt_tile([=](int k, int n) { return W[(size_t)k * DM + n]; }, (bf16_t*)(wl + (f ? WO_D2 : WO_D1)), DFF, nt * 64, kt * 64, tile);
      continue;
    }
    r -= 2 * T_D;
    if (r < T_IN) {
      const int nt = r / 16, kt = r % 16;
      const float* W = p.w_in + (size_t)l * DM * INW;
      cvt_tile([=](int k, int n) { return n < INW ? W[(size_t)k * INW + n] : 0.f; }, (bf16_t*)(wl + WO_IN), DM, nt * 64, kt * 64, tile);
      continue;
    }
    r -= T_IN;
    if (r < T_MLA) {
      const int nt = r / 6, kt = r % 6;
      const float* Wq = p.w_uq + (size_t)l * 256 * 480; const float* Wkv = p.w_ukv + (size_t)l * 128 * 640;
      cvt_tile([=](int k, int n) { float v = 0.f; if (n < 480) { if (k < 256) v = Wq[(size_t)k * 480 + n]; } else if (n < 1120) { if (k >= 256) v = Wkv[(size_t)(k - 256) * 640 + (n - 480)]; } return v; },
               (bf16_t*)(wl + WO_MLA), MLA_K, nt * 64, kt * 64, tile);
      continue;
    }
    r -= T_MLA;
    { const int nt = r / 16, kt = r % 16;
      const float* W = p.w_out + (size_t)l * DM * DM;
      cvt_tile([=](int k, int n) { return W[(size_t)k * DM + n]; }, (bf16_t*)(wl + WO_OUT), DM, nt * 64, kt * 64, tile); }
  }
}
__device__ __forceinline__ void phase_mod_reduce(const Params& p) {
  float* mod = (float*)(p.ws + WS_MOD); const float* part = (const float*)(p.ws + WS_ADAP);
  constexpr int TOT = DEPTH * 16 * MODW;
  for (int e = blockIdx.x * 512 + otid(); e < TOT; e += gridDim.x * 512) {
    const int l = e / (16 * MODW), j = e % MODW;
    float s = p.ada_b[l * MODW + j];
#pragma unroll
    for (int ks = 0; ks < 8; ++ks) s += part[(size_t)ks * TOT + e];
    mod[e] = s;
  }
}

__device__ __forceinline__ void phase_norm(const float* src, const float* gain, const float* shift, const float* scale, bf16_t* dst) {
  const int tid_ = otid(), lane = tid_ & 63, gw = blockIdx.x * 8 + (tid_ >> 6), NGW = gridDim.x * 8;
  for (int m = gw; m < MTOK; m += NGW) {
    const f32x4* xr = (const f32x4*)(src + (size_t)m * DM) + lane;
    f32x4 v[4]; float s = 0.f;
#pragma unroll
    for (int j = 0; j < 4; ++j) { v[j] = xr[64 * j]; s += (v[j].x * v[j].x + v[j].y * v[j].y) + (v[j].z * v[j].z + v[j].w * v[j].w); }
    const float rs = 1.f / sqrtf(wave_sum(s) * (1.f / DM) + RMS_EPS);
    const int b = m / SEQ;
    const f32x4* gp = (const f32x4*)gain + lane; const f32x4* shp = (const f32x4*)(shift + (size_t)b * MODW) + lane; const f32x4* scp = (const f32x4*)(scale + (size_t)b * MODW) + lane;
    u64* o8 = (u64*)(dst + (size_t)m * DM) + lane;
#pragma unroll
    for (int j = 0; j < 4; ++j) { const f32x4 g = gp[64 * j], sh = shp[64 * j], sc = scp[64 * j];
      const f32x4 y = (v[j] * rs) * g * (sc + 1.f) + sh;
      o8[64 * j] = (u64)cvt_pk_bf16(y.x, y.y) | ((u64)cvt_pk_bf16(y.z, y.w) << 32); }
  }
}
__device__ __forceinline__ void phase_final_norm(float* h, const float* gain) {
  const int tid_ = otid(), lane = tid_ & 63, gw = blockIdx.x * 8 + (tid_ >> 6), NGW = gridDim.x * 8;
  for (int m = gw; m < MTOK; m += NGW) {
    f32x4* xr = (f32x4*)(h + (size_t)m * DM) + lane;
    f32x4 v[4]; float s = 0.f;
#pragma unroll
    for (int j = 0; j < 4; ++j) { v[j] = xr[64 * j]; s += (v[j].x * v[j].x + v[j].y * v[j].y) + (v[j].z * v[j].z + v[j].w * v[j].w); }
    const float rs = 1.f / sqrtf(wave_sum(s) * (1.f / DM) + RMS_EPS);
    const f32x4* gp = (const f32x4*)gain + lane;
#pragma unroll
    for (int j = 0; j < 4; ++j) xr[64 * j] = (v[j] * rs) * gp[64 * j];
  }
}

__device__ __forceinline__ void phase_cvec(const Params& p) {
  const int tid_ = otid(), lane = tid_ & 63, fr = lane & 15, fq = lane >> 4, gw = blockIdx.x * 8 + (tid_ >> 6), NGW = gridDim.x * 8;
  constexpr int G_GU = NGU / 16, G_IN = INWP / 16, G_L = 2 * G_GU + G_IN;
  for (int it = gw; it < DEPTH * G_L; it += NGW) {
    const int l = it / G_L; int r = it % G_L; int g, ncols; size_t wo;
    if (r < G_GU) { g = 0; wo = WO_GU1; ncols = NGU; } else if (r < G_GU + G_IN) { r -= G_GU; g = 1; wo = WO_IN; ncols = INWP; } else { r -= G_GU + G_IN; g = 2; wo = WO_GU2; ncols = NGU; }
    const bf16_t* wt = (const bf16_t*)(p.ws + WS_W + (size_t)l * WL_STRIDE + wo) + (size_t)(r * 16 + fr) * DM + fq * 8;
    const float* sh = (const float*)(p.ws + WS_MOD) + ((size_t)l * 16 + fr) * MODW + (g * 3) * DM + fq * 8;
    f32x4 acc = (f32x4){0.f, 0.f, 0.f, 0.f};
#pragma unroll 4
    for (int s = 0; s < 32; ++s) {
      const bf16x8 wf = *(const bf16x8*)(wt + s * 32);
      const f32x4 a0 = *(const f32x4*)(sh + s * 32), a1 = *(const f32x4*)(sh + s * 32 + 4);
      u32x4 w; w.x = cvt_pk_bf16(a0[0], a0[1]); w.y = cvt_pk_bf16(a0[2], a0[3]); w.z = cvt_pk_bf16(a1[0], a1[1]); w.w = cvt_pk_bf16(a1[2], a1[3]);
      acc = __builtin_amdgcn_mfma_f32_16x16x32_bf16(wf, __builtin_bit_cast(bf16x8, w), acc, 0, 0, 0);
    }
    float* cvp = (float*)(p.ws + WS_CV) + ((size_t)(l * 3 + g) * 16 + fr) * 5632 + r * 16 + fq * 4;
    *(f32x4*)cvp = acc;
  }
}
__device__ __forceinline__ void phase_norm0(const float* src, const float* gain, const float* scale, bf16_t* dst, float* ssq) {
  const int tid_ = otid(), lane = tid_ & 63, gw = blockIdx.x * 8 + (tid_ >> 6), NGW = gridDim.x * 8;
  for (int m = gw; m < MTOK; m += NGW) {
    const f32x4* xr = (const f32x4*)(src + (size_t)m * DM) + lane;
    f32x4 v[4]; float s = 0.f;
#pragma unroll
    for (int j = 0; j < 4; ++j) { v[j] = xr[64 * j]; s += (v[j].x * v[j].x + v[j].y * v[j].y) + (v[j].z * v[j].z + v[j].w * v[j].w); }
    s = wave_sum(s);
    const int b = m / SEQ;
    const f32x4* gp = (const f32x4*)gain + lane; const f32x4* scp = (const f32x4*)(scale + (size_t)b * MODW) + lane;
    u64* o8 = (u64*)(dst + (size_t)m * DM) + lane;
#pragma unroll
    for (int j = 0; j < 4; ++j) { const f32x4 y = v[j] * gp[64 * j] * (scp[64 * j] + 1.f);
      o8[64 * j] = (u64)cvt_pk_bf16(y.x, y.y) | ((u64)cvt_pk_bf16(y.z, y.w) << 32); }
    if (lane == 0) *(f32x4*)(ssq + (size_t)m * 4) = (f32x4){s, 0.f, 0.f, 0.f};
  }
}

__device__ __forceinline__ float sumsq8(u32x4 w) { float a = 0.f;
  a += bflo(w.x) * bflo(w.x); a += bfhi(w.x) * bfhi(w.x); a += bflo(w.y) * bflo(w.y); a += bfhi(w.y) * bfhi(w.y);
  a += bflo(w.z) * bflo(w.z); a += bfhi(w.z) * bfhi(w.z); a += bflo(w.w) * bflo(w.w); a += bfhi(w.w) * bfhi(w.w); return a; }
__device__ __forceinline__ float group8_sum(float v) { v += __shfl_xor(v, 1); v += __shfl_xor(v, 2); v += __shfl_xor(v, 4); return v; }
constexpr size_t WS_KMAX = WS_BAR + 14336;
__device__ __forceinline__ void phase_prep(const Params& p, int l) {
  const int tid_ = otid(), lane = tid_ & 63, gw = blockIdx.x * 8 + (tid_ >> 6), NGW = gridDim.x * 8;
  bf16_t* proj = (bf16_t*)(p.ws + WS_BIG); bf16_t* mlaa = (bf16_t*)(p.ws + WS_MLAA); bf16_t* krope = (bf16_t*)(p.ws + WS_KROPE); bf16_t* ikn = (bf16_t*)(p.ws + WS_IKN);
  const float* qn = p.q_norm + l * 256; const float* kvn = p.kv_norm + l * 128;
  const float inv = rope_inv(lane & 15);
  const f32x4 gq = *(const f32x4*)(qn + 4 * lane); const f32x2 gkv = *(const f32x2*)(kvn + 2 * lane); const float gik = p.ik_norm[l * 64 + lane];
  unsigned* kmaxp = (unsigned*)(p.ws + WS_KMAX) + l * 256;
  constexpr int TB = 4;
  for (int base = gw * 16; base < MTOK; base += NGW * 16) {
   float kA = 0.f, kC = 0.f;
   for (int tg = 0; tg < 16; tg += TB) {
    u32x2 cqw[TB]; unsigned ckvw[TB]; float kr1[TB], kr2[TB], q1[TB][2], q2[TB][2], ikv[TB], ang[TB]; u32x4 wa[TB], wc[TB];
#pragma unroll
    for (int t = 0; t < TB; ++t) { const int m = base + tg + t; const bf16_t* pr = proj + (size_t)m * INWP;
      cqw[t] = *(const u32x2*)(pr + OFF_CQ + 4 * lane); ckvw[t] = *(const unsigned*)(pr + OFF_CKV + 2 * lane);
      kr1[t] = bf2f(pr[OFF_KR + (lane & 15)]); kr2[t] = bf2f(pr[OFF_KR + 16 + (lane & 15)]);
#pragma unroll
      for (int j = 0; j < 2; ++j) { const int pp = lane + 64 * j; const bf16_t* q = pr + OFF_IQ + (pp >> 4) * 64 + (pp & 15); q1[t][j] = bf2f(q[0]); q2[t][j] = bf2f(q[16]); }
      ikv[t] = bf2f(pr[OFF_IK + lane]);
      wa[t] = *(const u32x4*)(pr + OFF_KA + (lane < 48 ? lane : 0) * 8); wc[t] = *(const u32x4*)(pr + OFF_KC + (lane < 40 ? lane : 0) * 8);
      ang[t] = (float)p.pos[m] * inv; }
    u32x2 cqo[TB]; unsigned ckvo[TB]; unsigned short kro1[TB], kro2[TB], qo1[TB][2], qo2[TB][2], iko[TB];
#pragma unroll
    for (int t = 0; t < TB; ++t) {
      float sn, cs; sincos_big(ang[t], sn, cs);
      kA = fmaxf(kA, group8_sum(sumsq8(wa[t]))); kC = fmaxf(kC, group8_sum(sumsq8(wc[t])));
      { const float a0 = bflo(cqw[t].x), a1 = bfhi(cqw[t].x), a2 = bflo(cqw[t].y), a3 = bfhi(cqw[t].y);
        const float rs = __builtin_amdgcn_rsqf(wave_sum(a0 * a0 + a1 * a1 + a2 * a2 + a3 * a3) * (1.f / 256) + RMS_EPS);
        cqo[t].x = cvt_pk_bf16(a0 * rs * gq.x, a1 * rs * gq.y); cqo[t].y = cvt_pk_bf16(a2 * rs * gq.z, a3 * rs * gq.w); }
      { const float a0 = bflo(ckvw[t]), a1 = bfhi(ckvw[t]);
        const float rs = __builtin_amdgcn_rsqf(wave_sum(a0 * a0 + a1 * a1) * (1.f / 128) + RMS_EPS);
        ckvo[t] = cvt_pk_bf16(a0 * rs * gkv.x, a1 * rs * gkv.y); }
      kro1[t] = f2bf(kr1[t] * cs - kr2[t] * sn); kro2[t] = f2bf(kr2[t] * cs + kr1[t] * sn);
#pragma unroll
      for (int j = 0; j < 2; ++j) { qo1[t][j] = f2bf(q1[t][j] * cs - q2[t][j] * sn); qo2[t][j] = f2bf(q2[t][j] * cs + q1[t][j] * sn); }
      { const float a = ikv[t];
        const float rs = __builtin_amdgcn_rsqf(wave_sum(a * a) * (1.f / 64) + RMS_EPS);
        const float y = a * rs * gik, pa = __shfl_xor(y, 16);
        float o = y;
        if (lane < 16) o = y * cs - pa * sn; else if (lane < 32) o = y * cs + pa * sn;
        iko[t] = f2bf(o); }
    }
#pragma unroll
    for (int t = 0; t < TB; ++t) { const int m = base + tg + t; bf16_t* pr = proj + (size_t)m * INWP;
      *(u32x2*)(mlaa + (size_t)m * MLA_K + 4 * lane) = cqo[t];
      *(unsigned*)(mlaa + (size_t)m * MLA_K + 256 + 2 * lane) = ckvo[t];
      if (lane < 16) { krope[(size_t)m * 32 + lane] = kro1[t]; krope[(size_t)m * 32 + 16 + lane] = kro2[t]; }
#pragma unroll
      for (int j = 0; j < 2; ++j) { const int pp = lane + 64 * j; bf16_t* q = pr + OFF_IQ + (pp >> 4) * 64 + (pp & 15); q[0] = qo1[t][j]; q[16] = qo2[t][j]; }
      ikn[(size_t)m * 64 + lane] = iko[t]; }
   }
   const int bb = base / SEQ;
   if ((lane & 7) == 0) {
     if (lane < 48) __hip_atomic_fetch_max(kmaxp + bb * 16 + (lane >> 3), __builtin_bit_cast(unsigned, kA), __ATOMIC_RELAXED, __HIP_MEMORY_SCOPE_AGENT);
     if (lane < 40) __hip_atomic_fetch_max(kmaxp + bb * 16 + 11 + (lane >> 3), __builtin_bit_cast(unsigned, kC), __ATOMIC_RELAXED, __HIP_MEMORY_SCOPE_AGENT);
   }
  }
}
__device__ __forceinline__ void phase_qrope(const Params& p, int l) {
  const int tid_ = otid(), lane = tid_ & 63, gw = blockIdx.x * 8 + (tid_ >> 6), NGW = gridDim.x * 8;
  bf16_t* mlao = (bf16_t*)(p.ws + WS_MLAO); const bf16_t* krope = (const bf16_t*)(p.ws + WS_KROPE);
  unsigned* kmaxp = (unsigned*)(p.ws + WS_KMAX) + l * 256;
  const float inv = rope_inv(lane & 15);
  constexpr int TB = 4;
  for (int base = gw * 16; base < MTOK; base += NGW * 16) {
   float kM = 0.f;
   for (int tg = 0; tg < 16; tg += TB) {
    u32x4 wn[TB], wr[TB]; float q1[TB][2], q2[TB][2], ang[TB];
#pragma unroll
    for (int t = 0; t < TB; ++t) { const int m = base + tg + t; const int ll = lane < 40 ? lane : 0;
      wn[t] = *(const u32x4*)(mlao + (size_t)m * MLA_N + 480 + (ll >> 3) * 128 + (ll & 7) * 8); wr[t] = *(const u32x4*)(krope + (size_t)m * 32 + (lane & 3) * 8);
#pragma unroll
      for (int j = 0; j < 2; ++j) { const int pp = (lane + 64 * j < 80) ? lane + 64 * j : 0; const bf16_t* q = mlao + (size_t)m * MLA_N + (pp >> 4) * 96 + 64 + (pp & 15); q1[t][j] = bf2f(q[0]); q2[t][j] = bf2f(q[16]); }
      ang[t] = (float)p.pos[m] * inv; }
    unsigned short qo1[TB][2], qo2[TB][2];
#pragma unroll
    for (int t = 0; t < TB; ++t) {
      float sn, cs; sincos_big(ang[t], sn, cs);
      float r2 = sumsq8(wr[t]); r2 += __shfl_xor(r2, 1); r2 += __shfl_xor(r2, 2);
      kM = fmaxf(kM, group8_sum(sumsq8(wn[t])) + r2);
#pragma unroll
      for (int j = 0; j < 2; ++j) { qo1[t][j] = f2bf(q1[t][j] * cs - q2[t][j] * sn); qo2[t][j] = f2bf(q2[t][j] * cs + q1[t][j] * sn); }
    }
#pragma unroll
    for (int t = 0; t < TB; ++t) { const int m = base + tg + t;
#pragma unroll
      for (int j = 0; j < 2; ++j) { const int pp = lane + 64 * j;
        if (pp < 80) { bf16_t* q = mlao + (size_t)m * MLA_N + (pp >> 4) * 96 + 64 + (pp & 15); q[0] = qo1[t][j]; q[16] = qo2[t][j]; } } }
   }
   const int bb = base / SEQ;
   if ((lane & 7) == 0 && lane < 40) __hip_atomic_fetch_max(kmaxp + bb * 16 + 6 + (lane >> 3), __builtin_bit_cast(unsigned, kM), __ATOMIC_RELAXED, __HIP_MEMORY_SCOPE_AGENT);
  }
}

constexpr int SC_STRIDE = 2117;
__device__ __forceinline__ int wave_count(int c) { int t = 0;
#pragma unroll
  for (int b = 0; b < 6; ++b) t += (int)__popcll(__ballot((c >> b) & 1)) << b;
  return t; }
__device__ __forceinline__ unsigned fkey(float v) { const unsigned u = __builtin_bit_cast(unsigned, v + 0.0f); return (u & 0x80000000u) ? ~u : (u | 0x80000000u); }
#define DEF_WCOUNT(NAME, OP) \
__device__ __forceinline__ int NAME(const unsigned (&key)[32], unsigned thr) { \
  int cnt = 0; const unsigned m = __builtin_amdgcn_readfirstlane(thr); \
  _Pragma("unroll") for (int j = 0; j < 32; j += 4) { u64 a, b, c, d; int ta, tb, tc, td; \
    asm volatile("v_cmp_" OP "_u32 %[a], %[k0], %[m]\n\tv_cmp_" OP "_u32 %[b], %[k1], %[m]\n\tv_cmp_" OP "_u32 %[c], %[k2], %[m]\n\tv_cmp_" OP "_u32 %[d], %[k3], %[m]\n\t" \
                 "s_bcnt1_i32_b64 %[ta], %[a]\n\ts_bcnt1_i32_b64 %[tb], %[b]\n\ts_bcnt1_i32_b64 %[tc], %[c]\n\ts_bcnt1_i32_b64 %[td], %[d]\n\t" \
                 "s_add_i32 %[ta], %[ta], %[tb]\n\ts_add_i32 %[tc], %[tc], %[td]\n\ts_add_i32 %[cnt], %[cnt], %[ta]\n\ts_add_i32 %[cnt], %[cnt], %[tc]" \
      : [cnt] "+s"(cnt), [a] "=&s"(a), [b] "=&s"(b), [c] "=&s"(c), [d] "=&s"(d), [ta] "=&s"(ta), [tb] "=&s"(tb), [tc] "=&s"(tc), [td] "=&s"(td) \
      : [k0] "v"(key[j]), [k1] "v"(key[j + 1]), [k2] "v"(key[j + 2]), [k3] "v"(key[j + 3]), [m] "s"(m) : "scc"); } \
  return cnt; }
DEF_WCOUNT(wcount_ge, "ge")
DEF_WCOUNT(wcount_gt, "gt")
DEF_WCOUNT(wcount_eq, "eq")
__device__ __forceinline__ float unfkey(unsigned k) { const unsigned u = (k & 0x80000000u) ? (k & 0x7fffffffu) : ~k; return __builtin_bit_cast(float, u); }
__device__ __forceinline__ void phase_indexer(const Params& p, unsigned char* lds) {
  float* sc = (float*)lds;
  const int tid = otid(), lane = tid & 63, wave = __builtin_amdgcn_readfirstlane(tid >> 6), fr = lane & 15, fq = lane >> 4;
  const bf16_t* proj = (const bf16_t*)(p.ws + WS_BIG); const bf16_t* ikn = (const bf16_t*)(p.ws + WS_IKN); u64* mask = (u64*)(p.ws + WS_MASK);
  constexpr int NITEMS = BATCH * (SEQ / 16);
  for (int it = blockIdx.x; it < NITEMS; it += gridDim.x) {
    const int b = it % BATCH, qg = (SEQ / 16 - 1) - it / BATCH, t0 = qg * 16;
    const size_t rowb = (size_t)b * SEQ;
    if (t0 + 16 <= 256) {
      if (lane < 32) { mask[(rowb + t0 + 2 * wave) * 32 + lane] = ~0ull; mask[(rowb + t0 + 2 * wave + 1) * 32 + lane] = ~0ull; }
      continue;
    }
    __syncthreads();
    {
      const bf16_t* qrow = proj + (rowb + t0 + fr) * INWP;
      bf16x8 qf[8][2];
#pragma unroll
      for (int h = 0; h < 8; ++h)
#pragma unroll
        for (int s = 0; s < 2; ++s) qf[h][s] = *(const bf16x8*)(qrow + OFF_IQ + h * 64 + s * 32 + fq * 8);
      float wq[8];
      { const u32x4 w = *(const u32x4*)(qrow + OFF_IW); const float cw = 0.04419417382415922f;
        wq[0] = bflo(w.x) * cw; wq[1] = bfhi(w.x) * cw; wq[2] = bflo(w.y) * cw; wq[3] = bfhi(w.y) * cw; wq[4] = bflo(w.z) * cw; wq[5] = bfhi(w.z) * cw; wq[6] = bflo(w.w) * cw; wq[7] = bfhi(w.w) * cw; }
      const int nkt = qg + 1;
      bf16x8 ka[4][2], kb[4][2];
#define IDX_LOAD(X, base) do { _Pragma("unroll") for (int g = 0; g < 4; ++g) { int kk = (base) + 8 * g; kk = (kk < nkt) ? kk : 0; \
          const bf16_t* krow = ikn + (rowb + kk * 16 + fr) * 64 + fq * 8; X[g][0] = *(const bf16x8*)krow; X[g][1] = *(const bf16x8*)(krow + 32); } } while (0)
#define IDX_COMP(X, base) do { _Pragma("unroll") for (int g = 0; g < 4; ++g) { const int kk = (base) + 8 * g; if (kk < nkt) { \
          f32x4 a[8]; \
          _Pragma("unroll") for (int h = 0; h < 8; ++h) a[h] = __builtin_amdgcn_mfma_f32_16x16x32_bf16(X[g][0], qf[h][0], (f32x4){0.f, 0.f, 0.f, 0.f}, 0, 0, 0); \
          _Pragma("unroll") for (int h = 0; h < 8; ++h) a[h] = __builtin_amdgcn_mfma_f32_16x16x32_bf16(X[g][1], qf[h][1], a[h], 0, 0, 0); \
          f32x4 s4 = (f32x4){0.f, 0.f, 0.f, 0.f}; \
          _Pragma("unroll") for (int h = 0; h < 8; ++h) _Pragma("unroll") for (int jj = 0; jj < 4; ++jj) s4[jj] = __builtin_fmaf(wq[h], __builtin_amdgcn_fmed3f(a[h][jj], 0.f, __builtin_inff()), s4[jj]); \
          const int c0 = kk * 16 + fq * 4; float* dp = sc + fr * SC_STRIDE + c0 + (c0 >> 5); dp[0] = s4[0]; dp[1] = s4[1]; dp[2] = s4[2]; dp[3] = s4[3]; } } } while (0)
      int kt = wave;
      IDX_LOAD(ka, kt);
#pragma unroll 1
      while (kt < nkt) {
        IDX_LOAD(kb, kt + 32);
        IDX_COMP(ka, kt);
        kt += 32;
        if (kt >= nkt) break;
        IDX_LOAD(ka, kt + 32);
        IDX_COMP(kb, kt);
        kt += 32;
      }
#undef IDX_LOAD
#undef IDX_COMP
    }
    __syncthreads();
    for (int rr = 0; rr < 2; ++rr) {
      const int r = 2 * wave + rr, t = t0 + r;
      unsigned key[32];
      float kv[32];
#pragma unroll
      for (int j = 0; j < 32; ++j) kv[j] = sc[r * SC_STRIDE + lane * 33 + j];
#pragma unroll
      for (int j = 0; j < 32; ++j) asm volatile("" : "+v"(kv[j]));
#pragma unroll
      for (int j = 0; j < 32; ++j) { const int idx = lane * 32 + j; key[j] = (idx <= t) ? fkey(kv[j]) : 0u; }
      unsigned kmx = 0u, kmn = 0xffffffffu;
#pragma unroll
      for (int j = 0; j < 32; ++j) { kmx = max(kmx, key[j]); kmn = min(kmn, key[j] ? key[j] : 0xffffffffu); }
#pragma unroll
      for (int o = 1; o < 64; o <<= 1) { kmx = max(kmx, (unsigned)__shfl_xor((int)kmx, o)); kmn = min(kmn, (unsigned)__shfl_xor((int)kmn, o)); }
      unsigned lo = kmn, hi = kmx + 1u; int clo = t + 1, chi = 0;
#pragma unroll 1
      for (int itn = 0; itn < 128; ++itn) {
        if (clo == 256 || hi - lo <= 1u) break;
        unsigned mid;
        if (itn % 3 == 2) mid = lo + ((hi - lo) >> 1);
        else { const float flo = unfkey(lo), fhi = unfkey(hi - 1u); const int gap = clo - chi;
          const float off = (gap <= 8) ? 0.5f : fminf((float)gap * 0.125f, 16.f);
          const float tgt = 256.f + (((clo - 256) > (256 - chi)) ? off : -off);
          const float fm = flo + (fhi - flo) * (((float)clo - tgt) / (float)gap);
          mid = fkey(fm); }
        mid = max(lo + 1u, min(mid, hi - 1u));
        const int c = wcount_ge(key, mid);
        if (c >= 256) { lo = mid; clo = c; } else { hi = mid; chi = c; }
      }
      const unsigned T = lo;
      const int cgt = wcount_gt(key, T), ceq = wcount_eq(key, T);
      const int need = 256 - cgt;
      int cutoff = 4096;
      if (ceq > need) {
        int ceql = 0;
#pragma unroll
        for (int j = 0; j < 32; ++j) ceql += (key[j] == T) ? 1 : 0;
        int incl = ceql;
#pragma unroll
        for (int o = 1; o < 64; o <<= 1) { const int v = __shfl_up(incl, o); if (lane >= o) incl += v; }
        const int excl = incl - ceql;
        int mycut = 4096;
        if (excl < need && incl >= need) { int k = need - excl;
#pragma unroll
          for (int j = 0; j < 32; ++j) { if (key[j] == T) { --k; if (k == 0) mycut = lane * 32 + j; } } }
#pragma unroll
        for (int o = 1; o < 64; o <<= 1) mycut = min(mycut, __shfl_xor(mycut, o));
        cutoff = mycut;
      }
      unsigned W = 0u;
#pragma unroll
      for (int j = 0; j < 32; ++j) { const int idx = lane * 32 + j; W |= ((key[j] > T || (key[j] == T && idx <= cutoff)) ? 1u : 0u) << j; __builtin_amdgcn_sched_barrier(0); }
      ((unsigned*)mask)[(rowb + t) * 64 + lane] = W;
    }
  }
  __syncthreads();
}

constexpr int KROW = 208, VROW = 144;
constexpr int AT_BUF = 64 * KROW + 64 * VROW;
constexpr int AT_VOFF = 64 * KROW, AT_TAB = 2 * AT_BUF, TAB_PAD = 96, AT_END = AT_TAB + (2048 + TAB_PAD) * 4;
constexpr float LOG2E = 1.4426950408889634f;
__device__ __forceinline__ s16x4 vtr(const LAS unsigned char* ptr) { return __builtin_bit_cast(s16x4, __builtin_amdgcn_ds_read_tr16_b64_v4i16((LAS s16x4*)ptr)); }

template <int KS, int TYPE>
__device__ __forceinline__ void attn_item(const Params& p, unsigned char* lds, int b, int head, int qb, int l) {
  const int tid = otid(), lane = tid & 63, wave = __builtin_amdgcn_readfirstlane(tid >> 6), fr = lane & 15, fq = lane >> 4;
  const bf16_t* proj = (const bf16_t*)(p.ws + WS_BIG); const bf16_t* mlao = (const bf16_t*)(p.ws + WS_MLAO);
  const bf16_t* Qp; const bf16_t* Kp; const bf16_t* Vp; int qpitch, kpitch; float c2;
  const size_t rowb = (size_t)b * SEQ;
  if (TYPE == 0) { Qp = proj + OFF_QA + head * 64; Kp = proj + OFF_KA + head * 64; Vp = proj + OFF_VA + head * 64; qpitch = kpitch = INWP; c2 = 0.125f * LOG2E; }
  else if (TYPE == 1) { const int hb = head - 6; Qp = mlao + hb * 96; Kp = mlao + 480 + hb * 128; Vp = Kp + 64; qpitch = kpitch = MLA_N; c2 = 0.10206207261596575f * LOG2E; }
  else { const int hc = head - 11; Qp = proj + OFF_QC + hc * 64; Kp = proj + OFF_KC + hc * 64; Vp = proj + OFF_VC + hc * 64; qpitch = kpitch = INWP; c2 = 0.125f * LOG2E; }
  const bf16_t* K2p = (const bf16_t*)(p.ws + WS_KROPE);
  const u64* mask = (const u64*)(p.ws + WS_MASK);
  float* tab = (float*)(lds + AT_TAB);
  LAS unsigned char* l3 = (LAS unsigned char*)lds;

  __syncthreads();
  if (TYPE != 1) {
    const int col = (TYPE == 0) ? head : (head - 11 + 6);
    for (int e = tid; e < 2048 + TAB_PAD; e += 512) {
      const int d = e - TAB_PAD; float v = NEGV;
      if (d >= 0) { v = p.rel_bias[t5_bucket(d) * 11 + col];
        if (TYPE == 0) { const int mult = (d <= 128) + ((d & 3) == 0 && d <= 512) + ((d & 15) == 0);
          v = (mult == 0) ? NEGV : v + (mult == 1 ? 0.f : (mult == 2 ? 0.6931471805599453f : 1.0986122886681098f)); }
        v = (v <= -1e29f) ? NEGV : v * LOG2E; }
      tab[e] = v;
    }
  }
  const int q0 = qb * 256 + wave * 32;
  bf16x8 qf[2][KS];
#pragma unroll
  for (int u = 0; u < 2; ++u)
#pragma unroll
    for (int s = 0; s < KS; ++s) qf[u][s] = *(const bf16x8*)(Qp + (rowb + q0 + u * 16 + fr) * qpitch + s * 32 + fq * 8);
  float tabmax = 0.f;
  if (TYPE != 1) { const int col = (TYPE == 0) ? head : (head - 11 + 6);
    float tv = p.rel_bias[(lane & 31) * 11 + col];
#pragma unroll
    for (int o_ = 1; o_ < 32; o_ <<= 1) tv = fmaxf(tv, __shfl_xor(tv, o_));
    tabmax = tv * LOG2E + (TYPE == 0 ? 1.5849625007211563f : 0.f); }
  const float kmax = sqrtf(__builtin_bit_cast(float, ((const unsigned*)(p.ws + WS_KMAX))[l * 256 + b * 16 + head]));
  f32x4 o[4][2]; float sinit[2], lrow[2];
#pragma unroll
  for (int u = 0; u < 2; ++u) {
    float q2 = 0.f;
#pragma unroll
    for (int s_ = 0; s_ < KS; ++s_) q2 += sumsq8(__builtin_bit_cast(u32x4, qf[u][s_]));
    q2 += __shfl_xor(q2, 16); q2 += __shfl_xor(q2, 32);
    sinit[u] = -(sqrtf(q2) * kmax * 1.0001f + tabmax / c2 + 1e-3f);
    lrow[u] = 0.f;
#pragma unroll
    for (int dt = 0; dt < 4; ++dt) o[dt][u] = (f32x4){0.f, 0.f, 0.f, 0.f}; }

  const int nkt = (qb + 1) * 4;
  const int lkey = tid >> 3, lch = tid & 7;
  u32x4 kreg, vreg, k2reg; u64 mreg[2] = {0ull, 0ull};
#define AT_PREFETCH(kt_) do { const size_t r_ = rowb + (kt_) * 64 + lkey; \
    kreg = *(const u32x4*)(Kp + r_ * kpitch + lch * 8); vreg = *(const u32x4*)(Vp + r_ * kpitch + lch * 8); \
    if (KS == 3) { if (tid < 256) k2reg = *(const u32x4*)(K2p + (rowb + (kt_) * 64 + (tid >> 2)) * 32 + (tid & 3) * 8); } \
    if (TYPE == 2) { mreg[0] = mask[(rowb + q0 + fr) * 32 + (kt_)]; mreg[1] = mask[(rowb + q0 + 16 + fr) * 32 + (kt_)]; } } while (0)
#define AT_STORE(bufo_) do { *(u32x4*)(lds + (bufo_) + lkey * KROW + lch * 16) = kreg; *(u32x4*)(lds + (bufo_) + AT_VOFF + lkey * VROW + lch * 16) = vreg; \
    if (KS == 3) { if (tid < 256) *(u32x4*)(lds + (bufo_) + (tid >> 2) * KROW + 128 + (tid & 3) * 16) = k2reg; } } while (0)
  AT_PREFETCH(0);
  AT_STORE(0);
  __syncthreads();
#pragma unroll 1
  for (int kt = 0; kt < nkt; ++kt) {
    const int bufo = (kt & 1) * AT_BUF;
    const u64 mcur0 = mreg[0], mcur1 = mreg[1];
    if (kt + 1 < nkt) AT_PREFETCH(kt + 1);
    const int kbase = kt * 64;
    if (kbase <= q0 + 31) {
      bf16x8 kf[4][KS];
#pragma unroll
      for (int k16 = 0; k16 < 4; ++k16)
#pragma unroll
        for (int ss = 0; ss < KS; ++ss) kf[k16][ss] = *(const LAS bf16x8*)(l3 + bufo + (k16 * 16 + fr) * KROW + ss * 64 + fq * 16);
      float tv[2][16];
      if (TYPE != 1) {
#pragma unroll
        for (int u = 0; u < 2; ++u) { const float* tp = tab + (q0 + u * 16 + fr - kbase + TAB_PAD - fq * 4);
#pragma unroll
          for (int k16 = 0; k16 < 4; ++k16)
#pragma unroll
            for (int j = 0; j < 4; ++j) tv[u][k16 * 4 + j] = tp[-(k16 * 16 + j)]; }
      }
      __builtin_amdgcn_sched_barrier(0);
      f32x4 s[4][2];
#pragma unroll
      for (int k16 = 0; k16 < 4; ++k16) {
        s[k16][0] = (f32x4){sinit[0], sinit[0], sinit[0], sinit[0]}; s[k16][1] = (f32x4){sinit[1], sinit[1], sinit[1], sinit[1]};
#pragma unroll
        for (int ss = 0; ss < KS; ++ss) {
          s[k16][0] = __builtin_amdgcn_mfma_f32_16x16x32_bf16(kf[k16][ss], qf[0][ss], s[k16][0], 0, 0, 0);
          s[k16][1] = __builtin_amdgcn_mfma_f32_16x16x32_bf16(kf[k16][ss], qf[1][ss], s[k16][1], 0, 0, 0);
        }
      }
      __builtin_amdgcn_sched_barrier(0);
      s16x4 vv[2][4][2];
#pragma unroll
      for (int kc = 0; kc < 2; ++kc)
#pragma unroll
        for (int dt = 0; dt < 4; ++dt) {
          const LAS unsigned char* vb = l3 + bufo + AT_VOFF + (kc * 32 + 4 * fq + (fr >> 2)) * VROW + (dt * 16 + 4 * (fr & 3)) * 2;
          vv[kc][dt][0] = vtr(vb); vv[kc][dt][1] = vtr(vb + 16 * VROW);
        }
      __builtin_amdgcn_sched_barrier(0);
      const bool diag = (kbase + 63 > q0);
      bf16x8 pb[2][2];
#pragma unroll
      for (int u = 0; u < 2; ++u) {
        const int qpos = q0 + u * 16 + fr;
        unsigned wlo = 0u, whi = 0u;
        if (TYPE == 2) { const u64 mw = u ? mcur1 : mcur0; wlo = (unsigned)mw >> (fq * 4); whi = (unsigned)(mw >> 32) >> (fq * 4); }
        float ps = 0.f;
#pragma unroll
        for (int k16 = 0; k16 < 4; ++k16)
#pragma unroll
          for (int j = 0; j < 4; ++j) {
            float v;
            if (TYPE != 1) v = __builtin_fmaf(s[k16][u][j], c2, tv[u][k16 * 4 + j]);
            else { v = s[k16][u][j] * c2; if (diag) v = (kbase + k16 * 16 + fq * 4 + j > qpos) ? NEGV : v; }
            float e = __builtin_amdgcn_exp2f(v);
            if (TYPE == 2) { unsigned sel; asm("v_bfe_i32 %0, %1, %2, 1" : "=v"(sel) : "v"((k16 < 2) ? wlo : whi), "n"((k16 & 1) * 16 + j));
              e = __builtin_bit_cast(float, __builtin_bit_cast(unsigned, e) & sel); }
            s[k16][u][j] = e; ps += e;
          }
        lrow[u] += ps;
#pragma unroll
        for (int kc = 0; kc < 2; ++kc) {
          u32x4 w; w.x = cvt_pk_bf16(s[2 * kc][u][0], s[2 * kc][u][1]); w.y = cvt_pk_bf16(s[2 * kc][u][2], s[2 * kc][u][3]);
          w.z = cvt_pk_bf16(s[2 * kc + 1][u][0], s[2 * kc + 1][u][1]); w.w = cvt_pk_bf16(s[2 * kc + 1][u][2], s[2 * kc + 1][u][3]);
          pb[u][kc] = __builtin_bit_cast(bf16x8, w);
        }
      }
#pragma unroll
      for (int kc = 0; kc < 2; ++kc)
#pragma unroll
        for (int dt = 0; dt < 4; ++dt) {
          const bf16x8 vf = __builtin_shufflevector(vv[kc][dt][0], vv[kc][dt][1], 0, 1, 2, 3, 4, 5, 6, 7);
          o[dt][0] = __builtin_amdgcn_mfma_f32_16x16x32_bf16(vf, pb[0][kc], o[dt][0], 0, 0, 0);
          o[dt][1] = __builtin_amdgcn_mfma_f32_16x16x32_bf16(vf, pb[1][kc], o[dt][1], 0, 0, 0);
        }
    }
    if (kt + 1 < nkt) AT_STORE(AT_BUF - bufo);
    __syncthreads();
  }
#undef AT_PREFETCH
#undef AT_STORE
  bf16_t* outp = (bf16_t*)(p.ws + WS_NB);
#pragma unroll
  for (int u = 0; u < 2; ++u) {
    float l = lrow[u]; l += __shfl_xor(l, 16); l += __shfl_xor(l, 32);
    const float il = 1.f / l;
    bf16_t* orow = outp + (rowb + q0 + u * 16 + fr) * DM + head * 64 + fq * 4;
#pragma unroll
    for (int dt = 0; dt < 4; ++dt) { u32x2 w; w.x = cvt_pk_bf16(o[dt][u][0] * il, o[dt][u][1] * il); w.y = cvt_pk_bf16(o[dt][u][2] * il, o[dt][u][3] * il);
      *(u32x2*)(orow + dt * 16) = w; }
  }
}
__device__ __forceinline__ void phase_attn(const Params& p, unsigned char* lds, int l) {
  constexpr int NITEMS = BATCH * 16 * 8;
  for (int it = blockIdx.x; it < NITEMS; it += gridDim.x) {
    const int r = it >> 8, c = it & 255;
    const int qb = (r & 1) ? (r >> 1) : 7 - (r >> 1), b = c >> 4, head = ((c & 15) + 2 * r) & 15;
    if (head < 6) attn_item<2, 0>(p, lds, b, head, qb, l);
    else if (head < 11) attn_item<3, 1>(p, lds, b, head, qb, l);
    else attn_item<2, 2>(p, lds, b, head, qb, l);
  }
  __syncthreads();
}

#define XB_TMO      128
#define XB_XCNT(j)  (256  + 64 * (j))
#define XB_XSUB(j)  (1280 + 64 * (j))
#define XB_XGEN(j)  (2304 + 64 * (j))
#define XB_TOP      3328
#define XB_TOPGEN   3392
#define XCD_BAR_WORDS 3456
#define XB_SPIN_CAP (1u << 18)
__device__ __forceinline__ unsigned xb_ld(unsigned* p)              { return __hip_atomic_load(p, __ATOMIC_RELAXED, __HIP_MEMORY_SCOPE_AGENT); }
__device__ __forceinline__ unsigned xb_add(unsigned* p, unsigned v) { return __hip_atomic_fetch_add(p, v, __ATOMIC_RELAXED, __HIP_MEMORY_SCOPE_AGENT); }
__device__ __forceinline__ unsigned xb_xcc_id() { return (unsigned)__builtin_amdgcn_s_getreg((3 << 11) | 20) & 0xFu; }
#define XB_SPIN(cond, bar) do { unsigned _sp = 0; while (cond) { __builtin_amdgcn_s_sleep(1); \
    if ((++_sp & 255u) == 0u) { if (xb_ld(&(bar)[XB_TMO])) break; if (_sp > XB_SPIN_CAP) { atomicAdd(&(bar)[XB_TMO], 1u); break; } } } } while (0)
struct XcdBarrier { unsigned* bar; unsigned x; volatile LAS unsigned* st; };
__device__ __forceinline__ XcdBarrier xcd_barrier_post(unsigned* bar, volatile LAS unsigned* st) {
  XcdBarrier b; b.bar = bar; b.x = xb_xcc_id(); b.st = st;
  if (threadIdx.x == 0) (void)xb_add(&bar[XB_XCNT(b.x)], 1u);
  return b;
}
__device__ __forceinline__ void xcd_barrier_complete(unsigned* bar, unsigned x, unsigned& nloc, unsigned& nx) {
  const unsigned G = gridDim.x * gridDim.y * gridDim.z;
  unsigned sum, cnt, mine, sp = 0u;
  for (;;) {
    sum = 0u; cnt = 0u; mine = 0u;
#pragma unroll
    for (unsigned j = 0; j < 16; ++j) { const unsigned c = xb_ld(&bar[XB_XCNT(j)]); sum += c; cnt += (c > 0u) ? 1u : 0u; mine = (j == x) ? c : mine; }
    if (sum == G) break;
    __builtin_amdgcn_s_sleep(1);
    if ((++sp & 255u) == 0u) { if (xb_ld(&bar[XB_TMO])) break; if (sp > XB_SPIN_CAP) { atomicAdd(&bar[XB_TMO], 1u); break; } }
  }
  nloc = mine > 0u ? mine : 1u; nx = cnt > 0u ? cnt : 1u;
}
__device__ __forceinline__ void xcd_barrier(const XcdBarrier& b) {
  asm volatile("s_waitcnt vmcnt(0)" ::: "memory");
  __syncthreads();
  if (threadIdx.x == 0) {
    unsigned* bar = b.bar;
    __builtin_amdgcn_s_waitcnt(0);
    unsigned nloc = b.st[0], nx = b.st[1];
    if (nloc == 0u) { xcd_barrier_complete(bar, b.x, nloc, nx); b.st[0] = nloc; b.st[1] = nx; }
    const unsigned old = xb_add(&bar[XB_XSUB(b.x)], 1u);
    const unsigned gen = old / nloc;
    if (old + 1u == (gen + 1u) * nloc) {
      __builtin_amdgcn_fence(__ATOMIC_RELEASE, "agent");
      asm volatile("s_waitcnt vmcnt(0)" ::: "memory");
      const unsigned og = xb_add(&bar[XB_TOP], 1u);
      const unsigned tg = og / nx;
      if (og + 1u == (tg + 1u) * nx) xb_add(&bar[XB_TOPGEN], 1u);
      else XB_SPIN(xb_ld(&bar[XB_TOPGEN]) == tg, bar);
      __builtin_amdgcn_fence(__ATOMIC_ACQUIRE, "agent");
      xb_add(&bar[XB_XGEN(b.x)], 1u);
      asm volatile("s_waitcnt vmcnt(0)" ::: "memory");
    } else {
      XB_SPIN(xb_ld(&bar[XB_XGEN(b.x)]) == gen, bar);
      __builtin_amdgcn_fence(__ATOMIC_ACQUIRE, "agent");
      asm volatile("s_waitcnt vmcnt(0)" ::: "memory");
    }
  }
  __syncthreads();
}

#ifndef PHMASK
#define PHMASK 0xFFFFu
#endif
#ifndef DUPMASK
#define DUPMASK 0u
#endif
__global__ void __launch_bounds__(512) mega(Params p_unused) {
#if defined(__HIP_DEVICE_COMPILE__)
  extern __shared__ __attribute__((aligned(16))) unsigned char lds[];
  cg::grid_group grid = cg::this_grid();
  { volatile LAS unsigned* st = (volatile LAS unsigned*)((LAS unsigned char*)lds + (LDS_BYTES - 16)); if (threadIdx.x < 2) st[threadIdx.x] = 0u; }
  __syncthreads();
  (void)xcd_barrier_post((unsigned*)((*kparams()).ws + WS_BAR), (volatile LAS unsigned*)((LAS unsigned char*)lds + (LDS_BYTES - 16)));
  int nsteps = 3 + 10 * DEPTH + 1;
  asm volatile("" : "+s"(nsteps));
#pragma unroll 1
  for (int step = 0; step < nsteps; ++step) {
    const Params p = *kparams();
    if (step == 0) { phase0(p, lds); }
    else if (step == 1) { phase_mod_reduce(p); }
    else if (step == 2) { phase_cvec(p); phase_norm0(p.x, p.norm_ffn1, (const float*)(p.ws + WS_MOD) + 1 * DM, (bf16_t*)(p.ws + WS_NB), (float*)(p.ws + WS_SSQ)); }
    else if (step == nsteps - 1) { phase_final_norm(p.out, p.final_norm); }
    else {
      const int l = (step - 3) / 10, si = (step - 3) % 10, sub = si + 1 + (si >= 2) + (si >= 8);
      unsigned char* wl = p.ws + WS_W + (size_t)l * WL_STRIDE;
      const float* mod = (const float*)(p.ws + WS_MOD) + (size_t)l * 16 * MODW;
      const float* hin = (l == 0) ? p.x : p.out;
      bf16_t* NB = (bf16_t*)(p.ws + WS_NB); bf16_t* BIG = (bf16_t*)(p.ws + WS_BIG); bf16_t* HID2 = (bf16_t*)(p.ws + WS_BIG + 64 * MiB);
      float* ssq = (float*)(p.ws + WS_SSQ); const float* cvl = (const float*)(p.ws + WS_CV) + (size_t)l * 3 * CV_STRIDE;
      if (sub == 5) { phase_prep(p, l); }
      else if (sub == 7) { phase_qrope(p, l); phase_indexer(p, lds); }
      else if (sub == 8) { phase_attn(p, lds, l); }
      else {
        const bool isgu = (sub == 1 || sub == 11), isdn = (sub == 2 || sub == 12);
        const bf16_t* A = (sub == 2 || sub == 11) ? BIG : (sub == 12) ? HID2 : (sub == 6) ? (const bf16_t*)(p.ws + WS_MLAA) : NB;
        const size_t wo = (sub == 1) ? WO_GU1 : (sub == 11) ? WO_GU2 : (sub == 2) ? WO_D1 : (sub == 12) ? WO_D2 : (sub == 4) ? WO_IN : (sub == 6) ? WO_MLA : WO_OUT;
        const bf16_t* Bt = (const bf16_t*)(wl + wo);
        const int N = isgu ? NGU : (sub == 4) ? INWP : (sub == 6) ? MLA_N : DM, K = isdn ? DFF : (sub == 6) ? MLA_K : DM;
        pg8::EpiDyn E; E.sub = sub; E.l = l;
        run_gemm(lds, A, Bt, N, K, E);
      }
    }
    if (step == 0) grid.sync();
    else { XcdBarrier xbar; xbar.bar = (unsigned*)((*kparams()).ws + WS_BAR); xbar.x = xb_xcc_id(); xbar.st = (volatile LAS unsigned*)((LAS unsigned char*)lds + (LDS_BYTES - 16)); xcd_barrier(xbar); }
  }
#endif
}

extern "C" void kernel_launch(void* const* d_in, const int* in_sizes, int n_in, void* d_out, int out_size, void* d_ws, size_t ws_size, hipStream_t stream) {
  static int grid_blocks = 0;
  if (!grid_blocks) {
    int dev = 0, cus = 0, per_cu = 0;
    (void)hipGetDevice(&dev);
    (void)hipDeviceGetAttribute(&cus, hipDeviceAttributeMultiprocessorCount, dev);
    (void)hipFuncSetAttribute((const void*)mega, hipFuncAttributeMaxDynamicSharedMemorySize, LDS_BYTES);
    (void)hipOccupancyMaxActiveBlocksPerMultiprocessor(&per_cu, (const void*)mega, 512, LDS_BYTES);
    if (per_cu < 1) per_cu = 1;
    grid_blocks = cus * per_cu;
    if (ws_size < WS_END) fprintf(stderr, "kernel_launch: workspace too small: %zu < %zu\n", ws_size, (size_t)WS_END);
  }
  Params p{};
  p.x = (const float*)d_in[0]; p.c = (const float*)d_in[1]; p.pos = (const int*)d_in[2]; p.rel_bias = (const float*)d_in[3]; p.ada_w = (const float*)d_in[4]; p.ada_b = (const float*)d_in[5];
  p.norm_ffn1 = (const float*)d_in[6]; p.ffn1_gu = (const float*)d_in[7]; p.ffn1_down = (const float*)d_in[8]; p.norm_mix = (const float*)d_in[9]; p.w_in = (const float*)d_in[10];
  p.q_norm = (const float*)d_in[11]; p.w_uq = (const float*)d_in[12]; p.kv_norm = (const float*)d_in[13]; p.w_ukv = (const float*)d_in[14]; p.ik_norm = (const float*)d_in[15]; p.w_out = (const float*)d_in[16];
  p.norm_ffn2 = (const float*)d_in[17]; p.ffn2_gu = (const float*)d_in[18]; p.ffn2_down = (const float*)d_in[19]; p.final_norm = (const float*)d_in[20];
  p.out = (float*)d_out; p.ws = (unsigned char*)d_ws;
  (void)hipMemsetAsync((unsigned char*)d_ws + WS_BAR, 0, 16384, stream);
  void* args[] = {&p};
  hipError_t e = hipLaunchCooperativeKernel((void*)mega, dim3(grid_blocks), dim3(512), args, LDS_BYTES, stream);
  if (e != hipSuccess) fprintf(stderr, "cooperative launch failed: %s (grid %d)\n", hipGetErrorString(e), grid_blocks);
}
```

```cpp
#include <hip/hip_runtime.h>
#include <hip/hip_cooperative_groups.h>
#include <cstdio>
#include <cstdint>
namespace cg = cooperative_groups;

#define LAS __attribute__((address_space(3)))
typedef unsigned short bf16_t;
typedef short bf16x8 __attribute__((ext_vector_type(8)));
typedef short s16x4 __attribute__((ext_vector_type(4)));
typedef float f32x4 __attribute__((ext_vector_type(4)));
typedef float f32x2 __attribute__((ext_vector_type(2)));
typedef unsigned u32x4 __attribute__((ext_vector_type(4)));
typedef unsigned u32x2 __attribute__((ext_vector_type(2)));
typedef unsigned long long u64;

constexpr int BATCH = 16, SEQ = 2048, DM = 1024, MTOK = BATCH * SEQ, DFF = 2816, NGU = 2 * DFF, INW = 3112, INWP = 3328, NMOD = 9, DEPTH = 2;
constexpr int OFF_QA = 0, OFF_KA = 384, OFF_VA = 768, OFF_CQ = 1152, OFF_CKV = 1408, OFF_KR = 1536, OFF_QC = 1568, OFF_KC = 1888, OFF_VC = 2208, OFF_IQ = 2528, OFF_IK = 3040, OFF_IW = 3104;
constexpr int MLA_K = 384, MLA_N = 1280;
constexpr int MODW = NMOD * DM;
constexpr float RMS_EPS = 1e-6f;
constexpr float NEGV = -1e30f;

constexpr size_t MiB = 1ull << 20;
constexpr size_t WS_NB = 0;
constexpr size_t WS_BIG = 64 * MiB;
constexpr size_t WS_MLAA = 272 * MiB;
constexpr size_t WS_MLAO = 296 * MiB;
constexpr size_t WS_KROPE = 376 * MiB;
constexpr size_t WS_IKN = 378 * MiB;
constexpr size_t WS_MASK = 382 * MiB;
constexpr size_t WS_MOD = 390 * MiB;
constexpr size_t WS_ADAP = 392 * MiB;
constexpr size_t WS_W = 402 * MiB;
constexpr size_t WL_STRIDE = 43 * MiB;
constexpr size_t WO_GU1 = 0, WO_D1 = 11 * MiB, WO_IN = 11 * MiB + 5632 * 1024, WO_MLA = WO_IN + (size_t)INWP * 1024 * 2, WO_OUT = WO_MLA + 1 * MiB, WO_GU2 = WO_OUT + 2 * MiB, WO_D2 = WO_GU2 + 11 * MiB;
static_assert(WO_D2 + 5632 * 1024 <= WL_STRIDE, "weights map");
constexpr size_t WS_BAR = WS_W + 2 * WL_STRIDE;
constexpr size_t WS_SSQ = WS_BAR + 1 * MiB;
constexpr size_t WS_CV = WS_SSQ + 1 * MiB;
constexpr size_t CV_STRIDE = 16 * 5632;
constexpr size_t WS_END = WS_CV + 4 * MiB;

constexpr int LDS_BYTES = 143360;

struct Params {
  const float* x; const float* c; const int* pos; const float* rel_bias; const float* ada_w; const float* ada_b;
  const float* norm_ffn1; const float* ffn1_gu; const float* ffn1_down; const float* norm_mix; const float* w_in;
  const float* q_norm; const float* w_uq; const float* kv_norm; const float* w_ukv; const float* ik_norm; const float* w_out;
  const float* norm_ffn2; const float* ffn2_gu; const float* ffn2_down; const float* final_norm;
  float* out; unsigned char* ws;
};

__device__ __forceinline__ unsigned cvt_pk_bf16(float lo, float hi) { unsigned r; asm volatile("v_cvt_pk_bf16_f32 %0, %1, %2" : "=v"(r) : "v"(lo), "v"(hi)); return r; }
__device__ __forceinline__ float bf2f(unsigned short h) { return __builtin_bit_cast(float, (unsigned)h << 16); }
__device__ __forceinline__ float bflo(unsigned w) { return __builtin_bit_cast(float, w << 16); }
__device__ __forceinline__ float bfhi(unsigned w) { return __builtin_bit_cast(float, w & 0xffff0000u); }
__device__ __forceinline__ unsigned short f2bf(float f) { return (unsigned short)(cvt_pk_bf16(f, 0.f) & 0xffffu); }
__device__ __forceinline__ int otid() { int t = threadIdx.x; asm volatile("" : "+v"(t)); return t; }
__device__ __forceinline__ float wave_sum(float v) {
#pragma unroll
  for (int o = 1; o < 64; o <<= 1) v += __shfl_xor(v, o);
  return v;
}
__device__ __forceinline__ int t5_bucket(int n) {
  if (n < 16) return n;
  int b = 16;
  b += (n >= 19); b += (n >= 21); b += (n >= 24); b += (n >= 27); b += (n >= 31); b += (n >= 35); b += (n >= 40); b += (n >= 46);
  b += (n >= 52); b += (n >= 59); b += (n >= 67); b += (n >= 77); b += (n >= 87); b += (n >= 99); b += (n >= 113);
  return b;
}
__device__ __forceinline__ void sincos_big(float ang, float& s, float& c) {
  double rev = (double)ang * 0.15915494309189535;
  rev -= __builtin_floor(rev);
  float fr = (float)rev;
  s = __builtin_amdgcn_sinf(fr); c = __builtin_amdgcn_cosf(fr);
}
__device__ __forceinline__ float rope_inv(int i) { return __builtin_amdgcn_exp2f(-(float)i * (13.287712379549449f / 16.f)); }

typedef const Params __attribute__((address_space(4)))* cparams_t;
__device__ __forceinline__ cparams_t kparams() { cparams_t q = (cparams_t)__builtin_amdgcn_kernarg_segment_ptr(); asm volatile("" : "+s"(q)); return q; }
namespace pg8 {
constexpr int BM = 256, BK = 64, HALF = 128, HTB = HALF * BK * 2, STAGE_BYTES = 8 * HTB, NXCD = 8, WGM = 8;
__host__ __device__ __forceinline__ int lds_byte(int r, int c) { const int st = (r >> 4) * 2 + (c >> 5), rr = r & 15, cc = c & 31, ob = rr * 64 + cc * 2; return st * 1024 + (ob ^ (((ob >> 9) & 1) << 5)); }
__host__ __device__ __forceinline__ void stage_rc(int b, int& R, int& C) { const int st = b / 1024, sb = b % 1024, swz = sb ^ (((sb >> 9) & 1) << 5); R = (st >> 1) * 16 + swz / 64; C = (st & 1) * 32 + (swz % 64) / 2; }
__host__ __device__ __forceinline__ int perm32(int rho) { const int n = rho >> 4, i = rho & 15; return 8 * (i >> 2) + 4 * n + (i & 3); }
struct Unit { int pm, pn; };
struct Gemm { const bf16_t* A; const bf16_t* Bt; int M, N, K; };
struct StaticOrder {
  int nM, nN, nwg, G, c;
  __host__ __device__ void init(int M, int N, int G_, int c_) { nM = M / BM; nN = N / BM; nwg = nM * nN; G = G_; c = c_; }
  __host__ __device__ bool next(int i, Unit& u) const {
    const long L = (long)i * G + c; if (L >= nwg) return false;
    int wgid = (int)L; { const int q = nwg / NXCD, r = nwg % NXCD, xcd = wgid % NXCD, off = wgid / NXCD; wgid = (xcd < r ? xcd * (q + 1) : r * (q + 1) + (xcd - r) * q) + off; }
    const int nig = WGM * nN, gid = wgid / nig, fm = gid * WGM, gsz = (nM - fm) < WGM ? (nM - fm) : WGM;
    u.pm = fm + ((wgid % nig) % gsz); u.pn = (wgid % nig) / gsz; return true;
  }
  __device__ __forceinline__ void a_ready(const Unit&) const {}
  __device__ __forceinline__ void done(const Unit&) const {}
};

__device__ __forceinline__ float silu_mul(float g, float uu) { return g * __builtin_amdgcn_rcpf(1.f + __expf(-g)) * uu; }
struct EpiDyn {
  static constexpr bool PERM = true, AFTER_DRAIN = false;
  int sub, l;
  __device__ __forceinline__ void operator()(const f32x4 (&acc)[2][2][4][2], const Unit& u, int wr, int wc, int fr, int fq) const {
#if defined(__HIP_DEVICE_COMPILE__)
    const Params p = *kparams();
    unsigned char* wsb = p.ws;
    const float* mod = (const float*)(wsb + WS_MOD) + (size_t)l * 16 * MODW;
    bf16_t* NBp = (bf16_t*)(wsb + WS_NB); bf16_t* BIGp = (bf16_t*)(wsb + WS_BIG); bf16_t* HID2p = (bf16_t*)(wsb + WS_BIG + 64 * MiB);
    float* ssqb = (float*)(wsb + WS_SSQ); const float* cvl = (const float*)(wsb + WS_CV) + (size_t)l * 3 * CV_STRIDE;
    const bool isgu = (sub == 1 || sub == 11), isdn = (sub == 2 || sub == 12), isres = isdn || sub == 9, lastd = (sub == 12 && l + 1 >= DEPTH);
    const int type = isgu ? 1 : isres ? 2 : 0;
    bf16_t* O = (sub == 1 || sub == 4) ? BIGp : (sub == 11) ? HID2p : (bf16_t*)(wsb + WS_MLAO);
    const int ldc = (sub == 4) ? INWP : MLA_N, ncv = 5632;
    const float* ssq = (sub == 6) ? (const float*)nullptr : (const float*)ssqb;
    const float* cv = cvl + ((sub == 1) ? 0 : (sub == 4) ? 1 : 2) * CV_STRIDE;
    const float* src = (sub == 2 && l == 0) ? p.x : (const float*)p.out; float* dst = p.out;
    const float* gate = mod + ((sub == 2) ? 2 : (sub == 12) ? 8 : 5) * DM; const float coef = isdn ? 0.5f : 1.0f;
    bf16_t* nbo = lastd ? (bf16_t*)nullptr : (sub == 9) ? BIGp : NBp;
    const float* gain_n = (sub == 2) ? p.norm_mix + l * DM : (sub == 9) ? p.norm_ffn2 + l * DM : p.norm_ffn1 + (lastd ? 0 : (l + 1)) * DM;
    const float* scale_n = (sub == 2) ? mod + 4 * DM : (sub == 9) ? mod + 7 * DM : mod + 16 * MODW + 1 * DM;
    float* ssq_o = ssqb;
    extern __shared__ __attribute__((aligned(16))) unsigned char lds_epi[];
    LAS float* ps = (LAS float*)((LAS unsigned char*)lds_epi + 131072);
    const int row0 = u.pm * BM + wr * 64 + fr, b = u.pm >> 3;
    if (type == 0) {
      const int col0 = u.pn * BM + wc * 32 + 8 * fq;
      f32x4 cvv[2][2];
#pragma unroll
      for (int bj = 0; bj < 2; ++bj)
#pragma unroll
        for (int n = 0; n < 2; ++n) cvv[bj][n] = ssq ? *(const f32x4*)(cv + (size_t)b * ncv + col0 + bj * HALF + 4 * n) : (f32x4){0.f, 0.f, 0.f, 0.f};
#pragma unroll
      for (int ai = 0; ai < 2; ++ai)
#pragma unroll
        for (int m = 0; m < 4; ++m) { const int row = row0 + ai * HALF + m * 16; bf16_t* rowp = O + (size_t)row * ldc + col0;
          float rs = 1.f;
          if (ssq) { const f32x4 q = *(const f32x4*)(ssq + (size_t)row * 4); rs = __builtin_amdgcn_rsqf(((q[0] + q[1]) + (q[2] + q[3])) * (1.f / DM) + RMS_EPS); }
#pragma unroll
          for (int bj = 0; bj < 2; ++bj) { const f32x4 v0 = acc[ai][bj][m][0] * rs + cvv[bj][0], v1 = acc[ai][bj][m][1] * rs + cvv[bj][1];
            u32x4 w; w.x = cvt_pk_bf16(v0[0], v0[1]); w.y = cvt_pk_bf16(v0[2], v0[3]); w.z = cvt_pk_bf16(v1[0], v1[1]); w.w = cvt_pk_bf16(v1[2], v1[3]);
            *(u32x4*)(rowp + bj * HALF) = w; } }
    } else if (type == 1) {
      const int col0 = u.pn * HALF + wc * 32 + 8 * fq, ccol = u.pn * BM + wc * 32 + 8 * fq;
      f32x4 cvv[2][2];
#pragma unroll
      for (int bj = 0; bj < 2; ++bj)
#pragma unroll
        for (int n = 0; n < 2; ++n) cvv[bj][n] = *(const f32x4*)(cv + (size_t)b * ncv + ccol + bj * HALF + 4 * n);
#pragma unroll
      for (int ai = 0; ai < 2; ++ai)
#pragma unroll
        for (int m = 0; m < 4; ++m) { const int row = row0 + ai * HALF + m * 16; bf16_t* rowp = O + (size_t)row * DFF + col0;
          const f32x4 q = *(const f32x4*)(ssq + (size_t)row * 4); const float rs = __builtin_amdgcn_rsqf(((q[0] + q[1]) + (q[2] + q[3])) * (1.f / DM) + RMS_EPS);
          const f32x4 g0 = acc[ai][0][m][0] * rs + cvv[0][0], g1 = acc[ai][0][m][1] * rs + cvv[0][1], u0 = acc[ai][1][m][0] * rs + cvv[1][0], u1 = acc[ai][1][m][1] * rs + cvv[1][1];
          u32x4 w; w.x = cvt_pk_bf16(silu_mul(g0[0], u0[0]), silu_mul(g0[1], u0[1])); w.y = cvt_pk_bf16(silu_mul(g0[2], u0[2]), silu_mul(g0[3], u0[3]));
          w.z = cvt_pk_bf16(silu_mul(g1[0], u1[0]), silu_mul(g1[1], u1[1])); w.w = cvt_pk_bf16(silu_mul(g1[2], u1[2]), silu_mul(g1[3], u1[3]));
          *(u32x4*)rowp = w; }
    } else {
      const int col0 = u.pn * BM + wc * 32 + 8 * fq;
      const float* gp = gate + (size_t)b * MODW + col0;
      f32x4 gv[2][2], gn[2][2];
#pragma unroll
      for (int bj = 0; bj < 2; ++bj)
#pragma unroll
        for (int n = 0; n < 2; ++n) { gv[bj][n] = *(const f32x4*)(gp + bj * HALF + 4 * n) * coef;
          gn[bj][n] = nbo ? *(const f32x4*)(gain_n + col0 + bj * HALF + 4 * n) * (*(const f32x4*)(scale_n + (size_t)b * MODW + col0 + bj * HALF + 4 * n) + 1.f) : (f32x4){0.f, 0.f, 0.f, 0.f}; }
#pragma unroll
      for (int ai = 0; ai < 2; ++ai)
#pragma unroll
        for (int m = 0; m < 4; ++m) { const size_t ro = (size_t)(row0 + ai * HALF + m * 16) * DM + col0; float ss = 0.f;
#pragma unroll
          for (int bj = 0; bj < 2; ++bj) { f32x4 hn[2];
#pragma unroll
            for (int n = 0; n < 2; ++n) { const f32x4 sv = *(const f32x4*)(src + ro + bj * HALF + 4 * n); hn[n] = sv + gv[bj][n] * acc[ai][bj][m][n];
              *(f32x4*)(dst + ro + bj * HALF + 4 * n) = hn[n]; ss += (hn[n][0] * hn[n][0] + hn[n][1] * hn[n][1]) + (hn[n][2] * hn[n][2] + hn[n][3] * hn[n][3]); }
            if (nbo) { const f32x4 y0 = hn[0] * gn[bj][0], y1 = hn[1] * gn[bj][1];
              u32x4 w; w.x = cvt_pk_bf16(y0[0], y0[1]); w.y = cvt_pk_bf16(y0[2], y0[3]); w.z = cvt_pk_bf16(y1[0], y1[1]); w.w = cvt_pk_bf16(y1[2], y1[3]);
              *(u32x4*)(nbo + ro + bj * HALF) = w; } }
          if (nbo) { ss += __shfl_xor(ss, 16); ss += __shfl_xor(ss, 32); if (fq == 0) ps[wc * 256 + ai * HALF + wr * 64 + m * 16 + fr] = ss; } }
      if (nbo) {
        asm volatile("s_waitcnt lgkmcnt(0)" ::: "memory"); __builtin_amdgcn_s_barrier();
        const int tid = (wr * 4 + wc) * 64 + fq * 16 + fr;
        if (tid < 256) { const float tot = (ps[tid] + ps[256 + tid]) + (ps[512 + tid] + ps[768 + tid]); ssq_o[(size_t)(u.pm * BM + tid) * 4 + u.pn] = tot; }
      }
    }
#endif
  }
};

template <class Epi, class Sched, bool ALIGN_EPI = false, bool SP2 = false>
__device__ __forceinline__ void gemm_phase(LAS unsigned char* lds, const Gemm g, const Sched S, const Epi E) {
  const int tid = otid(), wid = __builtin_amdgcn_readfirstlane(tid >> 6), lane = tid & 63, wr = wid >> 2, wc = wid & 3, fr = lane & 15, fq = lane >> 4;
  const int K = g.K, nt = K / BK;
  unsigned voffA[2], voffB[2];
#pragma unroll
  for (int i = 0; i < 2; ++i) { int R, C; stage_rc(tid * 16 + i * 8192, R, C); const int Rb = Epi::PERM ? ((R & ~31) + perm32(R & 31)) : R;
    voffA[i] = (unsigned)(R * K + C) * 2u; voffB[i] = (unsigned)(Rb * K + C) * 2u; }
  const size_t kstep = (size_t)(BK * 2);
  const size_t hstep = (size_t)HALF * K * 2;
  const size_t tstep = 2 * hstep;
  const unsigned ldsw = (unsigned)wid * 1024u;
  const int aoff = lds_byte(wr * 64 + fr, fq * 8), boff = lds_byte(wc * 32 + fr, fq * 8);
#define PG8_SA(b, h) (((b) * 2 + (h)) * HTB)
#define PG8_SB(b, h) ((4 + (b) * 2 + (h)) * HTB)
#define PG8_STAGE(bufoff, gbase, voff) do { _Pragma("unroll") for (int _i = 0; _i < 2; ++_i) \
        __builtin_amdgcn_global_load_lds((const unsigned*)((const char*)(gbase) + (voff)[_i]), (LAS unsigned*)(lds + (bufoff) + ldsw + _i * 8192), 16, 0, 0); } while (0)
#define PG8_LDA(dst, b, h) do { _Pragma("unroll") for (int m = 0; m < 4; ++m) _Pragma("unroll") for (int k = 0; k < 2; ++k) dst[m][k] = *(const LAS bf16x8*)(lds + PG8_SA(b, h) + aoff + m * 2048 + k * 1024); } while (0)
#define PG8_LDB(dst, b, h) do { _Pragma("unroll") for (int n = 0; n < 2; ++n) _Pragma("unroll") for (int k = 0; k < 2; ++k) dst[n][k] = *(const LAS bf16x8*)(lds + PG8_SB(b, h) + boff + n * 2048 + k * 1024); } while (0)
#define PG8_MMA(ai, bj, At, Bt) do { __builtin_amdgcn_s_setprio(1); _Pragma("unroll") for (int m = 0; m < 4; ++m) _Pragma("unroll") for (int n = 0; n < 2; ++n) _Pragma("unroll") for (int k = 0; k < 2; ++k) \
        acc[ai][bj][m][n] = __builtin_amdgcn_mfma_f32_16x16x32_bf16(Bt[n][k], At[m][k], acc[ai][bj][m][n], 0, 0, 0); __builtin_amdgcn_s_setprio(0); } while (0)
#define PG8_WAIT_V(n) asm volatile("s_waitcnt vmcnt(" #n ")" ::: "memory")
#define PG8_WAIT_L(n) asm volatile("s_waitcnt lgkmcnt(" #n ")" ::: "memory")
#define PG8_BAR __builtin_amdgcn_s_barrier()
#define PG8_SCHED __builtin_amdgcn_sched_barrier(0)
  Unit cur, nxt; int ui = 0;
  if (!S.next(0, cur)) return;
  f32x4 acc[2][2][4][2];
#pragma unroll
  for (int a = 0; a < 2; ++a)
#pragma unroll
    for (int b = 0; b < 2; ++b)
#pragma unroll
      for (int m = 0; m < 4; ++m)
#pragma unroll
        for (int n = 0; n < 2; ++n) acc[a][b][m][n] = (f32x4){0.f, 0.f, 0.f, 0.f};
  bf16x8 At[4][2], B0[2][2], B1[2][2];
  const char* cA = (const char*)g.A + (size_t)cur.pm * tstep; const char* cB = (const char*)g.Bt + (size_t)cur.pn * tstep;
  S.a_ready(cur);
  if constexpr (SP2) {
    PG8_STAGE(PG8_SB(0, 0), cB, voffB); PG8_STAGE(PG8_SB(0, 1), cB + hstep, voffB); PG8_STAGE(PG8_SA(0, 0), cA, voffA); PG8_STAGE(PG8_SA(0, 1), cA + hstep, voffA);
    if (wr == 1) PG8_BAR;
    PG8_WAIT_V(2); PG8_BAR;
    PG8_STAGE(PG8_SB(1, 0), cB + kstep, voffB); PG8_STAGE(PG8_SA(1, 0), cA + kstep, voffA); PG8_STAGE(PG8_SB(1, 1), cB + hstep + kstep, voffB);
    PG8_WAIT_V(6); PG8_BAR;
  } else {
    PG8_STAGE(PG8_SB(0, 0), cB, voffB); PG8_STAGE(PG8_SA(0, 0), cA, voffA); PG8_STAGE(PG8_SB(0, 1), cB + hstep, voffB); PG8_STAGE(PG8_SA(0, 1), cA + hstep, voffA);
    if (wr == 1) PG8_BAR;
    PG8_WAIT_V(4); PG8_BAR;
    PG8_STAGE(PG8_SB(1, 0), cB + kstep, voffB); PG8_STAGE(PG8_SA(1, 0), cA + kstep, voffA); PG8_STAGE(PG8_SB(1, 1), cB + hstep + kstep, voffB);
    PG8_WAIT_V(6); PG8_BAR;
  }
  for (;;) {
    const bool has_next = S.next(ui + 1, nxt);
    const char* nA = has_next ? (const char*)g.A + (size_t)nxt.pm * tstep : cA; const char* nB = has_next ? (const char*)g.Bt + (size_t)nxt.pn * tstep : cB;
#pragma unroll 1
    for (int t = 0; t < nt; t += 2) {
      const bool last = (t == nt - 2);
      const char* a1 = cA + (size_t)(t + 1) * kstep;
      const char* a2 = last ? nA : cA + (size_t)(t + 2) * kstep; const char* b2 = last ? nB : cB + (size_t)(t + 2) * kstep;
      const char* a3 = a2 + kstep; const char* b3 = b2 + kstep;
      if (last && has_next) S.a_ready(nxt);
      if constexpr (SP2) {
        PG8_LDB(B0, 0, 0); PG8_LDB(B1, 0, 1); PG8_SCHED; PG8_LDA(At, 0, 0); PG8_STAGE(PG8_SA(1, 1), a1 + hstep, voffA);
        PG8_WAIT_V(8); PG8_WAIT_L(0); PG8_BAR; PG8_MMA(0, 0, At, B0); PG8_MMA(0, 1, At, B1); PG8_BAR; PG8_SCHED;
        PG8_LDA(At, 0, 1); PG8_STAGE(PG8_SB(0, 0), b2, voffB); PG8_STAGE(PG8_SB(0, 1), b2 + hstep, voffB); PG8_STAGE(PG8_SA(0, 0), a2, voffA);
        PG8_WAIT_V(8); PG8_WAIT_L(0); PG8_BAR; PG8_MMA(1, 0, At, B0); PG8_MMA(1, 1, At, B1); PG8_BAR; PG8_SCHED;
        PG8_LDB(B0, 1, 0); PG8_LDB(B1, 1, 1); PG8_SCHED; PG8_LDA(At, 1, 0); PG8_STAGE(PG8_SA(0, 1), a2 + hstep, voffA);
        PG8_WAIT_V(8); PG8_WAIT_L(0); PG8_BAR; PG8_MMA(0, 0, At, B0); PG8_MMA(0, 1, At, B1); PG8_BAR; PG8_SCHED;
        PG8_LDA(At, 1, 1); PG8_STAGE(PG8_SB(1, 0), b3, voffB); PG8_STAGE(PG8_SB(1, 1), b3 + hstep, voffB); PG8_STAGE(PG8_SA(1, 0), a3, voffA);
        PG8_WAIT_V(8); PG8_WAIT_L(0); PG8_BAR; PG8_MMA(1, 0, At, B0); PG8_MMA(1, 1, At, B1); PG8_BAR; PG8_SCHED;
      } else {
        PG8_LDB(B0, 0, 0); PG8_SCHED; PG8_LDA(At, 0, 0); PG8_STAGE(PG8_SA(1, 1), a1 + hstep, voffA);
        PG8_WAIT_L(8); PG8_BAR; PG8_WAIT_L(0); PG8_MMA(0, 0, At, B0); PG8_BAR; PG8_SCHED;
        PG8_LDB(B1, 0, 1); PG8_STAGE(PG8_SB(0, 0), b2, voffB);
        PG8_BAR; PG8_WAIT_L(0); PG8_MMA(0, 1, At, B1); PG8_BAR;
        PG8_LDA(At, 0, 1); PG8_STAGE(PG8_SA(0, 0), a2, voffA);
        PG8_BAR; PG8_WAIT_L(0); PG8_MMA(1, 0, At, B0); PG8_BAR; PG8_SCHED;
        PG8_STAGE(PG8_SB(0, 1), b2 + hstep, voffB);
        PG8_WAIT_V(6); PG8_BAR; PG8_MMA(1, 1, At, B1); PG8_BAR;
        PG8_LDB(B0, 1, 0); PG8_SCHED; PG8_LDA(At, 1, 0); PG8_STAGE(PG8_SA(0, 1), a2 + hstep, voffA);
        PG8_WAIT_L(8); PG8_BAR; PG8_WAIT_L(0); PG8_MMA(0, 0, At, B0); PG8_BAR; PG8_SCHED;
        PG8_LDB(B1, 1, 1); PG8_STAGE(PG8_SB(1, 0), b3, voffB);
        PG8_BAR; PG8_WAIT_L(0); PG8_MMA(0, 1, At, B1); PG8_BAR;
        PG8_LDA(At, 1, 1); PG8_STAGE(PG8_SA(1, 0), a3, voffA);
        PG8_BAR; PG8_WAIT_L(0); PG8_MMA(1, 0, At, B0); PG8_BAR; PG8_SCHED;
        PG8_STAGE(PG8_SB(1, 1), b3 + hstep, voffB);
        PG8_WAIT_V(6); PG8_BAR; PG8_MMA(1, 1, At, B1); PG8_BAR;
      }
    }
    if constexpr (ALIGN_EPI) { if (wr == 0) PG8_BAR; }
    if constexpr (!Epi::AFTER_DRAIN) { E(acc, cur, wr, wc, fr, fq); S.done(cur); }
    if (!has_next) break;
#pragma unroll
    for (int a = 0; a < 2; ++a)
#pragma unroll
      for (int b = 0; b < 2; ++b)
#pragma unroll
        for (int m = 0; m < 4; ++m)
#pragma unroll
          for (int n = 0; n < 2; ++n) acc[a][b][m][n] = (f32x4){0.f, 0.f, 0.f, 0.f};
    cur = nxt; cA = nA; cB = nB; ++ui;
    if constexpr (ALIGN_EPI) { if (wr == 1) PG8_BAR; }
  }
  PG8_WAIT_V(0);
  if constexpr (!ALIGN_EPI) { if (wr == 0) PG8_BAR; }
  PG8_BAR;
#undef PG8_SA
#undef PG8_SB
#undef PG8_STAGE
#undef PG8_LDA
#undef PG8_LDB
#undef PG8_MMA
#undef PG8_WAIT_V
#undef PG8_WAIT_L
#undef PG8_BAR
#undef PG8_SCHED
}
}

template <class Epi>
__device__ __forceinline__ void run_gemm(unsigned char* lds, const bf16_t* A, const bf16_t* Bt, int N, int K, const Epi E) {
  pg8::Gemm g{A, Bt, MTOK, N, K}; pg8::StaticOrder S; S.init(MTOK, N, (int)gridDim.x, (int)blockIdx.x);
  pg8::gemm_phase<Epi, pg8::StaticOrder, true, true>((LAS unsigned char*)lds, g, S, E);
  __syncthreads();
}

template <class F>
__device__ __forceinline__ void cvt_tile(F src, bf16_t* dst, int ldd, int n0, int k0, float* tile) {
  const int tid = otid();
  float v[8];
#pragma unroll
  for (int i = 0; i < 8; ++i) { const int k = i * 8 + (tid >> 6), n = tid & 63; v[i] = src(k0 + k, n0 + n); }
#pragma unroll
  for (int i = 0; i < 8; ++i) { const int k = i * 8 + (tid >> 6), n = tid & 63; tile[k * 65 + n] = v[i]; }
  __syncthreads();
  { const int n = tid >> 3, kc = (tid & 7) * 8; const float* s = tile + kc * 65 + n;
    u32x4 o; o.x = cvt_pk_bf16(s[0], s[65]); o.y = cvt_pk_bf16(s[2 * 65], s[3 * 65]); o.z = cvt_pk_bf16(s[4 * 65], s[5 * 65]); o.w = cvt_pk_bf16(s[6 * 65], s[7 * 65]);
    *(u32x4*)(dst + (size_t)(n0 + n) * ldd + k0 + kc) = o; }
  __syncthreads();
}

__device__ __forceinline__ void phase0(const Params& p, unsigned char* lds) {
  float* tile = (float*)lds;
  const int tid = otid();
  constexpr int N_ADA = DEPTH * 18 * 8;
  constexpr int T_GU = 88 * 16, T_D = 16 * 44, T_IN = 52 * 16, T_MLA = 20 * 6, T_OUT = 16 * 16;
  constexpr int T_LAYER = 2 * T_GU + 2 * T_D + T_IN + T_MLA + T_OUT;
  constexpr int NITEMS = N_ADA + DEPTH * T_LAYER;
  for (int it = blockIdx.x; it < NITEMS; it += gridDim.x) {
    if (it < N_ADA) {
      const int l = it / 144, r = it % 144, cb = r / 8, ks = r % 8;
      __syncthreads();
      for (int e = tid; e < 16 * 128; e += 512) { const int b = e >> 7, k = e & 127; const float v = p.c[b * DM + ks * 128 + k]; tile[e] = v / (1.f + __expf(-v)); }
      __syncthreads();
      const int j = cb * 512 + tid;
      const float* w = p.ada_w + (size_t)l * DM * MODW + (size_t)(ks * 128) * MODW + j;
      float acc[16];
#pragma unroll
      for (int b = 0; b < 16; ++b) acc[b] = 0.f;
#pragma unroll 1
      for (int k0 = 0; k0 < 128; k0 += 16) { float wv[16];
#pragma unroll
        for (int kk = 0; kk < 16; ++kk) wv[kk] = w[(size_t)(k0 + kk) * MODW];
#pragma unroll
        for (int kk = 0; kk < 16; ++kk)
#pragma unroll
          for (int b = 0; b < 16; ++b) acc[b] += tile[b * 128 + k0 + kk] * wv[kk]; }
      float* dstp = (float*)(p.ws + WS_ADAP) + ((size_t)(ks * DEPTH + l) * 16) * MODW + j;
#pragma unroll
      for (int b = 0; b < 16; ++b) dstp[(size_t)b * MODW] = acc[b];
      __syncthreads();
      continue;
    }
    int r = it - N_ADA; const int l = r / T_LAYER; r -= l * T_LAYER;
    unsigned char* wl = p.ws + WS_W + (size_t)l * WL_STRIDE;
    if (r < 2 * T_GU) {
      const int f = r / T_GU; r -= f * T_GU; const int nt = r / 16, kt = r % 16, n0 = nt * 64;
      const int pn = n0 >> 8, bj = (n0 >> 7) & 1, i0 = n0 & 127, scol0 = bj * DFF + pn * 128 + i0 - n0;
      const float* W = (f ? p.ffn2_gu : p.ffn1_gu) + (size_t)l * DM * NGU;
      cvt_tile([=](int k, int n) { return W[(size_t)k * NGU + n + scol0]; }, (bf16_t*)(wl + (f ? WO_GU2 : WO_GU1)), DM, n0, kt * 64, tile);
      continue;
    }
    r -= 2 * T_GU;
    if (r < 2 * T_D) {
      const int f = r / T_D; r -= f * T_D; const int nt = r / 44, kt = r % 44;
      const float* W = (f ? p.ffn2_down : p.ffn1_down) + (size_t)l * DFF * DM;
      cvt_tile([=](int k, int n) { return W[(size_t)k * DM + n]; }, (bf16_t*)(wl + (f ? WO_D2 : WO_D1)), DFF, nt * 64, kt * 64, tile);
      continue;
    }
    r -= 2 * T_D;
    if (r < T_IN) {
      const int nt = r / 16, kt = r % 16;
      const float* W = p.w_in + (size_t)l * DM * INW;
      cvt_tile([=](int k, int n) { return n < INW ? W[(size_t)k * INW + n] : 0.f; }, (bf16_t*)(wl + WO_IN), DM, nt * 64, kt * 64, tile);
      continue;
    }
    r -= T_IN;
    if (r < T_MLA) {
      const int nt = r / 6, kt = r % 6;
      const float* Wq = p.w_uq + (size_t)l * 256 * 480; const float* Wkv = p.w_ukv + (size_t)l * 128 * 640;
      cvt_tile([=](int k, int n) { float v = 0.f; if (n < 480) { if (k < 256) v = Wq[(size_t)k * 480 + n]; } else if (n < 1120) { if (k >= 256) v = Wkv[(size_t)(k - 256) * 640 + (n - 480)]; } return v; },
               (bf16_t*)(wl + WO_MLA), MLA_K, nt * 64, kt * 64, tile);
      continue;
    }
    r -= T_MLA;
    { const int nt = r / 16, kt = r % 16;
      const float* W = p.w_out + (size_t)l * DM * DM;
      cvt_tile([=](int k, int n) { return W[(size_t)k * DM + n]; }, (bf16_t*)(wl + WO_OUT), DM, nt * 64, kt * 64, tile); }
  }
}
__device__ __forceinline__ void phase_mod_reduce(const Params& p) {
  float* mod = (float*)(p.ws + WS_MOD); const float* part = (const float*)(p.ws + WS_ADAP);
  constexpr int TOT = DEPTH * 16 * MODW;
  for (int e = blockIdx.x * 512 + otid(); e < TOT; e += gridDim.x * 512) {
    const int l = e / (16 * MODW), j = e % MODW;
    float s = p.ada_b[l * MODW + j];
#pragma unroll
    for (int ks = 0; ks < 8; ++ks) s += part[(size_t)ks * TOT + e];
    mod[e] = s;
  }
}

__device__ __forceinline__ void phase_norm(const float* src, const float* gain, const float* shift, const float* scale, bf16_t* dst) {
  const int tid_ = otid(), lane = tid_ & 63, gw = blockIdx.x * 8 + (tid_ >> 6), NGW = gridDim.x * 8;
  for (int m = gw; m < MTOK; m += NGW) {
    const f32x4* xr = (const f32x4*)(src + (size_t)m * DM) + lane;
    f32x4 v[4]; float s = 0.f;
#pragma unroll
    for (int j = 0; j < 4; ++j) { v[j] = xr[64 * j]; s += (v[j].x * v[j].x + v[j].y * v[j].y) + (v[j].z * v[j].z + v[j].w * v[j].w); }
    const float rs = 1.f / sqrtf(wave_sum(s) * (1.f / DM) + RMS_EPS);
    const int b = m / SEQ;
    const f32x4* gp = (const f32x4*)gain + lane; const f32x4* shp = (const f32x4*)(shift + (size_t)b * MODW) + lane; const f32x4* scp = (const f32x4*)(scale + (size_t)b * MODW) + lane;
    u64* o8 = (u64*)(dst + (size_t)m * DM) + lane;
#pragma unroll
    for (int j = 0; j < 4; ++j) { const f32x4 g = gp[64 * j], sh = shp[64 * j], sc = scp[64 * j];
      const f32x4 y = (v[j] * rs) * g * (sc + 1.f) + sh;
      o8[64 * j] = (u64)cvt_pk_bf16(y.x, y.y) | ((u64)cvt_pk_bf16(y.z, y.w) << 32); }
  }
}
__device__ __forceinline__ void phase_final_norm(float* h, const float* gain) {
  const int tid_ = otid(), lane = tid_ & 63, gw = blockIdx.x * 8 + (tid_ >> 6), NGW = gridDim.x * 8;
  for (int m = gw; m < MTOK; m += NGW) {
    f32x4* xr = (f32x4*)(h + (size_t)m * DM) + lane;
    f32x4 v[4]; float s = 0.f;
#pragma unroll
    for (int j = 0; j < 4; ++j) { v[j] = xr[64 * j]; s += (v[j].x * v[j].x + v[j].y * v[j].y) + (v[j].z * v[j].z + v[j].w * v[j].w); }
    const float rs = 1.f / sqrtf(wave_sum(s) * (1.f / DM) + RMS_EPS);
    const f32x4* gp = (const f32x4*)gain + lane;
#pragma unroll
    for (int j = 0; j < 4; ++j) xr[64 * j] = (v[j] * rs) * gp[64 * j];
  }
}

__device__ __forceinline__ void phase_cvec(const Params& p) {
  const int tid_ = otid(), lane = tid_ & 63, fr = lane & 15, fq = lane >> 4, gw = blockIdx.x * 8 + (tid_ >> 6), NGW = gridDim.x * 8;
  constexpr int G_GU = NGU / 16, G_IN = INWP / 16, G_L = 2 * G_GU + G_IN;
  for (int it = gw; it < DEPTH * G_L; it += NGW) {
    const int l = it / G_L; int r = it % G_L; int g, ncols; size_t wo;
    if (r < G_GU) { g = 0; wo = WO_GU1; ncols = NGU; } else if (r < G_GU + G_IN) { r -= G_GU; g = 1; wo = WO_IN; ncols = INWP; } else { r -= G_GU + G_IN; g = 2; wo = WO_GU2; ncols = NGU; }
    const bf16_t* wt = (const bf16_t*)(p.ws + WS_W + (size_t)l * WL_STRIDE + wo) + (size_t)(r * 16 + fr) * DM + fq * 8;
    const float* sh = (const float*)(p.ws + WS_MOD) + ((size_t)l * 16 + fr) * MODW + (g * 3) * DM + fq * 8;
    f32x4 acc = (f32x4){0.f, 0.f, 0.f, 0.f};
#pragma unroll 4
    for (int s = 0; s < 32; ++s) {
      const bf16x8 wf = *(const bf16x8*)(wt + s * 32);
      const f32x4 a0 = *(const f32x4*)(sh + s * 32), a1 = *(const f32x4*)(sh + s * 32 + 4);
      u32x4 w; w.x = cvt_pk_bf16(a0[0], a0[1]); w.y = cvt_pk_bf16(a0[2], a0[3]); w.z = cvt_pk_bf16(a1[0], a1[1]); w.w = cvt_pk_bf16(a1[2], a1[3]);
      acc = __builtin_amdgcn_mfma_f32_16x16x32_bf16(wf, __builtin_bit_cast(bf16x8, w), acc, 0, 0, 0);
    }
    float* cvp = (float*)(p.ws + WS_CV) + ((size_t)(l * 3 + g) * 16 + fr) * 5632 + r * 16 + fq * 4;
    *(f32x4*)cvp = acc;
  }
}
__device__ __forceinline__ void phase_norm0(const float* src, const float* gain, const float* scale, bf16_t* dst, float* ssq) {
  const int tid_ = otid(), lane = tid_ & 63, gw = blockIdx.x * 8 + (tid_ >> 6), NGW = gridDim.x * 8;
  for (int m = gw; m < MTOK; m += NGW) {
    const f32x4* xr = (const f32x4*)(src + (size_t)m * DM) + lane;
    f32x4 v[4]; float s = 0.f;
#pragma unroll
    for (int j = 0; j < 4; ++j) { v[j] = xr[64 * j]; s += (v[j].x * v[j].x + v[j].y * v[j].y) + (v[j].z * v[j].z + v[j].w * v[j].w); }
    s = wave_sum(s);
    const int b = m / SEQ;
    const f32x4* gp = (const f32x4*)gain + lane; const f32x4* scp = (const f32x4*)(scale + (size_t)b * MODW) + lane;
    u64* o8 = (u64*)(dst + (size_t)m * DM) + lane;
#pragma unroll
    for (int j = 0; j < 4; ++j) { const f32x4 y = v[j] * gp[64 * j] * (scp[64 * j] + 1.f);
      o8[64 * j] = (u64)cvt_pk_bf16(y.x, y.y) | ((u64)cvt_pk_bf16(y.z, y.w) << 32); }
    if (lane == 0) *(f32x4*)(ssq + (size_t)m * 4) = (f32x4){s, 0.f, 0.f, 0.f};
  }
}

__device__ __forceinline__ float sumsq8(u32x4 w) { float a = 0.f;
  a += bflo(w.x) * bflo(w.x); a += bfhi(w.x) * bfhi(w.x); a += bflo(w.y) * bflo(w.y); a += bfhi(w.y) * bfhi(w.y);
  a += bflo(w.z) * bflo(w.z); a += bfhi(w.z) * bfhi(w.z); a += bflo(w.w) * bflo(w.w); a += bfhi(w.w) * bfhi(w.w); return a; }
__device__ __forceinline__ float group8_sum(float v) { v += __shfl_xor(v, 1); v += __shfl_xor(v, 2); v += __shfl_xor(v, 4); return v; }
constexpr size_t WS_KMAX = WS_BAR + 14336;
__device__ __forceinline__ void phase_prep(const Params& p, int l) {
  const int tid_ = otid(), lane = tid_ & 63, gw = blockIdx.x * 8 + (tid_ >> 6), NGW = gridDim.x * 8;
  bf16_t* proj = (bf16_t*)(p.ws + WS_BIG); bf16_t* mlaa = (bf16_t*)(p.ws + WS_MLAA); bf16_t* krope = (bf16_t*)(p.ws + WS_KROPE); bf16_t* ikn = (bf16_t*)(p.ws + WS_IKN);
  const float* qn = p.q_norm + l * 256; const float* kvn = p.kv_norm + l * 128;
  const float inv = rope_inv(lane & 15);
  const f32x4 gq = *(const f32x4*)(qn + 4 * lane); const f32x2 gkv = *(const f32x2*)(kvn + 2 * lane); const float gik = p.ik_norm[l * 64 + lane];
  unsigned* kmaxp = (unsigned*)(p.ws + WS_KMAX) + l * 256;
  constexpr int TB = 4;
  for (int base = gw * 16; base < MTOK; base += NGW * 16) {
   float kA = 0.f, kC = 0.f;
   for (int tg = 0; tg < 16; tg += TB) {
    u32x2 cqw[TB]; unsigned ckvw[TB]; float kr1[TB], kr2[TB], q1[TB][2], q2[TB][2], ikv[TB], ang[TB]; u32x4 wa[TB], wc[TB];
#pragma unroll
    for (int t = 0; t < TB; ++t) { const int m = base + tg + t; const bf16_t* pr = proj + (size_t)m * INWP;
      cqw[t] = *(const u32x2*)(pr + OFF_CQ + 4 * lane); ckvw[t] = *(const unsigned*)(pr + OFF_CKV + 2 * lane);
      kr1[t] = bf2f(pr[OFF_KR + (lane & 15)]); kr2[t] = bf2f(pr[OFF_KR + 16 + (lane & 15)]);
#pragma unroll
      for (int j = 0; j < 2; ++j) { const int pp = lane + 64 * j; const bf16_t* q = pr + OFF_IQ + (pp >> 4) * 64 + (pp & 15); q1[t][j] = bf2f(q[0]); q2[t][j] = bf2f(q[16]); }
      ikv[t] = bf2f(pr[OFF_IK + lane]);
      wa[t] = *(const u32x4*)(pr + OFF_KA + (lane < 48 ? lane : 0) * 8); wc[t] = *(const u32x4*)(pr + OFF_KC + (lane < 40 ? lane : 0) * 8);
      ang[t] = (float)p.pos[m] * inv; }
    u32x2 cqo[TB]; unsigned ckvo[TB]; unsigned short kro1[TB], kro2[TB], qo1[TB][2], qo2[TB][2], iko[TB];
#pragma unroll
    for (int t = 0; t < TB; ++t) {
      float sn, cs; sincos_big(ang[t], sn, cs);
      kA = fmaxf(kA, group8_sum(sumsq8(wa[t]))); kC = fmaxf(kC, group8_sum(sumsq8(wc[t])));
      { const float a0 = bflo(cqw[t].x), a1 = bfhi(cqw[t].x), a2 = bflo(cqw[t].y), a3 = bfhi(cqw[t].y);
        const float rs = __builtin_amdgcn_rsqf(wave_sum(a0 * a0 + a1 * a1 + a2 * a2 + a3 * a3) * (1.f / 256) + RMS_EPS);
        cqo[t].x = cvt_pk_bf16(a0 * rs * gq.x, a1 * rs * gq.y); cqo[t].y = cvt_pk_bf16(a2 * rs * gq.z, a3 * rs * gq.w); }
      { const float a0 = bflo(ckvw[t]), a1 = bfhi(ckvw[t]);
        const float rs = __builtin_amdgcn_rsqf(wave_sum(a0 * a0 + a1 * a1) * (1.f / 128) + RMS_EPS);
        ckvo[t] = cvt_pk_bf16(a0 * rs * gkv.x, a1 * rs * gkv.y); }
      kro1[t] = f2bf(kr1[t] * cs - kr2[t] * sn); kro2[t] = f2bf(kr2[t] * cs + kr1[t] * sn);
#pragma unroll
      for (int j = 0; j < 2; ++j) { qo1[t][j] = f2bf(q1[t][j] * cs - q2[t][j] * sn); qo2[t][j] = f2bf(q2[t][j] * cs + q1[t][j] * sn); }
      { const float a = ikv[t];
        const float rs = __builtin_amdgcn_rsqf(wave_sum(a * a) * (1.f / 64) + RMS_EPS);
        const float y = a * rs * gik, pa = __shfl_xor(y, 16);
        float o = y;
        if (lane < 16) o = y * cs - pa * sn; else if (lane < 32) o = y * cs + pa * sn;
        iko[t] = f2bf(o); }
    }
#pragma unroll
    for (int t = 0; t < TB; ++t) { const int m = base + tg + t; bf16_t* pr = proj + (size_t)m * INWP;
      *(u32x2*)(mlaa + (size_t)m * MLA_K + 4 * lane) = cqo[t];
      *(unsigned*)(mlaa + (size_t)m * MLA_K + 256 + 2 * lane) = ckvo[t];
      if (lane < 16) { krope[(size_t)m * 32 + lane] = kro1[t]; krope[(size_t)m * 32 + 16 + lane] = kro2[t]; }
#pragma unroll
      for (int j = 0; j < 2; ++j) { const int pp = lane + 64 * j; bf16_t* q = pr + OFF_IQ + (pp >> 4) * 64 + (pp & 15); q[0] = qo1[t][j]; q[16] = qo2[t][j]; }
      ikn[(size_t)m * 64 + lane] = iko[t]; }
   }
   const int bb = base / SEQ;
   if ((lane & 7) == 0) {
     if (lane < 48) __hip_atomic_fetch_max(kmaxp + bb * 16 + (lane >> 3), __builtin_bit_cast(unsigned, kA), __ATOMIC_RELAXED, __HIP_MEMORY_SCOPE_AGENT);
     if (lane < 40) __hip_atomic_fetch_max(kmaxp + bb * 16 + 11 + (lane >> 3), __builtin_bit_cast(unsigned, kC), __ATOMIC_RELAXED, __HIP_MEMORY_SCOPE_AGENT);
   }
  }
}
__device__ __forceinline__ void phase_qrope(const Params& p, int l) {
  const int tid_ = otid(), lane = tid_ & 63, gw = blockIdx.x * 8 + (tid_ >> 6), NGW = gridDim.x * 8;
  bf16_t* mlao = (bf16_t*)(p.ws + WS_MLAO); const bf16_t* krope = (const bf16_t*)(p.ws + WS_KROPE);
  unsigned* kmaxp = (unsigned*)(p.ws + WS_KMAX) + l * 256;
  const float inv = rope_inv(lane & 15);
  constexpr int TB = 4;
  for (int base = gw * 16; base < MTOK; base += NGW * 16) {
   float kM = 0.f;
   for (int tg = 0; tg < 16; tg += TB) {
    u32x4 wn[TB], wr[TB]; float q1[TB][2], q2[TB][2], ang[TB];
#pragma unroll
    for (int t = 0; t < TB; ++t) { const int m = base + tg + t; const int ll = lane < 40 ? lane : 0;
      wn[t] = *(const u32x4*)(mlao + (size_t)m * MLA_N + 480 + (ll >> 3) * 128 + (ll & 7) * 8); wr[t] = *(const u32x4*)(krope + (size_t)m * 32 + (lane & 3) * 8);
#pragma unroll
      for (int j = 0; j < 2; ++j) { const int pp = (lane + 64 * j < 80) ? lane + 64 * j : 0; const bf16_t* q = mlao + (size_t)m * MLA_N + (pp >> 4) * 96 + 64 + (pp & 15); q1[t][j] = bf2f(q[0]); q2[t][j] = bf2f(q[16]); }
      ang[t] = (float)p.pos[m] * inv; }
    unsigned short qo1[TB][2], qo2[TB][2];
#pragma unroll
    for (int t = 0; t < TB; ++t) {
      float sn, cs; sincos_big(ang[t], sn, cs);
      float r2 = sumsq8(wr[t]); r2 += __shfl_xor(r2, 1); r2 += __shfl_xor(r2, 2);
      kM = fmaxf(kM, group8_sum(sumsq8(wn[t])) + r2);
#pragma unroll
      for (int j = 0; j < 2; ++j) { qo1[t][j] = f2bf(q1[t][j] * cs - q2[t][j] * sn); qo2[t][j] = f2bf(q2[t][j] * cs + q1[t][j] * sn); }
    }
#pragma unroll
    for (int t = 0; t < TB; ++t) { const int m = base + tg + t;
#pragma unroll
      for (int j = 0; j < 2; ++j) { const int pp = lane + 64 * j;
        if (pp < 80) { bf16_t* q = mlao + (size_t)m * MLA_N + (pp >> 4) * 96 + 64 + (pp & 15); q[0] = qo1[t][j]; q[16] = qo2[t][j]; } } }
   }
   const int bb = base / SEQ;
   if ((lane & 7) == 0 && lane < 40) __hip_atomic_fetch_max(kmaxp + bb * 16 + 6 + (lane >> 3), __builtin_bit_cast(unsigned, kM), __ATOMIC_RELAXED, __HIP_MEMORY_SCOPE_AGENT);
  }
}

constexpr int SC_STRIDE = 2117;
__device__ __forceinline__ int wave_count(int c) { int t = 0;
#pragma unroll
  for (int b = 0; b < 6; ++b) t += (int)__popcll(__ballot((c >> b) & 1)) << b;
  return t; }
__device__ __forceinline__ unsigned fkey(float v) { const unsigned u = __builtin_bit_cast(unsigned, v + 0.0f); return (u & 0x80000000u) ? ~u : (u | 0x80000000u); }
#define DEF_WCOUNT(NAME, OP) \
__device__ __forceinline__ int NAME(const unsigned (&key)[32], unsigned thr) { \
  int cnt = 0; const unsigned m = __builtin_amdgcn_readfirstlane(thr); \
  _Pragma("unroll") for (int j = 0; j < 32; j += 4) { u64 a, b, c, d; int ta, tb, tc, td; \
    asm volatile("v_cmp_" OP "_u32 %[a], %[k0], %[m]\n\tv_cmp_" OP "_u32 %[b], %[k1], %[m]\n\tv_cmp_" OP "_u32 %[c], %[k2], %[m]\n\tv_cmp_" OP "_u32 %[d], %[k3], %[m]\n\t" \
                 "s_bcnt1_i32_b64 %[ta], %[a]\n\ts_bcnt1_i32_b64 %[tb], %[b]\n\ts_bcnt1_i32_b64 %[tc], %[c]\n\ts_bcnt1_i32_b64 %[td], %[d]\n\t" \
                 "s_add_i32 %[ta], %[ta], %[tb]\n\ts_add_i32 %[tc], %[tc], %[td]\n\ts_add_i32 %[cnt], %[cnt], %[ta]\n\ts_add_i32 %[cnt], %[cnt], %[tc]" \
      : [cnt] "+s"(cnt), [a] "=&s"(a), [b] "=&s"(b), [c] "=&s"(c), [d] "=&s"(d), [ta] "=&s"(ta), [tb] "=&s"(tb), [tc] "=&s"(tc), [td] "=&s"(td) \
      : [k0] "v"(key[j]), [k1] "v"(key[j + 1]), [k2] "v"(key[j + 2]), [k3] "v"(key[j + 3]), [m] "s"(m) : "scc"); } \
  return cnt; }
DEF_WCOUNT(wcount_ge, "ge")
DEF_WCOUNT(wcount_gt, "gt")
DEF_WCOUNT(wcount_eq, "eq")
__device__ __forceinline__ float unfkey(unsigned k) { const unsigned u = (k & 0x80000000u) ? (k & 0x7fffffffu) : ~k; return __builtin_bit_cast(float, u); }
__device__ __forceinline__ void phase_indexer(const Params& p, unsigned char* lds) {
  float* sc = (float*)lds;
  const int tid = otid(), lane = tid & 63, wave = __builtin_amdgcn_readfirstlane(tid >> 6), fr = lane & 15, fq = lane >> 4;
  const bf16_t* proj = (const bf16_t*)(p.ws + WS_BIG); const bf16_t* ikn = (const bf16_t*)(p.ws + WS_IKN); u64* mask = (u64*)(p.ws + WS_MASK);
  constexpr int NITEMS = BATCH * (SEQ / 16);
  for (int it = blockIdx.x; it < NITEMS; it += gridDim.x) {
    const int b = it % BATCH, qg = (SEQ / 16 - 1) - it / BATCH, t0 = qg * 16;
    const size_t rowb = (size_t)b * SEQ;
    if (t0 + 16 <= 256) {
      if (lane < 32) { mask[(rowb + t0 + 2 * wave) * 32 + lane] = ~0ull; mask[(rowb + t0 + 2 * wave + 1) * 32 + lane] = ~0ull; }
      continue;
    }
    __syncthreads();
    {
      const bf16_t* qrow = proj + (rowb + t0 + fr) * INWP;
      bf16x8 qf[8][2];
#pragma unroll
      for (int h = 0; h < 8; ++h)
#pragma unroll
        for (int s = 0; s < 2; ++s) qf[h][s] = *(const bf16x8*)(qrow + OFF_IQ + h * 64 + s * 32 + fq * 8);
      float wq[8];
      { const u32x4 w = *(const u32x4*)(qrow + OFF_IW); const float cw = 0.04419417382415922f;
        wq[0] = bflo(w.x) * cw; wq[1] = bfhi(w.x) * cw; wq[2] = bflo(w.y) * cw; wq[3] = bfhi(w.y) * cw; wq[4] = bflo(w.z) * cw; wq[5] = bfhi(w.z) * cw; wq[6] = bflo(w.w) * cw; wq[7] = bfhi(w.w) * cw; }
      const int nkt = qg + 1;
      bf16x8 ka[4][2], kb[4][2];
#define IDX_LOAD(X, base) do { _Pragma("unroll") for (int g = 0; g < 4; ++g) { int kk = (base) + 8 * g; kk = (kk < nkt) ? kk : 0; \
          const bf16_t* krow = ikn + (rowb + kk * 16 + fr) * 64 + fq * 8; X[g][0] = *(const bf16x8*)krow; X[g][1] = *(const bf16x8*)(krow + 32); } } while (0)
#define IDX_COMP(X, base) do { _Pragma("unroll") for (int g = 0; g < 4; ++g) { const int kk = (base) + 8 * g; if (kk < nkt) { \
          f32x4 a[8]; \
          _Pragma("unroll") for (int h = 0; h < 8; ++h) a[h] = __builtin_amdgcn_mfma_f32_16x16x32_bf16(X[g][0], qf[h][0], (f32x4){0.f, 0.f, 0.f, 0.f}, 0, 0, 0); \
          _Pragma("unroll") for (int h = 0; h < 8; ++h) a[h] = __builtin_amdgcn_mfma_f32_16x16x32_bf16(X[g][1], qf[h][1], a[h], 0, 0, 0); \
          f32x4 s4 = (f32x4){0.f, 0.f, 0.f, 0.f}; \
          _Pragma("unroll") for (int h = 0; h < 8; ++h) _Pragma("unroll") for (int jj = 0; jj < 4; ++jj) s4[jj] = __builtin_fmaf(wq[h], __builtin_amdgcn_fmed3f(a[h][jj], 0.f, __builtin_inff()), s4[jj]); \
          const int c0 = kk * 16 + fq * 4; float* dp = sc + fr * SC_STRIDE + c0 + (c0 >> 5); dp[0] = s4[0]; dp[1] = s4[1]; dp[2] = s4[2]; dp[3] = s4[3]; } } } while (0)
      int kt = wave;
      IDX_LOAD(ka, kt);
#pragma unroll 1
      while (kt < nkt) {
        IDX_LOAD(kb, kt + 32);
        IDX_COMP(ka, kt);
        kt += 32;
        if (kt >= nkt) break;
        IDX_LOAD(ka, kt + 32);
        IDX_COMP(kb, kt);
        kt += 32;
      }
#undef IDX_LOAD
#undef IDX_COMP
    }
    __syncthreads();
    for (int rr = 0; rr < 2; ++rr) {
      const int r = 2 * wave + rr, t = t0 + r;
      unsigned key[32];
      float kv[32];
#pragma unroll
      for (int j = 0; j < 32; ++j) kv[j] = sc[r * SC_STRIDE + lane * 33 + j];
#pragma unroll
      for (int j = 0; j < 32; ++j) asm volatile("" : "+v"(kv[j]));
#pragma unroll
      for (int j = 0; j < 32; ++j) { const int idx = lane * 32 + j; key[j] = (idx <= t) ? fkey(kv[j]) : 0u; }
      unsigned kmx = 0u, kmn = 0xffffffffu;
#pragma unroll
      for (int j = 0; j < 32; ++j) { kmx = max(kmx, key[j]); kmn = min(kmn, key[j] ? key[j] : 0xffffffffu); }
#pragma unroll
      for (int o = 1; o < 64; o <<= 1) { kmx = max(kmx, (unsigned)__shfl_xor((int)kmx, o)); kmn = min(kmn, (unsigned)__shfl_xor((int)kmn, o)); }
      unsigned lo = kmn, hi = kmx + 1u; int clo = t + 1, chi = 0;
#pragma unroll 1
      for (int itn = 0; itn < 128; ++itn) {
        if (clo == 256 || hi - lo <= 1u || clo - chi <= 64) break;
        unsigned mid;
        if (itn % 3 == 2) mid = lo + ((hi - lo) >> 1);
        else { const float flo = unfkey(lo), fhi = unfkey(hi - 1u); const int gap = clo - chi;
          const float off = (gap <= 8) ? 0.5f : fminf((float)gap * 0.125f, 16.f);
          const float tgt = 256.f + (((clo - 256) > (256 - chi)) ? off : -off);
          const float fm = flo + (fhi - flo) * (((float)clo - tgt) / (float)gap);
          mid = fkey(fm); }
        mid = max(lo + 1u, min(mid, hi - 1u));
        const int c = wcount_ge(key, mid);
        if (c >= 256) { lo = mid; clo = c; } else { hi = mid; chi = c; }
      }
      if (clo != 256 && hi - lo > 1u && clo - chi <= 64) {
        unsigned* cand = (unsigned*)(sc + r * SC_STRIDE);
        const unsigned range = hi - lo;
        int cl = 0;
#pragma unroll
        for (int j = 0; j < 32; ++j) cl += (key[j] - lo < range) ? 1 : 0;
        int incl = cl;
#pragma unroll
        for (int o = 1; o < 64; o <<= 1) { const int v = __shfl_up(incl, o); if (lane >= o) incl += v; }
        int pos = incl - cl;
        asm volatile("s_waitcnt lgkmcnt(0)" ::: "memory");
#pragma unroll
        for (int j = 0; j < 32; ++j) { if (key[j] - lo < range) { cand[pos] = key[j]; ++pos; } }
        asm volatile("s_waitcnt lgkmcnt(0)" ::: "memory");
        const int m = clo - chi;
        const unsigned x = (lane < m) ? cand[lane] : 0u;
        int g = 0, e = 0;
#pragma unroll 4
        for (int i = 0; i < m; ++i) { const unsigned y = (unsigned)__builtin_amdgcn_readlane((int)x, i); g += (y > x) ? 1 : 0; e += (y == x) ? 1 : 0; }
        const u64 bal = __ballot(lane < m && chi + g < 256 && chi + g + e >= 256);
        lo = (unsigned)__builtin_amdgcn_readlane((int)x, (int)__builtin_ctzll(bal | (1ull << 63)));
      }
      const unsigned T = lo;
      const int cgt = wcount_gt(key, T), ceq = wcount_eq(key, T);
      const int need = 256 - cgt;
      int cutoff = 4096;
      if (ceq > need) {
        int ceql = 0;
#pragma unroll
        for (int j = 0; j < 32; ++j) ceql += (key[j] == T) ? 1 : 0;
        int incl = ceql;
#pragma unroll
        for (int o = 1; o < 64; o <<= 1) { const int v = __shfl_up(incl, o); if (lane >= o) incl += v; }
        const int excl = incl - ceql;
        int mycut = 4096;
        if (excl < need && incl >= need) { int k = need - excl;
#pragma unroll
          for (int j = 0; j < 32; ++j) { if (key[j] == T) { --k; if (k == 0) mycut = lane * 32 + j; } } }
#pragma unroll
        for (int o = 1; o < 64; o <<= 1) mycut = min(mycut, __shfl_xor(mycut, o));
        cutoff = mycut;
      }
      unsigned W = 0u;
#pragma unroll
      for (int j = 0; j < 32; ++j) { const int idx = lane * 32 + j; W |= ((key[j] > T || (key[j] == T && idx <= cutoff)) ? 1u : 0u) << j; __builtin_amdgcn_sched_barrier(0); }
      ((unsigned*)mask)[(rowb + t) * 64 + lane] = W;
    }
  }
  __syncthreads();
}

constexpr int KROW = 208, VROW = 144;
constexpr int AT_BUF = 64 * KROW + 64 * VROW;
constexpr int AT_VOFF = 64 * KROW, AT_TAB = 2 * AT_BUF, TAB_PAD = 96, AT_END = AT_TAB + (2048 + TAB_PAD) * 4;
constexpr float LOG2E = 1.4426950408889634f;
__device__ __forceinline__ s16x4 vtr(const LAS unsigned char* ptr) { return __builtin_bit_cast(s16x4, __builtin_amdgcn_ds_read_tr16_b64_v4i16((LAS s16x4*)ptr)); }

template <int KS, int TYPE>
__device__ __forceinline__ void attn_item(const Params& p, unsigned char* lds, int b, int head, int qb, int l) {
  const int tid = otid(), lane = tid & 63, wave = __builtin_amdgcn_readfirstlane(tid >> 6), fr = lane & 15, fq = lane >> 4;
  const bf16_t* proj = (const bf16_t*)(p.ws + WS_BIG); const bf16_t* mlao = (const bf16_t*)(p.ws + WS_MLAO);
  const bf16_t* Qp; const bf16_t* Kp; const bf16_t* Vp; int qpitch, kpitch; float c2;
  const size_t rowb = (size_t)b * SEQ;
  if (TYPE == 0) { Qp = proj + OFF_QA + head * 64; Kp = proj + OFF_KA + head * 64; Vp = proj + OFF_VA + head * 64; qpitch = kpitch = INWP; c2 = 0.125f * LOG2E; }
  else if (TYPE == 1) { const int hb = head - 6; Qp = mlao + hb * 96; Kp = mlao + 480 + hb * 128; Vp = Kp + 64; qpitch = kpitch = MLA_N; c2 = 0.10206207261596575f * LOG2E; }
  else { const int hc = head - 11; Qp = proj + OFF_QC + hc * 64; Kp = proj + OFF_KC + hc * 64; Vp = proj + OFF_VC + hc * 64; qpitch = kpitch = INWP; c2 = 0.125f * LOG2E; }
  const bf16_t* K2p = (const bf16_t*)(p.ws + WS_KROPE);
  const u64* mask = (const u64*)(p.ws + WS_MASK);
  float* tab = (float*)(lds + AT_TAB);
  LAS unsigned char* l3 = (LAS unsigned char*)lds;

  __syncthreads();
  if (TYPE != 1) {
    const int col = (TYPE == 0) ? head : (head - 11 + 6);
    for (int e = tid; e < 2048 + TAB_PAD; e += 512) {
      const int d = e - TAB_PAD; float v = NEGV;
      if (d >= 0) { v = p.rel_bias[t5_bucket(d) * 11 + col];
        if (TYPE == 0) { const int mult = (d <= 128) + ((d & 3) == 0 && d <= 512) + ((d & 15) == 0);
          v = (mult == 0) ? NEGV : v + (mult == 1 ? 0.f : (mult == 2 ? 0.6931471805599453f : 1.0986122886681098f)); }
        v = (v <= -1e29f) ? NEGV : v * LOG2E; }
      tab[e] = v;
    }
  }
  const int q0 = qb * 256 + wave * 32;
  bf16x8 qf[2][KS];
#pragma unroll
  for (int u = 0; u < 2; ++u)
#pragma unroll
    for (int s = 0; s < KS; ++s) qf[u][s] = *(const bf16x8*)(Qp + (rowb + q0 + u * 16 + fr) * qpitch + s * 32 + fq * 8);
  float tabmax = 0.f;
  if (TYPE != 1) { const int col = (TYPE == 0) ? head : (head - 11 + 6);
    float tv = p.rel_bias[(lane & 31) * 11 + col];
#pragma unroll
    for (int o_ = 1; o_ < 32; o_ <<= 1) tv = fmaxf(tv, __shfl_xor(tv, o_));
    tabmax = tv * LOG2E + (TYPE == 0 ? 1.5849625007211563f : 0.f); }
  const float kmax = sqrtf(__builtin_bit_cast(float, ((const unsigned*)(p.ws + WS_KMAX))[l * 256 + b * 16 + head]));
  f32x4 o[4][2]; float sinit[2], lrow[2];
#pragma unroll
  for (int u = 0; u < 2; ++u) {
    float q2 = 0.f;
#pragma unroll
    for (int s_ = 0; s_ < KS; ++s_) q2 += sumsq8(__builtin_bit_cast(u32x4, qf[u][s_]));
    q2 += __shfl_xor(q2, 16); q2 += __shfl_xor(q2, 32);
    sinit[u] = -(sqrtf(q2) * kmax * 1.0001f + tabmax / c2 + 1e-3f);
    lrow[u] = 0.f;
#pragma unroll
    for (int dt = 0; dt < 4; ++dt) o[dt][u] = (f32x4){0.f, 0.f, 0.f, 0.f}; }

  const int nkt = (qb + 1) * 4;
  const int lkey = tid >> 3, lch = tid & 7;
  u32x4 kreg, vreg, k2reg; u64 mreg[2] = {0ull, 0ull};
#define AT_PREFETCH(kt_) do { const size_t r_ = rowb + (kt_) * 64 + lkey; \
    kreg = *(const u32x4*)(Kp + r_ * kpitch + lch * 8); vreg = *(const u32x4*)(Vp + r_ * kpitch + lch * 8); \
    if (KS == 3) { if (tid < 256) k2reg = *(const u32x4*)(K2p + (rowb + (kt_) * 64 + (tid >> 2)) * 32 + (tid & 3) * 8); } \
    if (TYPE == 2) { mreg[0] = mask[(rowb + q0 + fr) * 32 + (kt_)]; mreg[1] = mask[(rowb + q0 + 16 + fr) * 32 + (kt_)]; } } while (0)
#define AT_STORE(bufo_) do { *(u32x4*)(lds + (bufo_) + lkey * KROW + lch * 16) = kreg; *(u32x4*)(lds + (bufo_) + AT_VOFF + lkey * VROW + lch * 16) = vreg; \
    if (KS == 3) { if (tid < 256) *(u32x4*)(lds + (bufo_) + (tid >> 2) * KROW + 128 + (tid & 3) * 16) = k2reg; } } while (0)
  AT_PREFETCH(0);
  AT_STORE(0);
  __syncthreads();
  float tvfar[4] = {0.f, 0.f, 0.f, 0.f};
  if (TYPE != 1) { const float bfar = tab[TAB_PAD + (TYPE == 0 ? 2032 : 2047)];
#pragma unroll
    for (int j = 0; j < 4; ++j) tvfar[j] = (TYPE == 2 || ((fr - 4 * fq - j) & 15) == 0) ? bfar : NEGV; }
#pragma unroll 1
  for (int kt = 0; kt < nkt; ++kt) {
    const int bufo = (kt & 1) * AT_BUF;
    const u64 mcur0 = mreg[0], mcur1 = mreg[1];
    if (kt + 1 < nkt) AT_PREFETCH(kt + 1);
    const int kbase = kt * 64;
    if (kbase <= q0 + 31) {
      bf16x8 kf[4][KS];
#pragma unroll
      for (int k16 = 0; k16 < 4; ++k16)
#pragma unroll
        for (int ss = 0; ss < KS; ++ss) kf[k16][ss] = *(const LAS bf16x8*)(l3 + bufo + (k16 * 16 + fr) * KROW + ss * 64 + fq * 16);
      float tv[2][16];
      if (TYPE != 1) {
        if (q0 - kbase - 63 >= (TYPE == 0 ? 513 : 113)) {
#pragma unroll
          for (int u = 0; u < 2; ++u)
#pragma unroll
            for (int k16 = 0; k16 < 4; ++k16)
#pragma unroll
              for (int j = 0; j < 4; ++j) tv[u][k16 * 4 + j] = tvfar[j];
        } else {
#pragma unroll
          for (int u = 0; u < 2; ++u) { const float* tp = tab + (q0 + u * 16 + fr - kbase + TAB_PAD - fq * 4);
#pragma unroll
            for (int k16 = 0; k16 < 4; ++k16)
#pragma unroll
              for (int j = 0; j < 4; ++j) tv[u][k16 * 4 + j] = tp[-(k16 * 16 + j)]; }
        }
      }
      __builtin_amdgcn_sched_barrier(0);
      f32x4 s[4][2];
#pragma unroll
      for (int k16 = 0; k16 < 4; ++k16) {
        s[k16][0] = (f32x4){sinit[0], sinit[0], sinit[0], sinit[0]}; s[k16][1] = (f32x4){sinit[1], sinit[1], sinit[1], sinit[1]};
#pragma unroll
        for (int ss = 0; ss < KS; ++ss) {
          s[k16][0] = __builtin_amdgcn_mfma_f32_16x16x32_bf16(kf[k16][ss], qf[0][ss], s[k16][0], 0, 0, 0);
          s[k16][1] = __builtin_amdgcn_mfma_f32_16x16x32_bf16(kf[k16][ss], qf[1][ss], s[k16][1], 0, 0, 0);
        }
      }
      __builtin_amdgcn_sched_barrier(0);
      s16x4 vv[2][4][2];
#pragma unroll
      for (int kc = 0; kc < 2; ++kc)
#pragma unroll
        for (int dt = 0; dt < 4; ++dt) {
          const LAS unsigned char* vb = l3 + bufo + AT_VOFF + (kc * 32 + 4 * fq + (fr >> 2)) * VROW + (dt * 16 + 4 * (fr & 3)) * 2;
          vv[kc][dt][0] = vtr(vb); vv[kc][dt][1] = vtr(vb + 16 * VROW);
        }
      __builtin_amdgcn_sched_barrier(0);
      const bool diag = (kbase + 63 > q0);
      bf16x8 pb[2][2];
#pragma unroll
      for (int u = 0; u < 2; ++u) {
        const int qpos = q0 + u * 16 + fr;
        unsigned wlo = 0u, whi = 0u;
        if (TYPE == 2) { const u64 mw = u ? mcur1 : mcur0; wlo = (unsigned)mw >> (fq * 4); whi = (unsigned)(mw >> 32) >> (fq * 4); }
        float ps = 0.f;
#pragma unroll
        for (int k16 = 0; k16 < 4; ++k16)
#pragma unroll
          for (int j = 0; j < 4; ++j) {
            float v;
            if (TYPE != 1) v = __builtin_fmaf(s[k16][u][j], c2, tv[u][k16 * 4 + j]);
            else { v = s[k16][u][j] * c2; if (diag) v = (kbase + k16 * 16 + fq * 4 + j > qpos) ? NEGV : v; }
            float e = __builtin_amdgcn_exp2f(v);
            if (TYPE == 2) { unsigned sel; asm("v_bfe_i32 %0, %1, %2, 1" : "=v"(sel) : "v"((k16 < 2) ? wlo : whi), "n"((k16 & 1) * 16 + j));
              e = __builtin_bit_cast(float, __builtin_bit_cast(unsigned, e) & sel); }
            s[k16][u][j] = e; ps += e;
          }
        lrow[u] += ps;
#pragma unroll
        for (int kc = 0; kc < 2; ++kc) {
          u32x4 w; w.x = cvt_pk_bf16(s[2 * kc][u][0], s[2 * kc][u][1]); w.y = cvt_pk_bf16(s[2 * kc][u][2], s[2 * kc][u][3]);
          w.z = cvt_pk_bf16(s[2 * kc + 1][u][0], s[2 * kc + 1][u][1]); w.w = cvt_pk_bf16(s[2 * kc + 1][u][2], s[2 * kc + 1][u][3]);
          pb[u][kc] = __builtin_bit_cast(bf16x8, w);
        }
      }
#pragma unroll
      for (int kc = 0; kc < 2; ++kc)
#pragma unroll
        for (int dt = 0; dt < 4; ++dt) {
          const bf16x8 vf = __builtin_shufflevector(vv[kc][dt][0], vv[kc][dt][1], 0, 1, 2, 3, 4, 5, 6, 7);
          o[dt][0] = __builtin_amdgcn_mfma_f32_16x16x32_bf16(vf, pb[0][kc], o[dt][0], 0, 0, 0);
          o[dt][1] = __builtin_amdgcn_mfma_f32_16x16x32_bf16(vf, pb[1][kc], o[dt][1], 0, 0, 0);
        }
    }
    if (kt + 1 < nkt) AT_STORE(AT_BUF - bufo);
    __syncthreads();
  }
#undef AT_PREFETCH
#undef AT_STORE
  bf16_t* outp = (bf16_t*)(p.ws + WS_NB);
#pragma unroll
  for (int u = 0; u < 2; ++u) {
    float l = lrow[u]; l += __shfl_xor(l, 16); l += __shfl_xor(l, 32);
    const float il = 1.f / l;
    bf16_t* orow = outp + (rowb + q0 + u * 16 + fr) * DM + head * 64 + fq * 4;
#pragma unroll
    for (int dt = 0; dt < 4; ++dt) { u32x2 w; w.x = cvt_pk_bf16(o[dt][u][0] * il, o[dt][u][1] * il); w.y = cvt_pk_bf16(o[dt][u][2] * il, o[dt][u][3] * il);
      *(u32x2*)(orow + dt * 16) = w; }
  }
}
__device__ __forceinline__ void phase_attn(const Params& p, unsigned char* lds, int l) {
  constexpr int NITEMS = BATCH * 16 * 8;
  for (int it = blockIdx.x; it < NITEMS; it += gridDim.x) {
    const int r = it >> 8, c = it & 255;
    const int qb = (r & 1) ? (r >> 1) : 7 - (r >> 1), b = c >> 4, head = ((c & 15) + 2 * r) & 15;
    if (head < 6) attn_item<2, 0>(p, lds, b, head, qb, l);
    else if (head < 11) attn_item<3, 1>(p, lds, b, head, qb, l);
    else attn_item<2, 2>(p, lds, b, head, qb, l);
  }
  __syncthreads();
}

#define XB_TMO      128
#define XB_XCNT(j)  (256  + 64 * (j))
#define XB_XSUB(j)  (1280 + 64 * (j))
#define XB_XGEN(j)  (2304 + 64 * (j))
#define XB_TOP      3328
#define XB_TOPGEN   3392
#define XCD_BAR_WORDS 3456
#define XB_SPIN_CAP (1u << 18)
__device__ __forceinline__ unsigned xb_ld(unsigned* p)              { return __hip_atomic_load(p, __ATOMIC_RELAXED, __HIP_MEMORY_SCOPE_AGENT); }
__device__ __forceinline__ unsigned xb_add(unsigned* p, unsigned v) { return __hip_atomic_fetch_add(p, v, __ATOMIC_RELAXED, __HIP_MEMORY_SCOPE_AGENT); }
__device__ __forceinline__ unsigned xb_xcc_id() { return (unsigned)__builtin_amdgcn_s_getreg((3 << 11) | 20) & 0xFu; }
#define XB_SPIN(cond, bar) do { unsigned _sp = 0; while (cond) { __builtin_amdgcn_s_sleep(1); \
    if ((++_sp & 255u) == 0u) { if (xb_ld(&(bar)[XB_TMO])) break; if (_sp > XB_SPIN_CAP) { atomicAdd(&(bar)[XB_TMO], 1u); break; } } } } while (0)
struct XcdBarrier { unsigned* bar; unsigned x; volatile LAS unsigned* st; };
__device__ __forceinline__ XcdBarrier xcd_barrier_post(unsigned* bar, volatile LAS unsigned* st) {
  XcdBarrier b; b.bar = bar; b.x = xb_xcc_id(); b.st = st;
  if (threadIdx.x == 0) (void)xb_add(&bar[XB_XCNT(b.x)], 1u);
  return b;
}
__device__ __forceinline__ void xcd_barrier_complete(unsigned* bar, unsigned x, unsigned& nloc, unsigned& nx) {
  const unsigned G = gridDim.x * gridDim.y * gridDim.z;
  unsigned sum, cnt, mine, sp = 0u;
  for (;;) {
    sum = 0u; cnt = 0u; mine = 0u;
#pragma unroll
    for (unsigned j = 0; j < 16; ++j) { const unsigned c = xb_ld(&bar[XB_XCNT(j)]); sum += c; cnt += (c > 0u) ? 1u : 0u; mine = (j == x) ? c : mine; }
    if (sum == G) break;
    __builtin_amdgcn_s_sleep(1);
    if ((++sp & 255u) == 0u) { if (xb_ld(&bar[XB_TMO])) break; if (sp > XB_SPIN_CAP) { atomicAdd(&bar[XB_TMO], 1u); break; } }
  }
  nloc = mine > 0u ? mine : 1u; nx = cnt > 0u ? cnt : 1u;
}
__device__ __forceinline__ void xcd_barrier(const XcdBarrier& b) {
  asm volatile("s_waitcnt vmcnt(0)" ::: "memory");
  __syncthreads();
  if (threadIdx.x == 0) {
    unsigned* bar = b.bar;
    __builtin_amdgcn_s_waitcnt(0);
    unsigned nloc = b.st[0], nx = b.st[1];
    if (nloc == 0u) { xcd_barrier_complete(bar, b.x, nloc, nx); b.st[0] = nloc; b.st[1] = nx; }
    const unsigned old = xb_add(&bar[XB_XSUB(b.x)], 1u);
    const unsigned gen = old / nloc;
    if (old + 1u == (gen + 1u) * nloc) {
      __builtin_amdgcn_fence(__ATOMIC_RELEASE, "agent");
      asm volatile("s_waitcnt vmcnt(0)" ::: "memory");
      const unsigned og = xb_add(&bar[XB_TOP], 1u);
      const unsigned tg = og / nx;
      if (og + 1u == (tg + 1u) * nx) xb_add(&bar[XB_TOPGEN], 1u);
      else XB_SPIN(xb_ld(&bar[XB_TOPGEN]) == tg, bar);
      __builtin_amdgcn_fence(__ATOMIC_ACQUIRE, "agent");
      xb_add(&bar[XB_XGEN(b.x)], 1u);
      asm volatile("s_waitcnt vmcnt(0)" ::: "memory");
    } else {
      XB_SPIN(xb_ld(&bar[XB_XGEN(b.x)]) == gen, bar);
      __builtin_amdgcn_fence(__ATOMIC_ACQUIRE, "agent");
      asm volatile("s_waitcnt vmcnt(0)" ::: "memory");
    }
  }
  __syncthreads();
}

#ifndef PHMASK
#define PHMASK 0xFFFFu
#endif
#ifndef DUPMASK
#define DUPMASK 0u
#endif
__global__ void __launch_bounds__(512) mega(Params p_unused) {
#if defined(__HIP_DEVICE_COMPILE__)
  extern __shared__ __attribute__((aligned(16))) unsigned char lds[];
  cg::grid_group grid = cg::this_grid();
  { volatile LAS unsigned* st = (volatile LAS unsigned*)((LAS unsigned char*)lds + (LDS_BYTES - 16)); if (threadIdx.x < 2) st[threadIdx.x] = 0u; }
  __syncthreads();
  (void)xcd_barrier_post((unsigned*)((*kparams()).ws + WS_BAR), (volatile LAS unsigned*)((LAS unsigned char*)lds + (LDS_BYTES - 16)));
  int nsteps = 3 + 10 * DEPTH + 1;
  asm volatile("" : "+s"(nsteps));
#pragma unroll 1
  for (int step = 0; step < nsteps; ++step) {
    const Params p = *kparams();
    if (step == 0) { phase0(p, lds); }
    else if (step == 1) { phase_mod_reduce(p); }
    else if (step == 2) { phase_cvec(p); phase_norm0(p.x, p.norm_ffn1, (const float*)(p.ws + WS_MOD) + 1 * DM, (bf16_t*)(p.ws + WS_NB), (float*)(p.ws + WS_SSQ)); }
    else if (step == nsteps - 1) { phase_final_norm(p.out, p.final_norm); }
    else {
      const int l = (step - 3) / 10, si = (step - 3) % 10, sub = si + 1 + (si >= 2) + (si >= 8);
      unsigned char* wl = p.ws + WS_W + (size_t)l * WL_STRIDE;
      const float* mod = (const float*)(p.ws + WS_MOD) + (size_t)l * 16 * MODW;
      const float* hin = (l == 0) ? p.x : p.out;
      bf16_t* NB = (bf16_t*)(p.ws + WS_NB); bf16_t* BIG = (bf16_t*)(p.ws + WS_BIG); bf16_t* HID2 = (bf16_t*)(p.ws + WS_BIG + 64 * MiB);
      float* ssq = (float*)(p.ws + WS_SSQ); const float* cvl = (const float*)(p.ws + WS_CV) + (size_t)l * 3 * CV_STRIDE;
      if (sub == 5) { phase_prep(p, l); }
      else if (sub == 7) { phase_qrope(p, l); phase_indexer(p, lds); }
      else if (sub == 8) { phase_attn(p, lds, l); }
      else {
        const bool isgu = (sub == 1 || sub == 11), isdn = (sub == 2 || sub == 12);
        const bf16_t* A = (sub == 2 || sub == 11) ? BIG : (sub == 12) ? HID2 : (sub == 6) ? (const bf16_t*)(p.ws + WS_MLAA) : NB;
        const size_t wo = (sub == 1) ? WO_GU1 : (sub == 11) ? WO_GU2 : (sub == 2) ? WO_D1 : (sub == 12) ? WO_D2 : (sub == 4) ? WO_IN : (sub == 6) ? WO_MLA : WO_OUT;
        const bf16_t* Bt = (const bf16_t*)(wl + wo);
        const int N = isgu ? NGU : (sub == 4) ? INWP : (sub == 6) ? MLA_N : DM, K = isdn ? DFF : (sub == 6) ? MLA_K : DM;
        pg8::EpiDyn E; E.sub = sub; E.l = l;
        run_gemm(lds, A, Bt, N, K, E);
      }
    }
    if (step == 0) grid.sync();
    else { XcdBarrier xbar; xbar.bar = (unsigned*)((*kparams()).ws + WS_BAR); xbar.x = xb_xcc_id(); xbar.st = (volatile LAS unsigned*)((LAS unsigned char*)lds + (LDS_BYTES - 16)); xcd_barrier(xbar); }
  }
#endif
}

extern "C" void kernel_launch(void* const* d_in, const int* in_sizes, int n_in, void* d_out, int out_size, void* d_ws, size_t ws_size, hipStream_t stream) {
  static int grid_blocks = 0;
  if (!grid_blocks) {
    int dev = 0, cus = 0, per_cu = 0;
    (void)hipGetDevice(&dev);
    (void)hipDeviceGetAttribute(&cus, hipDeviceAttributeMultiprocessorCount, dev);
    (void)hipFuncSetAttribute((const void*)mega, hipFuncAttributeMaxDynamicSharedMemorySize, LDS_BYTES);
    (void)hipOccupancyMaxActiveBlocksPerMultiprocessor(&per_cu, (const void*)mega, 512, LDS_BYTES);
    if (per_cu < 1) per_cu = 1;
    grid_blocks = cus * per_cu;
    if (ws_size < WS_END) fprintf(stderr, "kernel_launch: workspace too small: %zu < %zu\n", ws_size, (size_t)WS_END);
  }
  Params p{};
  p.x = (const float*)d_in[0]; p.c = (const float*)d_in[1]; p.pos = (const int*)d_in[2]; p.rel_bias = (const float*)d_in[3]; p.ada_w = (const float*)d_in[4]; p.ada_b = (const float*)d_in[5];
  p.norm_ffn1 = (const float*)d_in[6]; p.ffn1_gu = (const float*)d_in[7]; p.ffn1_down = (const float*)d_in[8]; p.norm_mix = (const float*)d_in[9]; p.w_in = (const float*)d_in[10];
  p.q_norm = (const float*)d_in[11]; p.w_uq = (const float*)d_in[12]; p.kv_norm = (const float*)d_in[13]; p.w_ukv = (const float*)d_in[14]; p.ik_norm = (const float*)d_in[15]; p.w_out = (const float*)d_in[16];
  p.norm_ffn2 = (const float*)d_in[17]; p.ffn2_gu = (const float*)d_in[18]; p.ffn2_down = (const float*)d_in[19]; p.final_norm = (const float*)d_in[20];
  p.out = (float*)d_out; p.ws = (unsigned char*)d_ws;
  (void)hipMemsetAsync((unsigned char*)d_ws + WS_BAR, 0, 16384, stream);
  void* args[] = {&p};
  hipError_t e = hipLaunchCooperativeKernel((void*)mega, dim3(grid_blocks), dim3(512), args, LDS_BYTES, stream);
  if (e != hipSuccess) fprintf(stderr, "cooperative launch failed: %s (grid %d)\n", hipGetErrorString(e), grid_blocks);
}
```

```cpp
#include <hip/hip_runtime.h>
#include <hip/hip_cooperative_groups.h>
#include <cstdio>
#include <cstdint>
namespace cg = cooperative_groups;

#define LAS __attribute__((address_space(3)))
typedef unsigned short bf16_t;
typedef short bf16x8 __attribute__((ext_vector_type(8)));
typedef short s16x4 __attribute__((ext_vector_type(4)));
typedef float f32x4 __attribute__((ext_vector_type(4)));
typedef float f32x2 __attribute__((ext_vector_type(2)));
typedef unsigned u32x4 __attribute__((ext_vector_type(4)));
typedef unsigned u32x2 __attribute__((ext_vector_type(2)));
typedef unsigned long long u64;

constexpr int BATCH = 16, SEQ = 2048, DM = 1024, MTOK = BATCH * SEQ, DFF = 2816, NGU = 2 * DFF, INW = 3112, INWP = 3328, NMOD = 9, DEPTH = 2;
constexpr int OFF_QA = 0, OFF_KA = 384, OFF_VA = 768, OFF_CQ = 1152, OFF_CKV = 1408, OFF_KR = 1536, OFF_QC = 1568, OFF_KC = 1888, OFF_VC = 2208, OFF_IQ = 2528, OFF_IK = 3040, OFF_IW = 3104;
constexpr int MLA_K = 384, MLA_N = 1280;
constexpr int MODW = NMOD * DM;
constexpr float RMS_EPS = 1e-6f;
constexpr float NEGV = -1e30f;

constexpr size_t MiB = 1ull << 20;
constexpr size_t WS_NB = 0;
constexpr size_t WS_BIG = 64 * MiB;
constexpr size_t WS_MLAA = 272 * MiB;
constexpr size_t WS_MLAO = 296 * MiB;
constexpr size_t WS_KROPE = 376 * MiB;
constexpr size_t WS_IKN = 378 * MiB;
constexpr size_t WS_MASK = 382 * MiB;
constexpr size_t WS_MOD = 390 * MiB;
constexpr size_t WS_ADAP = 392 * MiB;
constexpr size_t WS_W = 402 * MiB;
constexpr size_t WL_STRIDE = 43 * MiB;
constexpr size_t WO_GU1 = 0, WO_D1 = 11 * MiB, WO_IN = 11 * MiB + 5632 * 1024, WO_MLA = WO_IN + (size_t)INWP * 1024 * 2, WO_OUT = WO_MLA + 1 * MiB, WO_GU2 = WO_OUT + 2 * MiB, WO_D2 = WO_GU2 + 11 * MiB;
static_assert(WO_D2 + 5632 * 1024 <= WL_STRIDE, "weights map");
constexpr size_t WS_BAR = WS_W + 2 * WL_STRIDE;
constexpr size_t WS_SSQ = WS_BAR + 1 * MiB;
constexpr size_t WS_CV = WS_SSQ + 1 * MiB;
constexpr size_t CV_STRIDE = 16 * 5632;
constexpr size_t WS_END = WS_CV + 4 * MiB;

constexpr int LDS_BYTES = 143360;

struct Params {
  const float* x; const float* c; const int* pos; const float* rel_bias; const float* ada_w; const float* ada_b;
  const float* norm_ffn1; const float* ffn1_gu; const float* ffn1_down; const float* norm_mix; const float* w_in;
  const float* q_norm; const float* w_uq; const float* kv_norm; const float* w_ukv; const float* ik_norm; const float* w_out;
  const float* norm_ffn2; const float* ffn2_gu; const float* ffn2_down; const float* final_norm;
  float* out; unsigned char* ws;
};

__device__ __forceinline__ unsigned cvt_pk_bf16(float lo, float hi) { unsigned r; asm volatile("v_cvt_pk_bf16_f32 %0, %1, %2" : "=v"(r) : "v"(lo), "v"(hi)); return r; }
__device__ __forceinline__ float bf2f(unsigned short h) { return __builtin_bit_cast(float, (unsigned)h << 16); }
__device__ __forceinline__ float bflo(unsigned w) { return __builtin_bit_cast(float, w << 16); }
__device__ __forceinline__ float bfhi(unsigned w) { return __builtin_bit_cast(float, w & 0xffff0000u); }
__device__ __forceinline__ unsigned short f2bf(float f) { return (unsigned short)(cvt_pk_bf16(f, 0.f) & 0xffffu); }
__device__ __forceinline__ int otid() { int t = threadIdx.x; asm volatile("" : "+v"(t)); return t; }
__device__ __forceinline__ float wave_sum(float v) {
#pragma unroll
  for (int o = 1; o < 64; o <<= 1) v += __shfl_xor(v, o);
  return v;
}
__device__ __forceinline__ int t5_bucket(int n) {
  if (n < 16) return n;
  int b = 16;
  b += (n >= 19); b += (n >= 21); b += (n >= 24); b += (n >= 27); b += (n >= 31); b += (n >= 35); b += (n >= 40); b += (n >= 46);
  b += (n >= 52); b += (n >= 59); b += (n >= 67); b += (n >= 77); b += (n >= 87); b += (n >= 99); b += (n >= 113);
  return b;
}
__device__ __forceinline__ void sincos_big(float ang, float& s, float& c) {
  double rev = (double)ang * 0.15915494309189535;
  rev -= __builtin_floor(rev);
  float fr = (float)rev;
  s = __builtin_amdgcn_sinf(fr); c = __builtin_amdgcn_cosf(fr);
}
__device__ __forceinline__ float rope_inv(int i) { return __builtin_amdgcn_exp2f(-(float)i * (13.287712379549449f / 16.f)); }

typedef const Params __attribute__((address_space(4)))* cparams_t;
__device__ __forceinline__ cparams_t kparams() { cparams_t q = (cparams_t)__builtin_amdgcn_kernarg_segment_ptr(); asm volatile("" : "+s"(q)); return q; }
namespace pg8 {
constexpr int BM = 256, BK = 64, HALF = 128, HTB = HALF * BK * 2, STAGE_BYTES = 8 * HTB, NXCD = 8, WGM = 8;
__host__ __device__ __forceinline__ int lds_byte(int r, int c) { const int st = (r >> 4) * 2 + (c >> 5), rr = r & 15, cc = c & 31, ob = rr * 64 + cc * 2; return st * 1024 + (ob ^ (((ob >> 9) & 1) << 5)); }
__host__ __device__ __forceinline__ void stage_rc(int b, int& R, int& C) { const int st = b / 1024, sb = b % 1024, swz = sb ^ (((sb >> 9) & 1) << 5); R = (st >> 1) * 16 + swz / 64; C = (st & 1) * 32 + (swz % 64) / 2; }
__host__ __device__ __forceinline__ int perm32(int rho) { const int n = rho >> 4, i = rho & 15; return 8 * (i >> 2) + 4 * n + (i & 3); }
struct Unit { int pm, pn; };
struct Gemm { const bf16_t* A; const bf16_t* Bt; int M, N, K; };
struct StaticOrder {
  int nM, nN, nwg, G, c;
  __host__ __device__ void init(int M, int N, int G_, int c_) { nM = M / BM; nN = N / BM; nwg = nM * nN; G = G_; c = c_; }
  __host__ __device__ bool next(int i, Unit& u) const {
    const long L = (long)i * G + c; if (L >= nwg) return false;
    int wgid = (int)L; { const int q = nwg / NXCD, r = nwg % NXCD, xcd = wgid % NXCD, off = wgid / NXCD; wgid = (xcd < r ? xcd * (q + 1) : r * (q + 1) + (xcd - r) * q) + off; }
    const int nig = WGM * nN, gid = wgid / nig, fm = gid * WGM, gsz = (nM - fm) < WGM ? (nM - fm) : WGM;
    u.pm = fm + ((wgid % nig) % gsz); u.pn = (wgid % nig) / gsz; return true;
  }
  __device__ __forceinline__ void a_ready(const Unit&) const {}
  __device__ __forceinline__ void done(const Unit&) const {}
};

__device__ __forceinline__ float silu_mul(float g, float uu) { return g * __builtin_amdgcn_rcpf(1.f + __expf(-g)) * uu; }
struct EpiDyn {
  static constexpr bool PERM = true, AFTER_DRAIN = false;
  int sub, l;
  __device__ __forceinline__ void operator()(const f32x4 (&acc)[2][2][4][2], const Unit& u, int wr, int wc, int fr, int fq) const {
#if defined(__HIP_DEVICE_COMPILE__)
    const Params p = *kparams();
    unsigned char* wsb = p.ws;
    const float* mod = (const float*)(wsb + WS_MOD) + (size_t)l * 16 * MODW;
    bf16_t* NBp = (bf16_t*)(wsb + WS_NB); bf16_t* BIGp = (bf16_t*)(wsb + WS_BIG); bf16_t* HID2p = (bf16_t*)(wsb + WS_BIG + 64 * MiB);
    float* ssqb = (float*)(wsb + WS_SSQ); const float* cvl = (const float*)(wsb + WS_CV) + (size_t)l * 3 * CV_STRIDE;
    const bool isgu = (sub == 1 || sub == 11), isdn = (sub == 2 || sub == 12), isres = isdn || sub == 9, lastd = (sub == 12 && l + 1 >= DEPTH);
    const int type = isgu ? 1 : isres ? 2 : 0;
    bf16_t* O = (sub == 1 || sub == 4) ? BIGp : (sub == 11) ? HID2p : (bf16_t*)(wsb + WS_MLAO);
    const int ldc = (sub == 4) ? INWP : MLA_N, ncv = 5632;
    const float* ssq = (sub == 6) ? (const float*)nullptr : (const float*)ssqb;
    const float* cv = cvl + ((sub == 1) ? 0 : (sub == 4) ? 1 : 2) * CV_STRIDE;
    const float* src = (sub == 2 && l == 0) ? p.x : (const float*)p.out; float* dst = p.out;
    const float* gate = mod + ((sub == 2) ? 2 : (sub == 12) ? 8 : 5) * DM; const float coef = isdn ? 0.5f : 1.0f;
    bf16_t* nbo = lastd ? (bf16_t*)nullptr : (sub == 9) ? BIGp : NBp;
    const float* gain_n = (sub == 2) ? p.norm_mix + l * DM : (sub == 9) ? p.norm_ffn2 + l * DM : p.norm_ffn1 + (lastd ? 0 : (l + 1)) * DM;
    const float* scale_n = (sub == 2) ? mod + 4 * DM : (sub == 9) ? mod + 7 * DM : mod + 16 * MODW + 1 * DM;
    float* ssq_o = ssqb;
    extern __shared__ __attribute__((aligned(16))) unsigned char lds_epi[];
    LAS float* ps = (LAS float*)((LAS unsigned char*)lds_epi + 131072);
    const int row0 = u.pm * BM + wr * 64 + fr, b = u.pm >> 3;
    if (type == 0) {
      const int col0 = u.pn * BM + wc * 32 + 8 * fq;
      f32x4 cvv[2][2];
#pragma unroll
      for (int bj = 0; bj < 2; ++bj)
#pragma unroll
        for (int n = 0; n < 2; ++n) cvv[bj][n] = ssq ? *(const f32x4*)(cv + (size_t)b * ncv + col0 + bj * HALF + 4 * n) : (f32x4){0.f, 0.f, 0.f, 0.f};
      f32x4 qv[2][4];
#pragma unroll
      for (int ai = 0; ai < 2; ++ai)
#pragma unroll
        for (int m = 0; m < 4; ++m) qv[ai][m] = ssq ? *(const f32x4*)(ssq + (size_t)(row0 + ai * HALF + m * 16) * 4) : (f32x4){0.f, 0.f, 0.f, 0.f};
#pragma unroll
      for (int ai = 0; ai < 2; ++ai)
#pragma unroll
        for (int m = 0; m < 4; ++m) { const int row = row0 + ai * HALF + m * 16; bf16_t* rowp = O + (size_t)row * ldc + col0;
          float rs = 1.f;
          if (ssq) { const f32x4 q = qv[ai][m]; rs = __builtin_amdgcn_rsqf(((q[0] + q[1]) + (q[2] + q[3])) * (1.f / DM) + RMS_EPS); }
#pragma unroll
          for (int bj = 0; bj < 2; ++bj) { const f32x4 v0 = acc[ai][bj][m][0] * rs + cvv[bj][0], v1 = acc[ai][bj][m][1] * rs + cvv[bj][1];
            u32x4 w; w.x = cvt_pk_bf16(v0[0], v0[1]); w.y = cvt_pk_bf16(v0[2], v0[3]); w.z = cvt_pk_bf16(v1[0], v1[1]); w.w = cvt_pk_bf16(v1[2], v1[3]);
            *(u32x4*)(rowp + bj * HALF) = w; } }
    } else if (type == 1) {
      const int col0 = u.pn * HALF + wc * 32 + 8 * fq, ccol = u.pn * BM + wc * 32 + 8 * fq;
      f32x4 cvv[2][2];
#pragma unroll
      for (int bj = 0; bj < 2; ++bj)
#pragma unroll
        for (int n = 0; n < 2; ++n) cvv[bj][n] = *(const f32x4*)(cv + (size_t)b * ncv + ccol + bj * HALF + 4 * n);
      f32x4 qv[2][4];
#pragma unroll
      for (int ai = 0; ai < 2; ++ai)
#pragma unroll
        for (int m = 0; m < 4; ++m) qv[ai][m] = *(const f32x4*)(ssq + (size_t)(row0 + ai * HALF + m * 16) * 4);
#pragma unroll
      for (int ai = 0; ai < 2; ++ai)
#pragma unroll
        for (int m = 0; m < 4; ++m) { const int row = row0 + ai * HALF + m * 16; bf16_t* rowp = O + (size_t)row * DFF + col0;
          const f32x4 q = qv[ai][m]; const float rs = __builtin_amdgcn_rsqf(((q[0] + q[1]) + (q[2] + q[3])) * (1.f / DM) + RMS_EPS);
          const f32x4 g0 = acc[ai][0][m][0] * rs + cvv[0][0], g1 = acc[ai][0][m][1] * rs + cvv[0][1], u0 = acc[ai][1][m][0] * rs + cvv[1][0], u1 = acc[ai][1][m][1] * rs + cvv[1][1];
          u32x4 w; w.x = cvt_pk_bf16(silu_mul(g0[0], u0[0]), silu_mul(g0[1], u0[1])); w.y = cvt_pk_bf16(silu_mul(g0[2], u0[2]), silu_mul(g0[3], u0[3]));
          w.z = cvt_pk_bf16(silu_mul(g1[0], u1[0]), silu_mul(g1[1], u1[1])); w.w = cvt_pk_bf16(silu_mul(g1[2], u1[2]), silu_mul(g1[3], u1[3]));
          *(u32x4*)rowp = w; }
    } else {
      const int col0 = u.pn * BM + wc * 32 + 8 * fq;
      const float* gp = gate + (size_t)b * MODW + col0;
      f32x4 gv[2][2], gn[2][2], g1[2][2], g2[2][2];
#pragma unroll
      for (int bj = 0; bj < 2; ++bj)
#pragma unroll
        for (int n = 0; n < 2; ++n) { gv[bj][n] = *(const f32x4*)(gp + bj * HALF + 4 * n);
          g1[bj][n] = nbo ? *(const f32x4*)(gain_n + col0 + bj * HALF + 4 * n) : (f32x4){0.f, 0.f, 0.f, 0.f};
          g2[bj][n] = nbo ? *(const f32x4*)(scale_n + (size_t)b * MODW + col0 + bj * HALF + 4 * n) : (f32x4){0.f, 0.f, 0.f, 0.f}; }
      __builtin_amdgcn_sched_barrier(0);
#pragma unroll
      for (int bj = 0; bj < 2; ++bj)
#pragma unroll
        for (int n = 0; n < 2; ++n) { gv[bj][n] = gv[bj][n] * coef; gn[bj][n] = g1[bj][n] * (g2[bj][n] + 1.f); }
#pragma unroll
      for (int aim = 0; aim < 4; ++aim) { const int ai = aim >> 1, m0 = (aim & 1) * 2;
        f32x4 svv[2][2][2];
#pragma unroll
        for (int mm = 0; mm < 2; ++mm)
#pragma unroll
          for (int bj = 0; bj < 2; ++bj)
#pragma unroll
            for (int n = 0; n < 2; ++n) svv[mm][bj][n] = *(const f32x4*)(src + (size_t)(row0 + ai * HALF + (m0 + mm) * 16) * DM + col0 + bj * HALF + 4 * n);
        __builtin_amdgcn_sched_barrier(0);
#pragma unroll
        for (int m = m0; m < m0 + 2; ++m) { const size_t ro = (size_t)(row0 + ai * HALF + m * 16) * DM + col0; float ss = 0.f;
#pragma unroll
          for (int bj = 0; bj < 2; ++bj) { f32x4 hn[2];
#pragma unroll
            for (int n = 0; n < 2; ++n) { const f32x4 sv = svv[m - m0][bj][n]; hn[n] = sv + gv[bj][n] * acc[ai][bj][m][n];
              *(f32x4*)(dst + ro + bj * HALF + 4 * n) = hn[n]; ss += (hn[n][0] * hn[n][0] + hn[n][1] * hn[n][1]) + (hn[n][2] * hn[n][2] + hn[n][3] * hn[n][3]); }
            if (nbo) { const f32x4 y0 = hn[0] * gn[bj][0], y1 = hn[1] * gn[bj][1];
              u32x4 w; w.x = cvt_pk_bf16(y0[0], y0[1]); w.y = cvt_pk_bf16(y0[2], y0[3]); w.z = cvt_pk_bf16(y1[0], y1[1]); w.w = cvt_pk_bf16(y1[2], y1[3]);
              *(u32x4*)(nbo + ro + bj * HALF) = w; } }
          if (nbo) { ss += __shfl_xor(ss, 16); ss += __shfl_xor(ss, 32);
            int t2 = threadIdx.x; asm volatile("" : "+v"(t2));
            if ((t2 & 48) == 0) ps[((t2 >> 6) & 3) * 256 + ai * HALF + ((t2 >> 8) & 1) * 64 + m * 16 + (t2 & 15)] = ss; } }
      }
      if (nbo) {
        asm volatile("s_waitcnt lgkmcnt(0)" ::: "memory"); __builtin_amdgcn_s_barrier();
        int tid = threadIdx.x; asm volatile("" : "+v"(tid));
        if (tid < 256) { const float tot = (ps[tid] + ps[256 + tid]) + (ps[512 + tid] + ps[768 + tid]); ssq_o[(size_t)(u.pm * BM + tid) * 4 + u.pn] = tot; }
      }
    }
#endif
  }
};

template <class Epi, class Sched, bool ALIGN_EPI = false, bool SP2 = false>
__device__ __forceinline__ void gemm_phase(LAS unsigned char* lds, const Gemm g, const Sched S, const Epi E) {
  const int tid = otid(), wid = __builtin_amdgcn_readfirstlane(tid >> 6), lane = tid & 63, wr = wid >> 2, wc = wid & 3, fr = lane & 15, fq = lane >> 4;
  const int K = g.K, nt = K / BK;
  unsigned voffA[2], voffB[2];
#pragma unroll
  for (int i = 0; i < 2; ++i) { int R, C; stage_rc(tid * 16 + i * 8192, R, C); const int Rb = Epi::PERM ? ((R & ~31) + perm32(R & 31)) : R;
    voffA[i] = (unsigned)(R * K + C) * 2u; voffB[i] = (unsigned)(Rb * K + C) * 2u; }
  const size_t kstep = (size_t)(BK * 2);
  const size_t hstep = (size_t)HALF * K * 2;
  const size_t tstep = 2 * hstep;
  const unsigned ldsw = (unsigned)wid * 1024u;
  const int aoff = lds_byte(wr * 64 + fr, fq * 8), boff = lds_byte(wc * 32 + fr, fq * 8);
#define PG8_SA(b, h) (((b) * 2 + (h)) * HTB)
#define PG8_SB(b, h) ((4 + (b) * 2 + (h)) * HTB)
#define PG8_STAGE(bufoff, gbase, voff) do { _Pragma("unroll") for (int _i = 0; _i < 2; ++_i) \
        __builtin_amdgcn_global_load_lds((const unsigned*)((const char*)(gbase) + (voff)[_i]), (LAS unsigned*)(lds + (bufoff) + ldsw + _i * 8192), 16, 0, 0); } while (0)
#define PG8_LDA(dst, b, h) do { _Pragma("unroll") for (int m = 0; m < 4; ++m) _Pragma("unroll") for (int k = 0; k < 2; ++k) dst[m][k] = *(const LAS bf16x8*)(lds + PG8_SA(b, h) + aoff + m * 2048 + k * 1024); } while (0)
#define PG8_LDB(dst, b, h) do { _Pragma("unroll") for (int n = 0; n < 2; ++n) _Pragma("unroll") for (int k = 0; k < 2; ++k) dst[n][k] = *(const LAS bf16x8*)(lds + PG8_SB(b, h) + boff + n * 2048 + k * 1024); } while (0)
#define PG8_MMA(ai, bj, At, Bt) do { __builtin_amdgcn_s_setprio(1); _Pragma("unroll") for (int m = 0; m < 4; ++m) _Pragma("unroll") for (int n = 0; n < 2; ++n) _Pragma("unroll") for (int k = 0; k < 2; ++k) \
        acc[ai][bj][m][n] = __builtin_amdgcn_mfma_f32_16x16x32_bf16(Bt[n][k], At[m][k], acc[ai][bj][m][n], 0, 0, 0); __builtin_amdgcn_s_setprio(0); } while (0)
#define PG8_WAIT_V(n) asm volatile("s_waitcnt vmcnt(" #n ")" ::: "memory")
#define PG8_WAIT_L(n) asm volatile("s_waitcnt lgkmcnt(" #n ")" ::: "memory")
#define PG8_BAR __builtin_amdgcn_s_barrier()
#define PG8_SCHED __builtin_amdgcn_sched_barrier(0)
  Unit cur, nxt; int ui = 0;
  if (!S.next(0, cur)) return;
  f32x4 acc[2][2][4][2];
#pragma unroll
  for (int a = 0; a < 2; ++a)
#pragma unroll
    for (int b = 0; b < 2; ++b)
#pragma unroll
      for (int m = 0; m < 4; ++m)
#pragma unroll
        for (int n = 0; n < 2; ++n) acc[a][b][m][n] = (f32x4){0.f, 0.f, 0.f, 0.f};
  bf16x8 At[4][2], B0[2][2], B1[2][2];
  const char* cA = (const char*)g.A + (size_t)cur.pm * tstep; const char* cB = (const char*)g.Bt + (size_t)cur.pn * tstep;
  S.a_ready(cur);
  if constexpr (SP2) {
    PG8_STAGE(PG8_SB(0, 0), cB, voffB); PG8_STAGE(PG8_SB(0, 1), cB + hstep, voffB); PG8_STAGE(PG8_SA(0, 0), cA, voffA); PG8_STAGE(PG8_SA(0, 1), cA + hstep, voffA);
    if (wr == 1) PG8_BAR;
    PG8_WAIT_V(2); PG8_BAR;
    PG8_STAGE(PG8_SB(1, 0), cB + kstep, voffB); PG8_STAGE(PG8_SA(1, 0), cA + kstep, voffA); PG8_STAGE(PG8_SB(1, 1), cB + hstep + kstep, voffB);
    PG8_WAIT_V(6); PG8_BAR;
  } else {
    PG8_STAGE(PG8_SB(0, 0), cB, voffB); PG8_STAGE(PG8_SA(0, 0), cA, voffA); PG8_STAGE(PG8_SB(0, 1), cB + hstep, voffB); PG8_STAGE(PG8_SA(0, 1), cA + hstep, voffA);
    if (wr == 1) PG8_BAR;
    PG8_WAIT_V(4); PG8_BAR;
    PG8_STAGE(PG8_SB(1, 0), cB + kstep, voffB); PG8_STAGE(PG8_SA(1, 0), cA + kstep, voffA); PG8_STAGE(PG8_SB(1, 1), cB + hstep + kstep, voffB);
    PG8_WAIT_V(6); PG8_BAR;
  }
  for (;;) {
    const bool has_next = S.next(ui + 1, nxt);
    const char* nA = has_next ? (const char*)g.A + (size_t)nxt.pm * tstep : cA; const char* nB = has_next ? (const char*)g.Bt + (size_t)nxt.pn * tstep : cB;
#pragma unroll 1
    for (int t = 0; t < nt; t += 2) {
      const bool last = (t == nt - 2);
      const char* a1 = cA + (size_t)(t + 1) * kstep;
      const char* a2 = last ? nA : cA + (size_t)(t + 2) * kstep; const char* b2 = last ? nB : cB + (size_t)(t + 2) * kstep;
      const char* a3 = a2 + kstep; const char* b3 = b2 + kstep;
      if (last && has_next) S.a_ready(nxt);
      if constexpr (SP2) {
        PG8_LDB(B0, 0, 0); PG8_LDB(B1, 0, 1); PG8_SCHED; PG8_LDA(At, 0, 0); PG8_STAGE(PG8_SA(1, 1), a1 + hstep, voffA);
        PG8_WAIT_V(8); PG8_WAIT_L(0); PG8_BAR; PG8_MMA(0, 0, At, B0); PG8_MMA(0, 1, At, B1); PG8_BAR; PG8_SCHED;
        PG8_LDA(At, 0, 1); PG8_STAGE(PG8_SB(0, 0), b2, voffB); PG8_STAGE(PG8_SB(0, 1), b2 + hstep, voffB); PG8_STAGE(PG8_SA(0, 0), a2, voffA);
        PG8_WAIT_V(8); PG8_WAIT_L(0); PG8_BAR; PG8_MMA(1, 0, At, B0); PG8_MMA(1, 1, At, B1); PG8_BAR; PG8_SCHED;
        PG8_LDB(B0, 1, 0); PG8_LDB(B1, 1, 1); PG8_SCHED; PG8_LDA(At, 1, 0); PG8_STAGE(PG8_SA(0, 1), a2 + hstep, voffA);
        PG8_WAIT_V(8); PG8_WAIT_L(0); PG8_BAR; PG8_MMA(0, 0, At, B0); PG8_MMA(0, 1, At, B1); PG8_BAR; PG8_SCHED;
        PG8_LDA(At, 1, 1); PG8_STAGE(PG8_SB(1, 0), b3, voffB); PG8_STAGE(PG8_SB(1, 1), b3 + hstep, voffB); PG8_STAGE(PG8_SA(1, 0), a3, voffA);
        PG8_WAIT_V(8); PG8_WAIT_L(0); PG8_BAR; PG8_MMA(1, 0, At, B0); PG8_MMA(1, 1, At, B1); PG8_BAR; PG8_SCHED;
      } else {
        PG8_LDB(B0, 0, 0); PG8_SCHED; PG8_LDA(At, 0, 0); PG8_STAGE(PG8_SA(1, 1), a1 + hstep, voffA);
        PG8_WAIT_L(8); PG8_BAR; PG8_WAIT_L(0); PG8_MMA(0, 0, At, B0); PG8_BAR; PG8_SCHED;
        PG8_LDB(B1, 0, 1); PG8_STAGE(PG8_SB(0, 0), b2, voffB);
        PG8_BAR; PG8_WAIT_L(0); PG8_MMA(0, 1, At, B1); PG8_BAR;
        PG8_LDA(At, 0, 1); PG8_STAGE(PG8_SA(0, 0), a2, voffA);
        PG8_BAR; PG8_WAIT_L(0); PG8_MMA(1, 0, At, B0); PG8_BAR; PG8_SCHED;
        PG8_STAGE(PG8_SB(0, 1), b2 + hstep, voffB);
        PG8_WAIT_V(6); PG8_BAR; PG8_MMA(1, 1, At, B1); PG8_BAR;
        PG8_LDB(B0, 1, 0); PG8_SCHED; PG8_LDA(At, 1, 0); PG8_STAGE(PG8_SA(0, 1), a2 + hstep, voffA);
        PG8_WAIT_L(8); PG8_BAR; PG8_WAIT_L(0); PG8_MMA(0, 0, At, B0); PG8_BAR; PG8_SCHED;
        PG8_LDB(B1, 1, 1); PG8_STAGE(PG8_SB(1, 0), b3, voffB);
        PG8_BAR; PG8_WAIT_L(0); PG8_MMA(0, 1, At, B1); PG8_BAR;
        PG8_LDA(At, 1, 1); PG8_STAGE(PG8_SA(1, 0), a3, voffA);
        PG8_BAR; PG8_WAIT_L(0); PG8_MMA(1, 0, At, B0); PG8_BAR; PG8_SCHED;
        PG8_STAGE(PG8_SB(1, 1), b3 + hstep, voffB);
        PG8_WAIT_V(6); PG8_BAR; PG8_MMA(1, 1, At, B1); PG8_BAR;
      }
    }
    if constexpr (ALIGN_EPI) { if (wr == 0) PG8_BAR; }
    if constexpr (!Epi::AFTER_DRAIN) { E(acc, cur, wr, wc, fr, fq); S.done(cur); }
    if (!has_next) break;
#pragma unroll
    for (int a = 0; a < 2; ++a)
#pragma unroll
      for (int b = 0; b < 2; ++b)
#pragma unroll
        for (int m = 0; m < 4; ++m)
#pragma unroll
          for (int n = 0; n < 2; ++n) acc[a][b][m][n] = (f32x4){0.f, 0.f, 0.f, 0.f};
    cur = nxt; cA = nA; cB = nB; ++ui;
    if constexpr (ALIGN_EPI) { if (wr == 1) PG8_BAR; }
  }
  PG8_WAIT_V(0);
  if constexpr (!ALIGN_EPI) { if (wr == 0) PG8_BAR; }
  PG8_BAR;
#undef PG8_SA
#undef PG8_SB
#undef PG8_STAGE
#undef PG8_LDA
#undef PG8_LDB
#undef PG8_MMA
#undef PG8_WAIT_V
#undef PG8_WAIT_L
#undef PG8_BAR
#undef PG8_SCHED
}
}

template <class Epi>
__device__ __forceinline__ void run_gemm(unsigned char* lds, const bf16_t* A, const bf16_t* Bt, int N, int K, const Epi E) {
  pg8::Gemm g{A, Bt, MTOK, N, K}; pg8::StaticOrder S; S.init(MTOK, N, (int)gridDim.x, (int)blockIdx.x);
  pg8::gemm_phase<Epi, pg8::StaticOrder, true, true>((LAS unsigned char*)lds, g, S, E);
  __syncthreads();
}

template <class F>
__device__ __forceinline__ void cvt_tile(F src, bf16_t* dst, int ldd, int n0, int k0, float* tile) {
  const int tid = otid();
  float v[8];
#pragma unroll
  for (int i = 0; i < 8; ++i) { const int k = i * 8 + (tid >> 6), n = tid & 63; v[i] = src(k0 + k, n0 + n); }
#pragma unroll
  for (int i = 0; i < 8; ++i) { const int k = i * 8 + (tid >> 6), n = tid & 63; tile[k * 65 + n] = v[i]; }
  __syncthreads();
  { const int n = tid >> 3, kc = (tid & 7) * 8; const float* s = tile + kc * 65 + n;
    u32x4 o; o.x = cvt_pk_bf16(s[0], s[65]); o.y = cvt_pk_bf16(s[2 * 65], s[3 * 65]); o.z = cvt_pk_bf16(s[4 * 65], s[5 * 65]); o.w = cvt_pk_bf16(s[6 * 65], s[7 * 65]);
    *(u32x4*)(dst + (size_t)(n0 + n) * ldd + k0 + kc) = o; }
  __syncthreads();
}

__device__ __forceinline__ void phase0(const Params& p, unsigned char* lds) {
  float* tile = (float*)lds;
  const int tid = otid();
  constexpr int N_ADA = DEPTH * 18 * 8;
  constexpr int T_GU = 88 * 16, T_D = 16 * 44, T_IN = 52 * 16, T_MLA = 20 * 6, T_OUT = 16 * 16;
  constexpr int T_LAYER = 2 * T_GU + 2 * T_D + T_IN + T_MLA + T_OUT;
  constexpr int NITEMS = N_ADA + DEPTH * T_LAYER;
  for (int it = blockIdx.x; it < NITEMS; it += gridDim.x) {
    if (it < N_ADA) {
      const int l = it / 144, r = it % 144, cb = r / 8, ks = r % 8;
      __syncthreads();
      for (int e = tid; e < 16 * 128; e += 512) { const int b = e >> 7, k = e & 127; const float v = p.c[b * DM + ks * 128 + k]; tile[e] = v / (1.f + __expf(-v)); }
      __syncthreads();
      const int j = cb * 512 + tid;
      const float* w = p.ada_w + (size_t)l * DM * MODW + (size_t)(ks * 128) * MODW + j;
      float acc[16];
#pragma unroll
      for (int b = 0; b < 16; ++b) acc[b] = 0.f;
#pragma unroll 1
      for (int k0 = 0; k0 < 128; k0 += 16) { float wv[16];
#pragma unroll
        for (int kk = 0; kk < 16; ++kk) wv[kk] = w[(size_t)(k0 + kk) * MODW];
#pragma unroll
        for (int kk = 0; kk < 16; ++kk)
#pragma unroll
          for (int b = 0; b < 16; ++b) acc[b] += tile[b * 128 + k0 + kk] * wv[kk]; }
      float* dstp = (float*)(p.ws + WS_ADAP) + ((size_t)(ks * DEPTH + l) * 16) * MODW + j;
#pragma unroll
      for (int b = 0; b < 16; ++b) dstp[(size_t)b * MODW] = acc[b];
      __syncthreads();
      continue;
    }
    int r = it - N_ADA; const int l = r / T_LAYER; r -= l * T_LAYER;
    unsigned char* wl = p.ws + WS_W + (size_t)l * WL_STRIDE;
    if (r < 2 * T_GU) {
      const int f = r / T_GU; r -= f * T_GU; const int nt = r / 16, kt = r % 16, n0 = nt * 64;
      const int pn = n0 >> 8, bj = (n0 >> 7) & 1, i0 = n0 & 127, scol0 = bj * DFF + pn * 128 + i0 - n0;
      const float* W = (f ? p.ffn2_gu : p.ffn1_gu) + (size_t)l * DM * NGU;
      cvt_tile([=](int k, int n) { return W[(size_t)k * NGU + n + scol0]; }, (bf16_t*)(wl + (f ? WO_GU2 : WO_GU1)), DM, n0, kt * 64, tile);
      continue;
    }
    r -= 2 * T_GU;
    if (r < 2 * T_D) {
      const int f = r / T_D; r -= f * T_D; const int nt = r / 44, kt = r % 44;
      const float* W = (f ? p.ffn2_down : p.ffn1_down) + (size_t)l * DFF * DM;
      cvt_tile([=](int k, int n) { return W[(size_t)k * DM + n]; }, (bf16_t*)(wl + (f ? WO_D2 : WO_D1)), DFF, nt * 64, kt * 64, tile);
      continue;
    }
    r -= 2 * T_D;
    if (r < T_IN) {
      const int nt = r / 16, kt = r % 16;
      const float* W = p.w_in + (size_t)l * DM * INW;
      cvt_tile([=](int k, int n) { return n < INW ? W[(size_t)k * INW + n] : 0.f; }, (bf16_t*)(wl + WO_IN), DM, nt * 64, kt * 64, tile);
      continue;
    }
    r -= T_IN;
    if (r < T_MLA) {
      const int nt = r / 6, kt = r % 6;
      const float* Wq = p.w_uq + (size_t)l * 256 * 480; const float* Wkv = p.w_ukv + (size_t)l * 128 * 640;
      cvt_tile([=](int k, int n) { float v = 0.f; if (n < 480) { if (k < 256) v = Wq[(size_t)k * 480 + n]; } else if (n < 1120) { if (k >= 256) v = Wkv[(size_t)(k - 256) * 640 + (n - 480)]; } return v; },
               (bf16_t*)(wl + WO_MLA), MLA_K, nt * 64, kt * 64, tile);
      continue;
    }
    r -= T_MLA;
    { const int nt = r / 16, kt = r % 16;
      const float* W = p.w_out + (size_t)l * DM * DM;
      cvt_tile([=](int k, int n) { return W[(size_t)k * DM + n]; }, (bf16_t*)(wl + WO_OUT), DM, nt * 64, kt * 64, tile); }
  }
}
__device__ __forceinline__ void phase_mod_reduce(const Params& p) {
  float* mod = (float*)(p.ws + WS_MOD); const float* part = (const float*)(p.ws + WS_ADAP);
  constexpr int TOT = DEPTH * 16 * MODW;
  for (int e = blockIdx.x * 512 + otid(); e < TOT; e += gridDim.x * 512) {
    const int l = e / (16 * MODW), j = e % MODW;
    float s = p.ada_b[l * MODW + j];
#pragma unroll
    for (int ks = 0; ks < 8; ++ks) s += part[(size_t)ks * TOT + e];
    mod[e] = s;
  }
}

__device__ __forceinline__ void phase_norm(const float* src, const float* gain, const float* shift, const float* scale, bf16_t* dst) {
  const int tid_ = otid(), lane = tid_ & 63, gw = blockIdx.x * 8 + (tid_ >> 6), NGW = gridDim.x * 8;
  for (int m = gw; m < MTOK; m += NGW) {
    const f32x4* xr = (const f32x4*)(src + (size_t)m * DM) + lane;
    f32x4 v[4]; float s = 0.f;
#pragma unroll
    for (int j = 0; j < 4; ++j) { v[j] = xr[64 * j]; s += (v[j].x * v[j].x + v[j].y * v[j].y) + (v[j].z * v[j].z + v[j].w * v[j].w); }
    const float rs = 1.f / sqrtf(wave_sum(s) * (1.f / DM) + RMS_EPS);
    const int b = m / SEQ;
    const f32x4* gp = (const f32x4*)gain + lane; const f32x4* shp = (const f32x4*)(shift + (size_t)b * MODW) + lane; const f32x4* scp = (const f32x4*)(scale + (size_t)b * MODW) + lane;
    u64* o8 = (u64*)(dst + (size_t)m * DM) + lane;
#pragma unroll
    for (int j = 0; j < 4; ++j) { const f32x4 g = gp[64 * j], sh = shp[64 * j], sc = scp[64 * j];
      const f32x4 y = (v[j] * rs) * g * (sc + 1.f) + sh;
      o8[64 * j] = (u64)cvt_pk_bf16(y.x, y.y) | ((u64)cvt_pk_bf16(y.z, y.w) << 32); }
  }
}
__device__ __forceinline__ void phase_final_norm(float* h, const float* gain) {
  const int tid_ = otid(), lane = tid_ & 63, gw = blockIdx.x * 8 + (tid_ >> 6), NGW = gridDim.x * 8;
  f32x4 g[4];
#pragma unroll
  for (int j = 0; j < 4; ++j) g[j] = ((const f32x4*)gain)[lane + 64 * j];
  constexpr int RB = 4;
  for (int m0 = gw * RB; m0 < MTOK; m0 += NGW * RB) {
    f32x4 v[RB][4]; float s[RB];
#pragma unroll
    for (int r = 0; r < RB; ++r) { const f32x4* xr = (const f32x4*)(h + (size_t)(m0 + r) * DM) + lane;
#pragma unroll
      for (int j = 0; j < 4; ++j) v[r][j] = xr[64 * j]; }
#pragma unroll
    for (int r = 0; r < RB; ++r) { float a = 0.f;
#pragma unroll
      for (int j = 0; j < 4; ++j) a += (v[r][j].x * v[r][j].x + v[r][j].y * v[r][j].y) + (v[r][j].z * v[r][j].z + v[r][j].w * v[r][j].w);
      s[r] = a; }
#pragma unroll
    for (int r = 0; r < RB; ++r) s[r] = __builtin_amdgcn_rsqf(wave_sum(s[r]) * (1.f / DM) + RMS_EPS);
#pragma unroll
    for (int r = 0; r < RB; ++r) { f32x4* xr = (f32x4*)(h + (size_t)(m0 + r) * DM) + lane;
#pragma unroll
      for (int j = 0; j < 4; ++j) xr[64 * j] = (v[r][j] * s[r]) * g[j]; }
  }
}

__device__ __forceinline__ void phase_cvec(const Params& p) {
  const int tid_ = otid(), lane = tid_ & 63, fr = lane & 15, fq = lane >> 4, gw = blockIdx.x * 8 + (tid_ >> 6), NGW = gridDim.x * 8;
  constexpr int G_GU = NGU / 16, G_IN = INWP / 16, G_L = 2 * G_GU + G_IN;
  for (int it = gw; it < DEPTH * G_L; it += NGW) {
    const int l = it / G_L; int r = it % G_L; int g, ncols; size_t wo;
    if (r < G_GU) { g = 0; wo = WO_GU1; ncols = NGU; } else if (r < G_GU + G_IN) { r -= G_GU; g = 1; wo = WO_IN; ncols = INWP; } else { r -= G_GU + G_IN; g = 2; wo = WO_GU2; ncols = NGU; }
    const bf16_t* wt = (const bf16_t*)(p.ws + WS_W + (size_t)l * WL_STRIDE + wo) + (size_t)(r * 16 + fr) * DM + fq * 8;
    const float* sh = (const float*)(p.ws + WS_MOD) + ((size_t)l * 16 + fr) * MODW + (g * 3) * DM + fq * 8;
    f32x4 acc = (f32x4){0.f, 0.f, 0.f, 0.f};
#pragma unroll 4
    for (int s = 0; s < 32; ++s) {
      const bf16x8 wf = *(const bf16x8*)(wt + s * 32);
      const f32x4 a0 = *(const f32x4*)(sh + s * 32), a1 = *(const f32x4*)(sh + s * 32 + 4);
      u32x4 w; w.x = cvt_pk_bf16(a0[0], a0[1]); w.y = cvt_pk_bf16(a0[2], a0[3]); w.z = cvt_pk_bf16(a1[0], a1[1]); w.w = cvt_pk_bf16(a1[2], a1[3]);
      acc = __builtin_amdgcn_mfma_f32_16x16x32_bf16(wf, __builtin_bit_cast(bf16x8, w), acc, 0, 0, 0);
    }
    float* cvp = (float*)(p.ws + WS_CV) + ((size_t)(l * 3 + g) * 16 + fr) * 5632 + r * 16 + fq * 4;
    *(f32x4*)cvp = acc;
  }
}
__device__ __forceinline__ void phase_norm0(const float* src, const float* gain, const float* scale, bf16_t* dst, float* ssq) {
  const int tid_ = otid(), lane = tid_ & 63, gw = blockIdx.x * 8 + (tid_ >> 6), NGW = gridDim.x * 8;
  for (int m = gw; m < MTOK; m += NGW) {
    const f32x4* xr = (const f32x4*)(src + (size_t)m * DM) + lane;
    f32x4 v[4]; float s = 0.f;
#pragma unroll
    for (int j = 0; j < 4; ++j) { v[j] = xr[64 * j]; s += (v[j].x * v[j].x + v[j].y * v[j].y) + (v[j].z * v[j].z + v[j].w * v[j].w); }
    s = wave_sum(s);
    const int b = m / SEQ;
    const f32x4* gp = (const f32x4*)gain + lane; const f32x4* scp = (const f32x4*)(scale + (size_t)b * MODW) + lane;
    u64* o8 = (u64*)(dst + (size_t)m * DM) + lane;
#pragma unroll
    for (int j = 0; j < 4; ++j) { const f32x4 y = v[j] * gp[64 * j] * (scp[64 * j] + 1.f);
      o8[64 * j] = (u64)cvt_pk_bf16(y.x, y.y) | ((u64)cvt_pk_bf16(y.z, y.w) << 32); }
    if (lane == 0) *(f32x4*)(ssq + (size_t)m * 4) = (f32x4){s, 0.f, 0.f, 0.f};
  }
}

__device__ __forceinline__ float sumsq8(u32x4 w) { float a = 0.f;
  a += bflo(w.x) * bflo(w.x); a += bfhi(w.x) * bfhi(w.x); a += bflo(w.y) * bflo(w.y); a += bfhi(w.y) * bfhi(w.y);
  a += bflo(w.z) * bflo(w.z); a += bfhi(w.z) * bfhi(w.z); a += bflo(w.w) * bflo(w.w); a += bfhi(w.w) * bfhi(w.w); return a; }
__device__ __forceinline__ float group8_sum(float v) { v += __shfl_xor(v, 1); v += __shfl_xor(v, 2); v += __shfl_xor(v, 4); return v; }
constexpr size_t WS_KMAX = WS_BAR + 14336;
__device__ __forceinline__ void phase_prep(const Params& p, int l) {
  const int tid_ = otid(), lane = tid_ & 63, gw = blockIdx.x * 8 + (tid_ >> 6), NGW = gridDim.x * 8;
  bf16_t* proj = (bf16_t*)(p.ws + WS_BIG); bf16_t* mlaa = (bf16_t*)(p.ws + WS_MLAA); bf16_t* krope = (bf16_t*)(p.ws + WS_KROPE); bf16_t* ikn = (bf16_t*)(p.ws + WS_IKN);
  const float* qn = p.q_norm + l * 256; const float* kvn = p.kv_norm + l * 128;
  const float inv = rope_inv(lane & 15);
  const f32x4 gq = *(const f32x4*)(qn + 4 * lane); const f32x2 gkv = *(const f32x2*)(kvn + 2 * lane); const float gik = p.ik_norm[l * 64 + lane];
  unsigned* kmaxp = (unsigned*)(p.ws + WS_KMAX) + l * 256;
  constexpr int TB = 4;
  for (int base = gw * 16; base < MTOK; base += NGW * 16) {
   float kA = 0.f, kC = 0.f;
   for (int tg = 0; tg < 16; tg += TB) {
    u32x2 cqw[TB]; unsigned ckvw[TB]; float kr1[TB], kr2[TB], q1[TB][2], q2[TB][2], ikv[TB], ang[TB]; u32x4 wa[TB], wc[TB];
#pragma unroll
    for (int t = 0; t < TB; ++t) { const int m = base + tg + t; const bf16_t* pr = proj + (size_t)m * INWP;
      cqw[t] = *(const u32x2*)(pr + OFF_CQ + 4 * lane); ckvw[t] = *(const unsigned*)(pr + OFF_CKV + 2 * lane);
      kr1[t] = bf2f(pr[OFF_KR + (lane & 15)]); kr2[t] = bf2f(pr[OFF_KR + 16 + (lane & 15)]);
#pragma unroll
      for (int j = 0; j < 2; ++j) { const int pp = lane + 64 * j; const bf16_t* q = pr + OFF_IQ + (pp >> 4) * 64 + (pp & 15); q1[t][j] = bf2f(q[0]); q2[t][j] = bf2f(q[16]); }
      ikv[t] = bf2f(pr[OFF_IK + lane]);
      wa[t] = *(const u32x4*)(pr + OFF_KA + (lane < 48 ? lane : 0) * 8); wc[t] = *(const u32x4*)(pr + OFF_KC + (lane < 40 ? lane : 0) * 8);
      ang[t] = (float)p.pos[m] * inv; }
    u32x2 cqo[TB]; unsigned ckvo[TB]; unsigned short kro1[TB], kro2[TB], qo1[TB][2], qo2[TB][2], iko[TB];
#pragma unroll
    for (int t = 0; t < TB; ++t) {
      float sn, cs; sincos_big(ang[t], sn, cs);
      kA = fmaxf(kA, group8_sum(sumsq8(wa[t]))); kC = fmaxf(kC, group8_sum(sumsq8(wc[t])));
      { const float a0 = bflo(cqw[t].x), a1 = bfhi(cqw[t].x), a2 = bflo(cqw[t].y), a3 = bfhi(cqw[t].y);
        const float rs = __builtin_amdgcn_rsqf(wave_sum(a0 * a0 + a1 * a1 + a2 * a2 + a3 * a3) * (1.f / 256) + RMS_EPS);
        cqo[t].x = cvt_pk_bf16(a0 * rs * gq.x, a1 * rs * gq.y); cqo[t].y = cvt_pk_bf16(a2 * rs * gq.z, a3 * rs * gq.w); }
      { const float a0 = bflo(ckvw[t]), a1 = bfhi(ckvw[t]);
        const float rs = __builtin_amdgcn_rsqf(wave_sum(a0 * a0 + a1 * a1) * (1.f / 128) + RMS_EPS);
        ckvo[t] = cvt_pk_bf16(a0 * rs * gkv.x, a1 * rs * gkv.y); }
      kro1[t] = f2bf(kr1[t] * cs - kr2[t] * sn); kro2[t] = f2bf(kr2[t] * cs + kr1[t] * sn);
#pragma unroll
      for (int j = 0; j < 2; ++j) { qo1[t][j] = f2bf(q1[t][j] * cs - q2[t][j] * sn); qo2[t][j] = f2bf(q2[t][j] * cs + q1[t][j] * sn); }
      { const float a = ikv[t];
        const float rs = __builtin_amdgcn_rsqf(wave_sum(a * a) * (1.f / 64) + RMS_EPS);
        const float y = a * rs * gik, pa = __shfl_xor(y, 16);
        float o = y;
        if (lane < 16) o = y * cs - pa * sn; else if (lane < 32) o = y * cs + pa * sn;
        iko[t] = f2bf(o); }
    }
#pragma unroll
    for (int t = 0; t < TB; ++t) { const int m = base + tg + t; bf16_t* pr = proj + (size_t)m * INWP;
      *(u32x2*)(mlaa + (size_t)m * MLA_K + 4 * lane) = cqo[t];
      *(unsigned*)(mlaa + (size_t)m * MLA_K + 256 + 2 * lane) = ckvo[t];
      if (lane < 16) { krope[(size_t)m * 32 + lane] = kro1[t]; krope[(size_t)m * 32 + 16 + lane] = kro2[t]; }
#pragma unroll
      for (int j = 0; j < 2; ++j) { const int pp = lane + 64 * j; bf16_t* q = pr + OFF_IQ + (pp >> 4) * 64 + (pp & 15); q[0] = qo1[t][j]; q[16] = qo2[t][j]; }
      ikn[(size_t)m * 64 + lane] = iko[t]; }
   }
   const int bb = base / SEQ;
   if ((lane & 7) == 0) {
     if (lane < 48) __hip_atomic_fetch_max(kmaxp + bb * 16 + (lane >> 3), __builtin_bit_cast(unsigned, kA), __ATOMIC_RELAXED, __HIP_MEMORY_SCOPE_AGENT);
     if (lane < 40) __hip_atomic_fetch_max(kmaxp + bb * 16 + 11 + (lane >> 3), __builtin_bit_cast(unsigned, kC), __ATOMIC_RELAXED, __HIP_MEMORY_SCOPE_AGENT);
   }
  }
}
__device__ __forceinline__ void phase_qrope(const Params& p, int l) {
  const int tid_ = otid(), lane = tid_ & 63, gw = blockIdx.x * 8 + (tid_ >> 6), NGW = gridDim.x * 8;
  bf16_t* mlao = (bf16_t*)(p.ws + WS_MLAO); const bf16_t* krope = (const bf16_t*)(p.ws + WS_KROPE);
  unsigned* kmaxp = (unsigned*)(p.ws + WS_KMAX) + l * 256;
  const float inv = rope_inv(lane & 15);
  constexpr int TB = 4;
  for (int base = gw * 16; base < MTOK; base += NGW * 16) {
   float kM = 0.f;
   for (int tg = 0; tg < 16; tg += TB) {
    u32x4 wn[TB], wr[TB]; float q1[TB][2], q2[TB][2], ang[TB];
#pragma unroll
    for (int t = 0; t < TB; ++t) { const int m = base + tg + t; const int ll = lane < 40 ? lane : 0;
      wn[t] = *(const u32x4*)(mlao + (size_t)m * MLA_N + 480 + (ll >> 3) * 128 + (ll & 7) * 8); wr[t] = *(const u32x4*)(krope + (size_t)m * 32 + (lane & 3) * 8);
#pragma unroll
      for (int j = 0; j < 2; ++j) { const int pp = (lane + 64 * j < 80) ? lane + 64 * j : 0; const bf16_t* q = mlao + (size_t)m * MLA_N + (pp >> 4) * 96 + 64 + (pp & 15); q1[t][j] = bf2f(q[0]); q2[t][j] = bf2f(q[16]); }
      ang[t] = (float)p.pos[m] * inv; }
    unsigned short qo1[TB][2], qo2[TB][2];
#pragma unroll
    for (int t = 0; t < TB; ++t) {
      float sn, cs; sincos_big(ang[t], sn, cs);
      float r2 = sumsq8(wr[t]); r2 += __shfl_xor(r2, 1); r2 += __shfl_xor(r2, 2);
      kM = fmaxf(kM, group8_sum(sumsq8(wn[t])) + r2);
#pragma unroll
      for (int j = 0; j < 2; ++j) { qo1[t][j] = f2bf(q1[t][j] * cs - q2[t][j] * sn); qo2[t][j] = f2bf(q2[t][j] * cs + q1[t][j] * sn); }
    }
#pragma unroll
    for (int t = 0; t < TB; ++t) { const int m = base + tg + t;
#pragma unroll
      for (int j = 0; j < 2; ++j) { const int pp = lane + 64 * j;
        if (pp < 80) { bf16_t* q = mlao + (size_t)m * MLA_N + (pp >> 4) * 96 + 64 + (pp & 15); q[0] = qo1[t][j]; q[16] = qo2[t][j]; } } }
   }
   const int bb = base / SEQ;
   if ((lane & 7) == 0 && lane < 40) __hip_atomic_fetch_max(kmaxp + bb * 16 + 6 + (lane >> 3), __builtin_bit_cast(unsigned, kM), __ATOMIC_RELAXED, __HIP_MEMORY_SCOPE_AGENT);
  }
}

constexpr int SC_STRIDE = 2117;
__device__ __forceinline__ int wave_count(int c) { int t = 0;
#pragma unroll
  for (int b = 0; b < 6; ++b) t += (int)__popcll(__ballot((c >> b) & 1)) << b;
  return t; }
__device__ __forceinline__ unsigned fkey(float v) { const unsigned u = __builtin_bit_cast(unsigned, v + 0.0f); return (u & 0x80000000u) ? ~u : (u | 0x80000000u); }
#define DEF_WCOUNT(NAME, OP) \
__device__ __forceinline__ int NAME(const unsigned (&key)[32], unsigned thr) { \
  int cnt = 0; const unsigned m = __builtin_amdgcn_readfirstlane(thr); \
  _Pragma("unroll") for (int j = 0; j < 32; j += 4) { u64 a, b, c, d; int ta, tb, tc, td; \
    asm volatile("v_cmp_" OP "_u32 %[a], %[k0], %[m]\n\tv_cmp_" OP "_u32 %[b], %[k1], %[m]\n\tv_cmp_" OP "_u32 %[c], %[k2], %[m]\n\tv_cmp_" OP "_u32 %[d], %[k3], %[m]\n\t" \
                 "s_bcnt1_i32_b64 %[ta], %[a]\n\ts_bcnt1_i32_b64 %[tb], %[b]\n\ts_bcnt1_i32_b64 %[tc], %[c]\n\ts_bcnt1_i32_b64 %[td], %[d]\n\t" \
                 "s_add_i32 %[ta], %[ta], %[tb]\n\ts_add_i32 %[tc], %[tc], %[td]\n\ts_add_i32 %[cnt], %[cnt], %[ta]\n\ts_add_i32 %[cnt], %[cnt], %[tc]" \
      : [cnt] "+s"(cnt), [a] "=&s"(a), [b] "=&s"(b), [c] "=&s"(c), [d] "=&s"(d), [ta] "=&s"(ta), [tb] "=&s"(tb), [tc] "=&s"(tc), [td] "=&s"(td) \
      : [k0] "v"(key[j]), [k1] "v"(key[j + 1]), [k2] "v"(key[j + 2]), [k3] "v"(key[j + 3]), [m] "s"(m) : "scc"); } \
  return cnt; }
DEF_WCOUNT(wcount_ge, "ge")
DEF_WCOUNT(wcount_gt, "gt")
DEF_WCOUNT(wcount_eq, "eq")
__device__ __forceinline__ float unfkey(unsigned k) { const unsigned u = (k & 0x80000000u) ? (k & 0x7fffffffu) : ~k; return __builtin_bit_cast(float, u); }
__device__ __forceinline__ void phase_indexer(const Params& p, unsigned char* lds) {
  float* sc = (float*)lds;
  const int tid = otid(), lane = tid & 63, wave = __builtin_amdgcn_readfirstlane(tid >> 6), fr = lane & 15, fq = lane >> 4;
  const bf16_t* proj = (const bf16_t*)(p.ws + WS_BIG); const bf16_t* ikn = (const bf16_t*)(p.ws + WS_IKN); u64* mask = (u64*)(p.ws + WS_MASK);
  constexpr int NITEMS = BATCH * (SEQ / 16);
  for (int it = blockIdx.x; it < NITEMS; it += gridDim.x) {
    const int b = it % BATCH, qg = (SEQ / 16 - 1) - it / BATCH, t0 = qg * 16;
    const size_t rowb = (size_t)b * SEQ;
    if (t0 + 16 <= 256) {
      if (lane < 32) { mask[(rowb + t0 + 2 * wave) * 32 + lane] = ~0ull; mask[(rowb + t0 + 2 * wave + 1) * 32 + lane] = ~0ull; }
      continue;
    }
    __syncthreads();
    {
      const bf16_t* qrow = proj + (rowb + t0 + fr) * INWP;
      bf16x8 qf[8][2];
#pragma unroll
      for (int h = 0; h < 8; ++h)
#pragma unroll
        for (int s = 0; s < 2; ++s) qf[h][s] = *(const bf16x8*)(qrow + OFF_IQ + h * 64 + s * 32 + fq * 8);
      float wq[8];
      { const u32x4 w = *(const u32x4*)(qrow + OFF_IW); const float cw = 0.04419417382415922f;
        wq[0] = bflo(w.x) * cw; wq[1] = bfhi(w.x) * cw; wq[2] = bflo(w.y) * cw; wq[3] = bfhi(w.y) * cw; wq[4] = bflo(w.z) * cw; wq[5] = bfhi(w.z) * cw; wq[6] = bflo(w.w) * cw; wq[7] = bfhi(w.w) * cw; }
      const int nkt = qg + 1;
      bf16x8 ka[4][2], kb[4][2];
#define IDX_LOAD(X, base) do { _Pragma("unroll") for (int g = 0; g < 4; ++g) { int kk = (base) + 8 * g; kk = (kk < nkt) ? kk : 0; \
          const bf16_t* krow = ikn + (rowb + kk * 16 + fr) * 64 + fq * 8; X[g][0] = *(const bf16x8*)krow; X[g][1] = *(const bf16x8*)(krow + 32); } } while (0)
#define IDX_COMP(X, base) do { _Pragma("unroll") for (int g = 0; g < 4; ++g) { const int kk = (base) + 8 * g; if (kk < nkt) { \
          f32x4 a[8]; \
          _Pragma("unroll") for (int h = 0; h < 8; ++h) a[h] = __builtin_amdgcn_mfma_f32_16x16x32_bf16(X[g][0], qf[h][0], (f32x4){0.f, 0.f, 0.f, 0.f}, 0, 0, 0); \
          _Pragma("unroll") for (int h = 0; h < 8; ++h) a[h] = __builtin_amdgcn_mfma_f32_16x16x32_bf16(X[g][1], qf[h][1], a[h], 0, 0, 0); \
          f32x4 s4 = (f32x4){0.f, 0.f, 0.f, 0.f}; \
          _Pragma("unroll") for (int h = 0; h < 8; ++h) _Pragma("unroll") for (int jj = 0; jj < 4; ++jj) s4[jj] = __builtin_fmaf(wq[h], __builtin_amdgcn_fmed3f(a[h][jj], 0.f, __builtin_inff()), s4[jj]); \
          const int c0 = kk * 16 + fq * 4; float* dp = sc + fr * SC_STRIDE + c0 + (c0 >> 5); dp[0] = s4[0]; dp[1] = s4[1]; dp[2] = s4[2]; dp[3] = s4[3]; } } } while (0)
      int kt = wave;
      IDX_LOAD(ka, kt);
#pragma unroll 1
      while (kt < nkt) {
        IDX_LOAD(kb, kt + 32);
        IDX_COMP(ka, kt);
        kt += 32;
        if (kt >= nkt) break;
        IDX_LOAD(ka, kt + 32);
        IDX_COMP(kb, kt);
        kt += 32;
      }
#undef IDX_LOAD
#undef IDX_COMP
    }
    __syncthreads();
    for (int rr = 0; rr < 2; ++rr) {
      const int r = 2 * wave + rr, t = t0 + r;
      unsigned key[32];
      float kv[32];
#pragma unroll
      for (int j = 0; j < 32; ++j) kv[j] = sc[r * SC_STRIDE + lane * 33 + j];
#pragma unroll
      for (int j = 0; j < 32; ++j) asm volatile("" : "+v"(kv[j]));
#pragma unroll
      for (int j = 0; j < 32; ++j) { const int idx = lane * 32 + j; key[j] = (idx <= t) ? fkey(kv[j]) : 0u; }
      unsigned kmx = 0u, kmn = 0xffffffffu;
#pragma unroll
      for (int j = 0; j < 32; ++j) { kmx = max(kmx, key[j]); kmn = min(kmn, key[j] ? key[j] : 0xffffffffu); }
#pragma unroll
      for (int o = 1; o < 64; o <<= 1) { kmx = max(kmx, (unsigned)__shfl_xor((int)kmx, o)); kmn = min(kmn, (unsigned)__shfl_xor((int)kmn, o)); }
      unsigned lo = kmn, hi = kmx + 1u; int clo = t + 1, chi = 0;
#pragma unroll 1
      for (int itn = 0; itn < 128; ++itn) {
        if (clo == 256 || hi - lo <= 1u || clo - chi <= 64) break;
        unsigned mid;
        if (itn % 3 == 2) mid = lo + ((hi - lo) >> 1);
        else { const float flo = unfkey(lo), fhi = unfkey(hi - 1u); const int gap = clo - chi;
          const float off = (gap <= 8) ? 0.5f : fminf((float)gap * 0.125f, 16.f);
          const float tgt = 256.f + (((clo - 256) > (256 - chi)) ? off : -off);
          const float fm = flo + (fhi - flo) * (((float)clo - tgt) / (float)gap);
          mid = fkey(fm); }
        mid = max(lo + 1u, min(mid, hi - 1u));
        const int c = wcount_ge(key, mid);
        if (c >= 256) { lo = mid; clo = c; } else { hi = mid; chi = c; }
      }
      if (clo != 256 && hi - lo > 1u && clo - chi <= 64) {
        unsigned* cand = (unsigned*)(sc + r * SC_STRIDE);
        const unsigned range = hi - lo;
        int cl = 0;
#pragma unroll
        for (int j = 0; j < 32; ++j) cl += (key[j] - lo < range) ? 1 : 0;
        int incl = cl;
#pragma unroll
        for (int o = 1; o < 64; o <<= 1) { const int v = __shfl_up(incl, o); if (lane >= o) incl += v; }
        int pos = incl - cl;
        asm volatile("s_waitcnt lgkmcnt(0)" ::: "memory");
#pragma unroll
        for (int j = 0; j < 32; ++j) { if (key[j] - lo < range) { cand[pos] = key[j]; ++pos; } }
        asm volatile("s_waitcnt lgkmcnt(0)" ::: "memory");
        const int m = clo - chi;
        const unsigned x = (lane < m) ? cand[lane] : 0u;
        int g = 0, e = 0;
#pragma unroll 4
        for (int i = 0; i < m; ++i) { const unsigned y = (unsigned)__builtin_amdgcn_readlane((int)x, i); g += (y > x) ? 1 : 0; e += (y == x) ? 1 : 0; }
        const u64 bal = __ballot(lane < m && chi + g < 256 && chi + g + e >= 256);
        lo = (unsigned)__builtin_amdgcn_readlane((int)x, (int)__builtin_ctzll(bal | (1ull << 63)));
      }
      const unsigned T = lo;
      const int cgt = wcount_gt(key, T), ceq = wcount_eq(key, T);
      const int need = 256 - cgt;
      int cutoff = 4096;
      if (ceq > need) {
        int ceql = 0;
#pragma unroll
        for (int j = 0; j < 32; ++j) ceql += (key[j] == T) ? 1 : 0;
        int incl = ceql;
#pragma unroll
        for (int o = 1; o < 64; o <<= 1) { const int v = __shfl_up(incl, o); if (lane >= o) incl += v; }
        const int excl = incl - ceql;
        int mycut = 4096;
        if (excl < need && incl >= need) { int k = need - excl;
#pragma unroll
          for (int j = 0; j < 32; ++j) { if (key[j] == T) { --k; if (k == 0) mycut = lane * 32 + j; } } }
#pragma unroll
        for (int o = 1; o < 64; o <<= 1) mycut = min(mycut, __shfl_xor(mycut, o));
        cutoff = mycut;
      }
      unsigned W = 0u;
#pragma unroll
      for (int j = 0; j < 32; ++j) { const int idx = lane * 32 + j; W |= ((key[j] > T || (key[j] == T && idx <= cutoff)) ? 1u : 0u) << j; __builtin_amdgcn_sched_barrier(0); }
      ((unsigned*)mask)[(rowb + t) * 64 + lane] = W;
    }
  }
  __syncthreads();
}

constexpr int KROW = 208, VROW = 144;
constexpr int AT_BUF = 64 * KROW + 64 * VROW;
constexpr int AT_VOFF = 64 * KROW, AT_TAB = 2 * AT_BUF, TAB_PAD = 96, AT_END = AT_TAB + (2048 + TAB_PAD) * 4;
constexpr float LOG2E = 1.4426950408889634f;
__device__ __forceinline__ s16x4 vtr(const LAS unsigned char* ptr) { return __builtin_bit_cast(s16x4, __builtin_amdgcn_ds_read_tr16_b64_v4i16((LAS s16x4*)ptr)); }

template <int KS, int TYPE>
__device__ __forceinline__ void attn_item(const Params& p, unsigned char* lds, int b, int head, int qb, int l) {
  const int tid = otid(), lane = tid & 63, wave = __builtin_amdgcn_readfirstlane(tid >> 6), fr = lane & 15, fq = lane >> 4;
  const bf16_t* proj = (const bf16_t*)(p.ws + WS_BIG); const bf16_t* mlao = (const bf16_t*)(p.ws + WS_MLAO);
  const bf16_t* Qp; const bf16_t* Kp; const bf16_t* Vp; int qpitch, kpitch; float c2;
  const size_t rowb = (size_t)b * SEQ;
  if (TYPE == 0) { Qp = proj + OFF_QA + head * 64; Kp = proj + OFF_KA + head * 64; Vp = proj + OFF_VA + head * 64; qpitch = kpitch = INWP; c2 = 0.125f * LOG2E; }
  else if (TYPE == 1) { const int hb = head - 6; Qp = mlao + hb * 96; Kp = mlao + 480 + hb * 128; Vp = Kp + 64; qpitch = kpitch = MLA_N; c2 = 0.10206207261596575f * LOG2E; }
  else { const int hc = head - 11; Qp = proj + OFF_QC + hc * 64; Kp = proj + OFF_KC + hc * 64; Vp = proj + OFF_VC + hc * 64; qpitch = kpitch = INWP; c2 = 0.125f * LOG2E; }
  const bf16_t* K2p = (const bf16_t*)(p.ws + WS_KROPE);
  const u64* mask = (const u64*)(p.ws + WS_MASK);
  float* tab = (float*)(lds + AT_TAB);
  LAS unsigned char* l3 = (LAS unsigned char*)lds;

  __syncthreads();
  if (TYPE != 1) {
    const int col = (TYPE == 0) ? head : (head - 11 + 6);
    for (int e = tid; e < 2048 + TAB_PAD; e += 512) {
      const int d = e - TAB_PAD; float v = NEGV;
      if (d >= 0) { v = p.rel_bias[t5_bucket(d) * 11 + col];
        if (TYPE == 0) { const int mult = (d <= 128) + ((d & 3) == 0 && d <= 512) + ((d & 15) == 0);
          v = (mult == 0) ? NEGV : v + (mult == 1 ? 0.f : (mult == 2 ? 0.6931471805599453f : 1.0986122886681098f)); }
        v = (v <= -1e29f) ? NEGV : v * LOG2E; }
      tab[e] = v;
    }
  }
  const int q0 = qb * 256 + wave * 32;
  bf16x8 qf[2][KS];
#pragma unroll
  for (int u = 0; u < 2; ++u)
#pragma unroll
    for (int s = 0; s < KS; ++s) qf[u][s] = *(const bf16x8*)(Qp + (rowb + q0 + u * 16 + fr) * qpitch + s * 32 + fq * 8);
  float tabmax = 0.f;
  if (TYPE != 1) { const int col = (TYPE == 0) ? head : (head - 11 + 6);
    float tv = p.rel_bias[(lane & 31) * 11 + col];
#pragma unroll
    for (int o_ = 1; o_ < 32; o_ <<= 1) tv = fmaxf(tv, __shfl_xor(tv, o_));
    tabmax = tv * LOG2E + (TYPE == 0 ? 1.5849625007211563f : 0.f); }
  const float kmax = sqrtf(__builtin_bit_cast(float, ((const unsigned*)(p.ws + WS_KMAX))[l * 256 + b * 16 + head]));
  f32x4 o[4][2]; float sinit[2], lrow[2];
#pragma unroll
  for (int u = 0; u < 2; ++u) {
    float q2 = 0.f;
#pragma unroll
    for (int s_ = 0; s_ < KS; ++s_) q2 += sumsq8(__builtin_bit_cast(u32x4, qf[u][s_]));
    q2 += __shfl_xor(q2, 16); q2 += __shfl_xor(q2, 32);
    sinit[u] = -(sqrtf(q2) * kmax * 1.0001f + tabmax / c2 + 1e-3f);
    lrow[u] = 0.f;
#pragma unroll
    for (int dt = 0; dt < 4; ++dt) o[dt][u] = (f32x4){0.f, 0.f, 0.f, 0.f}; }

  const int nkt = (qb + 1) * 4;
  const int lkey = tid >> 3, lch = tid & 7;
  u32x4 kreg, vreg, k2reg; u64 mreg[2] = {0ull, 0ull};
#define AT_PREFETCH(kt_) do { const size_t r_ = rowb + (kt_) * 64 + lkey; \
    kreg = *(const u32x4*)(Kp + r_ * kpitch + lch * 8); vreg = *(const u32x4*)(Vp + r_ * kpitch + lch * 8); \
    if (KS == 3) { if (tid < 256) k2reg = *(const u32x4*)(K2p + (rowb + (kt_) * 64 + (tid >> 2)) * 32 + (tid & 3) * 8); } \
    if (TYPE == 2) { mreg[0] = mask[(rowb + q0 + fr) * 32 + (kt_)]; mreg[1] = mask[(rowb + q0 + 16 + fr) * 32 + (kt_)]; } } while (0)
#define AT_STORE(bufo_) do { *(u32x4*)(lds + (bufo_) + lkey * KROW + lch * 16) = kreg; *(u32x4*)(lds + (bufo_) + AT_VOFF + lkey * VROW + lch * 16) = vreg; \
    if (KS == 3) { if (tid < 256) *(u32x4*)(lds + (bufo_) + (tid >> 2) * KROW + 128 + (tid & 3) * 16) = k2reg; } } while (0)
  AT_PREFETCH(0);
  AT_STORE(0);
  __syncthreads();
  float tvfar[4] = {0.f, 0.f, 0.f, 0.f};
  if (TYPE != 1) { const float bfar = tab[TAB_PAD + (TYPE == 0 ? 2032 : 2047)];
#pragma unroll
    for (int j = 0; j < 4; ++j) tvfar[j] = (TYPE == 2 || ((fr - 4 * fq - j) & 15) == 0) ? bfar : NEGV; }
#pragma unroll 1
  for (int kt = 0; kt < nkt; ++kt) {
    const int bufo = (kt & 1) * AT_BUF;
    const u64 mcur0 = mreg[0], mcur1 = mreg[1];
    if (kt + 1 < nkt) AT_PREFETCH(kt + 1);
    const int kbase = kt * 64;
    if (kbase <= q0 + 31) {
      bf16x8 kf[4][KS];
#pragma unroll
      for (int k16 = 0; k16 < 4; ++k16)
#pragma unroll
        for (int ss = 0; ss < KS; ++ss) kf[k16][ss] = *(const LAS bf16x8*)(l3 + bufo + (k16 * 16 + fr) * KROW + ss * 64 + fq * 16);
      float tv[2][16];
      if (TYPE != 1) {
        if (q0 - kbase - 63 >= (TYPE == 0 ? 513 : 113)) {
#pragma unroll
          for (int u = 0; u < 2; ++u)
#pragma unroll
            for (int k16 = 0; k16 < 4; ++k16)
#pragma unroll
              for (int j = 0; j < 4; ++j) tv[u][k16 * 4 + j] = tvfar[j];
        } else {
#pragma unroll
          for (int u = 0; u < 2; ++u) { const float* tp = tab + (q0 + u * 16 + fr - kbase + TAB_PAD - fq * 4);
#pragma unroll
            for (int k16 = 0; k16 < 4; ++k16)
#pragma unroll
              for (int j = 0; j < 4; ++j) tv[u][k16 * 4 + j] = tp[-(k16 * 16 + j)]; }
        }
      }
      __builtin_amdgcn_sched_barrier(0);
      f32x4 s[4][2];
#pragma unroll
      for (int k16 = 0; k16 < 4; ++k16) {
        s[k16][0] = (f32x4){sinit[0], sinit[0], sinit[0], sinit[0]}; s[k16][1] = (f32x4){sinit[1], sinit[1], sinit[1], sinit[1]};
#pragma unroll
        for (int ss = 0; ss < KS; ++ss) {
          s[k16][0] = __builtin_amdgcn_mfma_f32_16x16x32_bf16(kf[k16][ss], qf[0][ss], s[k16][0], 0, 0, 0);
          s[k16][1] = __builtin_amdgcn_mfma_f32_16x16x32_bf16(kf[k16][ss], qf[1][ss], s[k16][1], 0, 0, 0);
        }
      }
      __builtin_amdgcn_sched_barrier(0);
      s16x4 vv[2][4][2];
#pragma unroll
      for (int kc = 0; kc < 2; ++kc)
#pragma unroll
        for (int dt = 0; dt < 4; ++dt) {
          const LAS unsigned char* vb = l3 + bufo + AT_VOFF + (kc * 32 + 4 * fq + (fr >> 2)) * VROW + (dt * 16 + 4 * (fr & 3)) * 2;
          vv[kc][dt][0] = vtr(vb); vv[kc][dt][1] = vtr(vb + 16 * VROW);
        }
      __builtin_amdgcn_sched_barrier(0);
      const bool diag = (kbase + 63 > q0);
      bf16x8 pb[2][2];
#pragma unroll
      for (int u = 0; u < 2; ++u) {
        const int qpos = q0 + u * 16 + fr;
        unsigned wlo = 0u, whi = 0u;
        if (TYPE == 2) { const u64 mw = u ? mcur1 : mcur0; wlo = (unsigned)mw >> (fq * 4); whi = (unsigned)(mw >> 32) >> (fq * 4); }
        float ps = 0.f;
#pragma unroll
        for (int k16 = 0; k16 < 4; ++k16)
#pragma unroll
          for (int j = 0; j < 4; ++j) {
            float v;
            if (TYPE != 1) v = __builtin_fmaf(s[k16][u][j], c2, tv[u][k16 * 4 + j]);
            else { v = s[k16][u][j] * c2; if (diag) v = (kbase + k16 * 16 + fq * 4 + j > qpos) ? NEGV : v; }
            float e = __builtin_amdgcn_exp2f(v);
            if (TYPE == 2) { unsigned sel; asm("v_bfe_i32 %0, %1, %2, 1" : "=v"(sel) : "v"((k16 < 2) ? wlo : whi), "n"((k16 & 1) * 16 + j));
              e = __builtin_bit_cast(float, __builtin_bit_cast(unsigned, e) & sel); }
            s[k16][u][j] = e; ps += e;
          }
        lrow[u] += ps;
#pragma unroll
        for (int kc = 0; kc < 2; ++kc) {
          u32x4 w; w.x = cvt_pk_bf16(s[2 * kc][u][0], s[2 * kc][u][1]); w.y = cvt_pk_bf16(s[2 * kc][u][2], s[2 * kc][u][3]);
          w.z = cvt_pk_bf16(s[2 * kc + 1][u][0], s[2 * kc + 1][u][1]); w.w = cvt_pk_bf16(s[2 * kc + 1][u][2], s[2 * kc + 1][u][3]);
          pb[u][kc] = __builtin_bit_cast(bf16x8, w);
        }
      }
#pragma unroll
      for (int kc = 0; kc < 2; ++kc)
#pragma unroll
        for (int dt = 0; dt < 4; ++dt) {
          const bf16x8 vf = __builtin_shufflevector(vv[kc][dt][0], vv[kc][dt][1], 0, 1, 2, 3, 4, 5, 6, 7);
          o[dt][0] = __builtin_amdgcn_mfma_f32_16x16x32_bf16(vf, pb[0][kc], o[dt][0], 0, 0, 0);
          o[dt][1] = __builtin_amdgcn_mfma_f32_16x16x32_bf16(vf, pb[1][kc], o[dt][1], 0, 0, 0);
        }
    }
    if (kt + 1 < nkt) AT_STORE(AT_BUF - bufo);
    __syncthreads();
  }
#undef AT_PREFETCH
#undef AT_STORE
  bf16_t* outp = (bf16_t*)(p.ws + WS_NB);
#pragma unroll
  for (int u = 0; u < 2; ++u) {
    float l = lrow[u]; l += __shfl_xor(l, 16); l += __shfl_xor(l, 32);
    const float il = 1.f / l;
    bf16_t* orow = outp + (rowb + q0 + u * 16 + fr) * DM + head * 64 + fq * 4;
#pragma unroll
    for (int dt = 0; dt < 4; ++dt) { u32x2 w; w.x = cvt_pk_bf16(o[dt][u][0] * il, o[dt][u][1] * il); w.y = cvt_pk_bf16(o[dt][u][2] * il, o[dt][u][3] * il);
      *(u32x2*)(orow + dt * 16) = w; }
  }
}
__device__ __forceinline__ void phase_attn(const Params& p, unsigned char* lds, int l) {
  constexpr int NITEMS = BATCH * 16 * 8;
  for (int it = blockIdx.x; it < NITEMS; it += gridDim.x) {
    const int r = it >> 8, c = it & 255;
    const int qb = (r & 1) ? (r >> 1) : 7 - (r >> 1), b = c >> 4, head = ((c & 15) + 2 * r) & 15;
    if (head < 6) attn_item<2, 0>(p, lds, b, head, qb, l);
    else if (head < 11) attn_item<3, 1>(p, lds, b, head, qb, l);
    else attn_item<2, 2>(p, lds, b, head, qb, l);
  }
  __syncthreads();
}

#define XB_TMO      128
#define XB_XCNT(j)  (256  + 64 * (j))
#define XB_XSUB(j)  (1280 + 64 * (j))
#define XB_XGEN(j)  (2304 + 64 * (j))
#define XB_TOP      3328
#define XB_TOPGEN   3392
#define XCD_BAR_WORDS 3456
#define XB_SPIN_CAP (1u << 18)
__device__ __forceinline__ unsigned xb_ld(unsigned* p)              { return __hip_atomic_load(p, __ATOMIC_RELAXED, __HIP_MEMORY_SCOPE_AGENT); }
__device__ __forceinline__ unsigned xb_add(unsigned* p, unsigned v) { return __hip_atomic_fetch_add(p, v, __ATOMIC_RELAXED, __HIP_MEMORY_SCOPE_AGENT); }
__device__ __forceinline__ unsigned xb_xcc_id() { return (unsigned)__builtin_amdgcn_s_getreg((3 << 11) | 20) & 0xFu; }
#define XB_SPIN(cond, bar) do { unsigned _sp = 0; while (cond) { __builtin_amdgcn_s_sleep(1); \
    if ((++_sp & 255u) == 0u) { if (xb_ld(&(bar)[XB_TMO])) break; if (_sp > XB_SPIN_CAP) { atomicAdd(&(bar)[XB_TMO], 1u); break; } } } } while (0)
struct XcdBarrier { unsigned* bar; unsigned x; volatile LAS unsigned* st; };
__device__ __forceinline__ XcdBarrier xcd_barrier_post(unsigned* bar, volatile LAS unsigned* st) {
  XcdBarrier b; b.bar = bar; b.x = xb_xcc_id(); b.st = st;
  if (threadIdx.x == 0) (void)xb_add(&bar[XB_XCNT(b.x)], 1u);
  return b;
}
__device__ __forceinline__ void xcd_barrier_complete(unsigned* bar, unsigned x, unsigned& nloc, unsigned& nx) {
  const unsigned G = gridDim.x * gridDim.y * gridDim.z;
  unsigned sum, cnt, mine, sp = 0u;
  for (;;) {
    sum = 0u; cnt = 0u; mine = 0u;
#pragma unroll
    for (unsigned j = 0; j < 16; ++j) { const unsigned c = xb_ld(&bar[XB_XCNT(j)]); sum += c; cnt += (c > 0u) ? 1u : 0u; mine = (j == x) ? c : mine; }
    if (sum == G) break;
    __builtin_amdgcn_s_sleep(1);
    if ((++sp & 255u) == 0u) { if (xb_ld(&bar[XB_TMO])) break; if (sp > XB_SPIN_CAP) { atomicAdd(&bar[XB_TMO], 1u); break; } }
  }
  nloc = mine > 0u ? mine : 1u; nx = cnt > 0u ? cnt : 1u;
}
__device__ __forceinline__ void xcd_barrier(const XcdBarrier& b) {
  asm volatile("s_waitcnt vmcnt(0)" ::: "memory");
  __syncthreads();
  if (threadIdx.x == 0) {
    unsigned* bar = b.bar;
    __builtin_amdgcn_s_waitcnt(0);
    unsigned nloc = b.st[0], nx = b.st[1];
    if (nloc == 0u) { xcd_barrier_complete(bar, b.x, nloc, nx); b.st[0] = nloc; b.st[1] = nx; }
    const unsigned old = xb_add(&bar[XB_XSUB(b.x)], 1u);
    const unsigned gen = old / nloc;
    if (old + 1u == (gen + 1u) * nloc) {
      __builtin_amdgcn_fence(__ATOMIC_RELEASE, "agent");
      asm volatile("s_waitcnt vmcnt(0)" ::: "memory");
      const unsigned og = xb_add(&bar[XB_TOP], 1u);
      const unsigned tg = og / nx;
      if (og + 1u == (tg + 1u) * nx) xb_add(&bar[XB_TOPGEN], 1u);
      else XB_SPIN(xb_ld(&bar[XB_TOPGEN]) == tg, bar);
      __builtin_amdgcn_fence(__ATOMIC_ACQUIRE, "agent");
      xb_add(&bar[XB_XGEN(b.x)], 1u);
      asm volatile("s_waitcnt vmcnt(0)" ::: "memory");
    } else {
      XB_SPIN(xb_ld(&bar[XB_XGEN(b.x)]) == gen, bar);
      __builtin_amdgcn_fence(__ATOMIC_ACQUIRE, "agent");
      asm volatile("s_waitcnt vmcnt(0)" ::: "memory");
    }
  }
  __syncthreads();
}

#ifndef PHMASK
#define PHMASK 0xFFFFu
#endif
#ifndef DUPMASK
#define DUPMASK 0u
#endif
__global__ void __launch_bounds__(512) mega(Params p_unused) {
#if defined(__HIP_DEVICE_COMPILE__)
  extern __shared__ __attribute__((aligned(16))) unsigned char lds[];
  cg::grid_group grid = cg::this_grid();
  { volatile LAS unsigned* st = (volatile LAS unsigned*)((LAS unsigned char*)lds + (LDS_BYTES - 16)); if (threadIdx.x < 2) st[threadIdx.x] = 0u; }
  __syncthreads();
  (void)xcd_barrier_post((unsigned*)((*kparams()).ws + WS_BAR), (volatile LAS unsigned*)((LAS unsigned char*)lds + (LDS_BYTES - 16)));
  int nsteps = 3 + 10 * DEPTH + 1;
  asm volatile("" : "+s"(nsteps));
#pragma unroll 1
  for (int step = 0; step < nsteps; ++step) {
    const Params p = *kparams();
    if (step == 0) { phase0(p, lds); }
    else if (step == 1) { phase_mod_reduce(p); }
    else if (step == 2) { phase_cvec(p); phase_norm0(p.x, p.norm_ffn1, (const float*)(p.ws + WS_MOD) + 1 * DM, (bf16_t*)(p.ws + WS_NB), (float*)(p.ws + WS_SSQ)); }
    else if (step == nsteps - 1) { phase_final_norm(p.out, p.final_norm); }
    else {
      const int l = (step - 3) / 10, si = (step - 3) % 10, sub = si + 1 + (si >= 2) + (si >= 8);
      unsigned char* wl = p.ws + WS_W + (size_t)l * WL_STRIDE;
      const float* mod = (const float*)(p.ws + WS_MOD) + (size_t)l * 16 * MODW;
      const float* hin = (l == 0) ? p.x : p.out;
      bf16_t* NB = (bf16_t*)(p.ws + WS_NB); bf16_t* BIG = (bf16_t*)(p.ws + WS_BIG); bf16_t* HID2 = (bf16_t*)(p.ws + WS_BIG + 64 * MiB);
      float* ssq = (float*)(p.ws + WS_SSQ); const float* cvl = (const float*)(p.ws + WS_CV) + (size_t)l * 3 * CV_STRIDE;
      if (sub == 5) { phase_prep(p, l); }
      else if (sub == 7) { phase_qrope(p, l); phase_indexer(p, lds); }
      else if (sub == 8) { phase_attn(p, lds, l); }
      else {
        const bool isgu = (sub == 1 || sub == 11), isdn = (sub == 2 || sub == 12);
        const bf16_t* A = (sub == 2 || sub == 11) ? BIG : (sub == 12) ? HID2 : (sub == 6) ? (const bf16_t*)(p.ws + WS_MLAA) : NB;
        const size_t wo = (sub == 1) ? WO_GU1 : (sub == 11) ? WO_GU2 : (sub == 2) ? WO_D1 : (sub == 12) ? WO_D2 : (sub == 4) ? WO_IN : (sub == 6) ? WO_MLA : WO_OUT;
        const bf16_t* Bt = (const bf16_t*)(wl + wo);
        const int N = isgu ? NGU : (sub == 4) ? INWP : (sub == 6) ? MLA_N : DM, K = isdn ? DFF : (sub == 6) ? MLA_K : DM;
        pg8::EpiDyn E; E.sub = sub; E.l = l;
        run_gemm(lds, A, Bt, N, K, E);
      }
    }
    if (step == 0) grid.sync();
    else { XcdBarrier xbar; xbar.bar = (unsigned*)((*kparams()).ws + WS_BAR); xbar.x = xb_xcc_id(); xbar.st = (volatile LAS unsigned*)((LAS unsigned char*)lds + (LDS_BYTES - 16)); xcd_barrier(xbar); }
  }
#endif
}

extern "C" void kernel_launch(void* const* d_in, const int* in_sizes, int n_in, void* d_out, int out_size, void* d_ws, size_t ws_size, hipStream_t stream) {
  static int grid_blocks = 0;
  if (!grid_blocks) {
    int dev = 0, cus = 0, per_cu = 0;
    (void)hipGetDevice(&dev);
    (void)hipDeviceGetAttribute(&cus, hipDeviceAttributeMultiprocessorCount, dev);
    (void)hipFuncSetAttribute((const void*)mega, hipFuncAttributeMaxDynamicSharedMemorySize, LDS_BYTES);
    (void)hipOccupancyMaxActiveBlocksPerMultiprocessor(&per_cu, (const void*)mega, 512, LDS_BYTES);
    if (per_cu < 1) per_cu = 1;
    grid_blocks = cus * per_cu;
    if (ws_size < WS_END) fprintf(stderr, "kernel_launch: workspace too small: %zu < %zu\n", ws_size, (size_t)WS_END);
  }
  Params p{};
  p.x = (const float*)d_in[0]; p.c = (const float*)d_in[1]; p.pos = (const int*)d_in[2]; p.rel_bias = (const float*)d_in[3]; p.ada_w = (const float*)d_in[4]; p.ada_b = (const float*)d_in[5];
  p.norm_ffn1 = (const float*)d_in[6]; p.ffn1_gu = (const float*)d_in[7]; p.ffn1_down = (const float*)d_in[8]; p.norm_mix = (const float*)d_in[9]; p.w_in = (const float*)d_in[10];
  p.q_norm = (const float*)d_in[11]; p.w_uq = (const float*)d_in[12]; p.kv_norm = (const float*)d_in[13]; p.w_ukv = (const float*)d_in[14]; p.ik_norm = (const float*)d_in[15]; p.w_out = (const float*)d_in[16];
  p.norm_ffn2 = (const float*)d_in[17]; p.ffn2_gu = (const float*)d_in[18]; p.ffn2_down = (const float*)d_in[19]; p.final_norm = (const float*)d_in[20];
  p.out = (float*)d_out; p.ws = (unsigned char*)d_ws;
  (void)hipMemsetAsync((unsigned char*)d_ws + WS_BAR, 0, 16384, stream);
  void* args[] = {&p};
  hipError_t e = hipLaunchCooperativeKernel((void*)mega, dim3(grid_blocks), dim3(512), args, LDS_BYTES, stream);
  if (e != hipSuccess) fprintf(stderr, "cooperative launch failed: %s (grid %d)\n", hipGetErrorString(e), grid_blocks);
}
```

```cpp
#include <hip/hip_runtime.h>
#include <hip/hip_cooperative_groups.h>
#include <cstdio>
#include <cstdint>
namespace cg = cooperative_groups;

#define LAS __attribute__((address_space(3)))
typedef unsigned short bf16_t;
typedef short bf16x8 __attribute__((ext_vector_type(8)));
typedef short s16x4 __attribute__((ext_vector_type(4)));
typedef float f32x4 __attribute__((ext_vector_type(4)));
typedef float f32x2 __attribute__((ext_vector_type(2)));
typedef unsigned u32x4 __attribute__((ext_vector_type(4)));
typedef unsigned u32x2 __attribute__((ext_vector_type(2)));
typedef unsigned long long u64;

constexpr int BATCH = 16, SEQ = 2048, DM = 1024, MTOK = BATCH * SEQ, DFF = 2816, NGU = 2 * DFF, INW = 3112, INWP = 3328, NMOD = 9, DEPTH = 2;
constexpr int OFF_QA = 0, OFF_KA = 384, OFF_VA = 768, OFF_CQ = 1152, OFF_CKV = 1408, OFF_KR = 1536, OFF_QC = 1568, OFF_KC = 1888, OFF_VC = 2208, OFF_IQ = 2528, OFF_IK = 3040, OFF_IW = 3104;
constexpr int MLA_K = 384, MLA_N = 1280;
constexpr int MODW = NMOD * DM;
constexpr float RMS_EPS = 1e-6f;
constexpr float NEGV = -1e30f;

constexpr size_t MiB = 1ull << 20;
constexpr size_t WS_NB = 0;
constexpr size_t WS_BIG = 64 * MiB;
constexpr size_t WS_MLAA = 272 * MiB;
constexpr size_t WS_MLAO = 296 * MiB;
constexpr size_t WS_KROPE = 376 * MiB;
constexpr size_t WS_IKN = 378 * MiB;
constexpr size_t WS_MASK = 382 * MiB;
constexpr size_t WS_MOD = 390 * MiB;
constexpr size_t WS_ADAP = 392 * MiB;
constexpr size_t WS_W = 402 * MiB;
constexpr size_t WL_STRIDE = 43 * MiB;
constexpr size_t WO_GU1 = 0, WO_D1 = 11 * MiB, WO_IN = 11 * MiB + 5632 * 1024, WO_MLA = WO_IN + (size_t)INWP * 1024 * 2, WO_OUT = WO_MLA + 1 * MiB, WO_GU2 = WO_OUT + 2 * MiB, WO_D2 = WO_GU2 + 11 * MiB;
static_assert(WO_D2 + 5632 * 1024 <= WL_STRIDE, "weights map");
constexpr size_t WS_BAR = WS_W + 2 * WL_STRIDE;
constexpr size_t WS_SSQ = WS_BAR + 1 * MiB;
constexpr size_t WS_CV = WS_SSQ + 1 * MiB;
constexpr size_t CV_STRIDE = 16 * 5632;
constexpr size_t WS_END = WS_CV + 4 * MiB;

constexpr int LDS_BYTES = 143360;

struct Params {
  const float* x; const float* c; const int* pos; const float* rel_bias; const float* ada_w; const float* ada_b;
  const float* norm_ffn1; const float* ffn1_gu; const float* ffn1_down; const float* norm_mix; const float* w_in;
  const float* q_norm; const float* w_uq; const float* kv_norm; const float* w_ukv; const float* ik_norm; const float* w_out;
  const float* norm_ffn2; const float* ffn2_gu; const float* ffn2_down; const float* final_norm;
  float* out; unsigned char* ws;
};

__device__ __forceinline__ unsigned cvt_pk_bf16(float lo, float hi) { unsigned r; asm volatile("v_cvt_pk_bf16_f32 %0, %1, %2" : "=v"(r) : "v"(lo), "v"(hi)); return r; }
__device__ __forceinline__ float bf2f(unsigned short h) { return __builtin_bit_cast(float, (unsigned)h << 16); }
__device__ __forceinline__ float bflo(unsigned w) { return __builtin_bit_cast(float, w << 16); }
__device__ __forceinline__ float bfhi(unsigned w) { return __builtin_bit_cast(float, w & 0xffff0000u); }
__device__ __forceinline__ unsigned short f2bf(float f) { return (unsigned short)(cvt_pk_bf16(f, 0.f) & 0xffffu); }
__device__ __forceinline__ int otid() { int t = threadIdx.x; asm volatile("" : "+v"(t)); return t; }
__device__ __forceinline__ float wave_sum(float v) {
#pragma unroll
  for (int o = 1; o < 64; o <<= 1) v += __shfl_xor(v, o);
  return v;
}
__device__ __forceinline__ int t5_bucket(int n) {
  if (n < 16) return n;
  int b = 16;
  b += (n >= 19); b += (n >= 21); b += (n >= 24); b += (n >= 27); b += (n >= 31); b += (n >= 35); b += (n >= 40); b += (n >= 46);
  b += (n >= 52); b += (n >= 59); b += (n >= 67); b += (n >= 77); b += (n >= 87); b += (n >= 99); b += (n >= 113);
  return b;
}
__device__ __forceinline__ void sincos_big(float ang, float& s, float& c) {
  double rev = (double)ang * 0.15915494309189535;
  rev -= __builtin_floor(rev);
  float fr = (float)rev;
  s = __builtin_amdgcn_sinf(fr); c = __builtin_amdgcn_cosf(fr);
}
__device__ __forceinline__ float rope_inv(int i) { return __builtin_amdgcn_exp2f(-(float)i * (13.287712379549449f / 16.f)); }

typedef const Params __attribute__((address_space(4)))* cparams_t;
__device__ __forceinline__ cparams_t kparams() { cparams_t q = (cparams_t)__builtin_amdgcn_kernarg_segment_ptr(); asm volatile("" : "+s"(q)); return q; }
namespace pg8 {
constexpr int BM = 256, BK = 64, HALF = 128, HTB = HALF * BK * 2, STAGE_BYTES = 8 * HTB, NXCD = 8, WGM = 4;
__host__ __device__ __forceinline__ int lds_byte(int r, int c) { const int st = (r >> 4) * 2 + (c >> 5), rr = r & 15, cc = c & 31, ob = rr * 64 + cc * 2; return st * 1024 + (ob ^ (((ob >> 9) & 1) << 5)); }
__host__ __device__ __forceinline__ void stage_rc(int b, int& R, int& C) { const int st = b / 1024, sb = b % 1024, swz = sb ^ (((sb >> 9) & 1) << 5); R = (st >> 1) * 16 + swz / 64; C = (st & 1) * 32 + (swz % 64) / 2; }
__host__ __device__ __forceinline__ int perm32(int rho) { const int n = rho >> 4, i = rho & 15; return 8 * (i >> 2) + 4 * n + (i & 3); }
struct Unit { int pm, pn; };
struct Gemm { const bf16_t* A; const bf16_t* Bt; int M, N, K; };
struct StaticOrder {
  int nM, nN, nwg, G, c;
  __host__ __device__ void init(int M, int N, int G_, int c_) { nM = M / BM; nN = N / BM; nwg = nM * nN; G = G_; c = c_; }
  __host__ __device__ bool next(int i, Unit& u) const {
    const long L = (long)i * G + c; if (L >= nwg) return false;
    int wgid = (int)L; { const int q = nwg / NXCD, r = nwg % NXCD, xcd = wgid % NXCD, off = wgid / NXCD; wgid = (xcd < r ? xcd * (q + 1) : r * (q + 1) + (xcd - r) * q) + off; }
    const int nig = WGM * nN, gid = wgid / nig, fm = gid * WGM, gsz = (nM - fm) < WGM ? (nM - fm) : WGM;
    u.pm = fm + ((wgid % nig) % gsz); u.pn = (wgid % nig) / gsz; return true;
  }
  __device__ __forceinline__ void a_ready(const Unit&) const {}
  __device__ __forceinline__ void done(const Unit&) const {}
};

__device__ __forceinline__ float silu_mul(float g, float uu) { return g * __builtin_amdgcn_rcpf(1.f + __expf(-g)) * uu; }
struct EpiDyn {
  static constexpr bool PERM = true, AFTER_DRAIN = false;
  int sub, l;
  __device__ __forceinline__ void operator()(const f32x4 (&acc)[2][2][4][2], const Unit& u, int wr, int wc, int fr, int fq) const {
#if defined(__HIP_DEVICE_COMPILE__)
    const Params p = *kparams();
    unsigned char* wsb = p.ws;
    const float* mod = (const float*)(wsb + WS_MOD) + (size_t)l * 16 * MODW;
    bf16_t* NBp = (bf16_t*)(wsb + WS_NB); bf16_t* BIGp = (bf16_t*)(wsb + WS_BIG); bf16_t* HID2p = (bf16_t*)(wsb + WS_BIG + 64 * MiB);
    float* ssqb = (float*)(wsb + WS_SSQ); const float* cvl = (const float*)(wsb + WS_CV) + (size_t)l * 3 * CV_STRIDE;
    const bool isgu = (sub == 1 || sub == 11), isdn = (sub == 2 || sub == 12), isres = isdn || sub == 9, lastd = (sub == 12 && l + 1 >= DEPTH);
    const int type = isgu ? 1 : isres ? 2 : 0;
    bf16_t* O = (sub == 1 || sub == 4) ? BIGp : (sub == 11) ? HID2p : (bf16_t*)(wsb + WS_MLAO);
    const int ldc = (sub == 4) ? INWP : MLA_N, ncv = 5632;
    const float* ssq = (sub == 6) ? (const float*)nullptr : (const float*)ssqb;
    const float* cv = cvl + ((sub == 1) ? 0 : (sub == 4) ? 1 : 2) * CV_STRIDE;
    const float* src = (sub == 2 && l == 0) ? p.x : (const float*)p.out; float* dst = p.out;
    const float* gate = mod + ((sub == 2) ? 2 : (sub == 12) ? 8 : 5) * DM; const float coef = isdn ? 0.5f : 1.0f;
    bf16_t* nbo = lastd ? (bf16_t*)nullptr : (sub == 9) ? BIGp : NBp;
    const float* gain_n = (sub == 2) ? p.norm_mix + l * DM : (sub == 9) ? p.norm_ffn2 + l * DM : p.norm_ffn1 + (lastd ? 0 : (l + 1)) * DM;
    const float* scale_n = (sub == 2) ? mod + 4 * DM : (sub == 9) ? mod + 7 * DM : mod + 16 * MODW + 1 * DM;
    float* ssq_o = ssqb;
    extern __shared__ __attribute__((aligned(16))) unsigned char lds_epi[];
    LAS float* ps = (LAS float*)((LAS unsigned char*)lds_epi + 131072);
    const int row0 = u.pm * BM + wr * 64 + fr, b = u.pm >> 3;
    if (type == 0) {
      const int col0 = u.pn * BM + wc * 32 + 8 * fq;
      f32x4 cvv[2][2];
#pragma unroll
      for (int bj = 0; bj < 2; ++bj)
#pragma unroll
        for (int n = 0; n < 2; ++n) cvv[bj][n] = ssq ? *(const f32x4*)(cv + (size_t)b * ncv + col0 + bj * HALF + 4 * n) : (f32x4){0.f, 0.f, 0.f, 0.f};
      f32x4 qv[2][4];
#pragma unroll
      for (int ai = 0; ai < 2; ++ai)
#pragma unroll
        for (int m = 0; m < 4; ++m) qv[ai][m] = ssq ? *(const f32x4*)(ssq + (size_t)(row0 + ai * HALF + m * 16) * 4) : (f32x4){0.f, 0.f, 0.f, 0.f};
#pragma unroll
      for (int ai = 0; ai < 2; ++ai)
#pragma unroll
        for (int m = 0; m < 4; ++m) { const int row = row0 + ai * HALF + m * 16; bf16_t* rowp = O + (size_t)row * ldc + col0;
          float rs = 1.f;
          if (ssq) { const f32x4 q = qv[ai][m]; rs = __builtin_amdgcn_rsqf(((q[0] + q[1]) + (q[2] + q[3])) * (1.f / DM) + RMS_EPS); }
#pragma unroll
          for (int bj = 0; bj < 2; ++bj) { const f32x4 v0 = acc[ai][bj][m][0] * rs + cvv[bj][0], v1 = acc[ai][bj][m][1] * rs + cvv[bj][1];
            u32x4 w; w.x = cvt_pk_bf16(v0[0], v0[1]); w.y = cvt_pk_bf16(v0[2], v0[3]); w.z = cvt_pk_bf16(v1[0], v1[1]); w.w = cvt_pk_bf16(v1[2], v1[3]);
            *(u32x4*)(rowp + bj * HALF) = w; } }
    } else if (type == 1) {
      const int col0 = u.pn * HALF + wc * 32 + 8 * fq, ccol = u.pn * BM + wc * 32 + 8 * fq;
      f32x4 cvv[2][2];
#pragma unroll
      for (int bj = 0; bj < 2; ++bj)
#pragma unroll
        for (int n = 0; n < 2; ++n) cvv[bj][n] = *(const f32x4*)(cv + (size_t)b * ncv + ccol + bj * HALF + 4 * n);
      f32x4 qv[2][4];
#pragma unroll
      for (int ai = 0; ai < 2; ++ai)
#pragma unroll
        for (int m = 0; m < 4; ++m) qv[ai][m] = *(const f32x4*)(ssq + (size_t)(row0 + ai * HALF + m * 16) * 4);
#pragma unroll
      for (int ai = 0; ai < 2; ++ai)
#pragma unroll
        for (int m = 0; m < 4; ++m) { const int row = row0 + ai * HALF + m * 16; bf16_t* rowp = O + (size_t)row * DFF + col0;
          const f32x4 q = qv[ai][m]; const float rs = __builtin_amdgcn_rsqf(((q[0] + q[1]) + (q[2] + q[3])) * (1.f / DM) + RMS_EPS);
          const f32x4 g0 = acc[ai][0][m][0] * rs + cvv[0][0], g1 = acc[ai][0][m][1] * rs + cvv[0][1], u0 = acc[ai][1][m][0] * rs + cvv[1][0], u1 = acc[ai][1][m][1] * rs + cvv[1][1];
          u32x4 w; w.x = cvt_pk_bf16(silu_mul(g0[0], u0[0]), silu_mul(g0[1], u0[1])); w.y = cvt_pk_bf16(silu_mul(g0[2], u0[2]), silu_mul(g0[3], u0[3]));
          w.z = cvt_pk_bf16(silu_mul(g1[0], u1[0]), silu_mul(g1[1], u1[1])); w.w = cvt_pk_bf16(silu_mul(g1[2], u1[2]), silu_mul(g1[3], u1[3]));
          *(u32x4*)rowp = w; }
    } else {
      const int col0 = u.pn * BM + wc * 32 + 8 * fq;
      const float* gp = gate + (size_t)b * MODW + col0;
      f32x4 gv[2][2], gn[2][2], g1[2][2], g2[2][2];
#pragma unroll
      for (int bj = 0; bj < 2; ++bj)
#pragma unroll
        for (int n = 0; n < 2; ++n) { gv[bj][n] = *(const f32x4*)(gp + bj * HALF + 4 * n);
          g1[bj][n] = nbo ? *(const f32x4*)(gain_n + col0 + bj * HALF + 4 * n) : (f32x4){0.f, 0.f, 0.f, 0.f};
          g2[bj][n] = nbo ? *(const f32x4*)(scale_n + (size_t)b * MODW + col0 + bj * HALF + 4 * n) : (f32x4){0.f, 0.f, 0.f, 0.f}; }
      __builtin_amdgcn_sched_barrier(0);
#pragma unroll
      for (int bj = 0; bj < 2; ++bj)
#pragma unroll
        for (int n = 0; n < 2; ++n) { gv[bj][n] = gv[bj][n] * coef; gn[bj][n] = g1[bj][n] * (g2[bj][n] + 1.f); }
#pragma unroll
      for (int aim = 0; aim < 4; ++aim) { const int ai = aim >> 1, m0 = (aim & 1) * 2;
        f32x4 svv[2][2][2];
#pragma unroll
        for (int mm = 0; mm < 2; ++mm)
#pragma unroll
          for (int bj = 0; bj < 2; ++bj)
#pragma unroll
            for (int n = 0; n < 2; ++n) svv[mm][bj][n] = *(const f32x4*)(src + (size_t)(row0 + ai * HALF + (m0 + mm) * 16) * DM + col0 + bj * HALF + 4 * n);
        __builtin_amdgcn_sched_barrier(0);
#pragma unroll
        for (int m = m0; m < m0 + 2; ++m) { const size_t ro = (size_t)(row0 + ai * HALF + m * 16) * DM + col0; float ss = 0.f;
#pragma unroll
          for (int bj = 0; bj < 2; ++bj) { f32x4 hn[2];
#pragma unroll
            for (int n = 0; n < 2; ++n) { const f32x4 sv = svv[m - m0][bj][n]; hn[n] = sv + gv[bj][n] * acc[ai][bj][m][n];
              *(f32x4*)(dst + ro + bj * HALF + 4 * n) = hn[n]; ss += (hn[n][0] * hn[n][0] + hn[n][1] * hn[n][1]) + (hn[n][2] * hn[n][2] + hn[n][3] * hn[n][3]); }
            if (nbo) { const f32x4 y0 = hn[0] * gn[bj][0], y1 = hn[1] * gn[bj][1];
              u32x4 w; w.x = cvt_pk_bf16(y0[0], y0[1]); w.y = cvt_pk_bf16(y0[2], y0[3]); w.z = cvt_pk_bf16(y1[0], y1[1]); w.w = cvt_pk_bf16(y1[2], y1[3]);
              *(u32x4*)(nbo + ro + bj * HALF) = w; } }
          if (nbo) { ss += __shfl_xor(ss, 16); ss += __shfl_xor(ss, 32);
            int t2 = threadIdx.x; asm volatile("" : "+v"(t2));
            if ((t2 & 48) == 0) ps[((t2 >> 6) & 3) * 256 + ai * HALF + ((t2 >> 8) & 1) * 64 + m * 16 + (t2 & 15)] = ss; } }
      }
      if (nbo) {
        asm volatile("s_waitcnt lgkmcnt(0)" ::: "memory"); __builtin_amdgcn_s_barrier();
        int tid = threadIdx.x; asm volatile("" : "+v"(tid));
        if (tid < 256) { const float tot = (ps[tid] + ps[256 + tid]) + (ps[512 + tid] + ps[768 + tid]); ssq_o[(size_t)(u.pm * BM + tid) * 4 + u.pn] = tot; }
      }
    }
#endif
  }
};

template <class Epi, class Sched, bool ALIGN_EPI = false, bool SP2 = false>
__device__ __forceinline__ void gemm_phase(LAS unsigned char* lds, const Gemm g, const Sched S, const Epi E) {
  const int tid = otid(), wid = __builtin_amdgcn_readfirstlane(tid >> 6), lane = tid & 63, wr = wid >> 2, wc = wid & 3, fr = lane & 15, fq = lane >> 4;
  const int K = g.K, nt = K / BK;
  unsigned voffA[2], voffB[2];
#pragma unroll
  for (int i = 0; i < 2; ++i) { int R, C; stage_rc(tid * 16 + i * 8192, R, C); const int Rb = Epi::PERM ? ((R & ~31) + perm32(R & 31)) : R;
    voffA[i] = (unsigned)(R * K + C) * 2u; voffB[i] = (unsigned)(Rb * K + C) * 2u; }
  const size_t kstep = (size_t)(BK * 2);
  const size_t hstep = (size_t)HALF * K * 2;
  const size_t tstep = 2 * hstep;
  const unsigned ldsw = (unsigned)wid * 1024u;
  const int aoff = lds_byte(wr * 64 + fr, fq * 8), boff = lds_byte(wc * 32 + fr, fq * 8);
#define PG8_SA(b, h) (((b) * 2 + (h)) * HTB)
#define PG8_SB(b, h) ((4 + (b) * 2 + (h)) * HTB)
#define PG8_STAGE(bufoff, gbase, voff) do { _Pragma("unroll") for (int _i = 0; _i < 2; ++_i) \
        __builtin_amdgcn_global_load_lds((const unsigned*)((const char*)(gbase) + (voff)[_i]), (LAS unsigned*)(lds + (bufoff) + ldsw + _i * 8192), 16, 0, 0); } while (0)
#define PG8_LDA(dst, b, h) do { _Pragma("unroll") for (int m = 0; m < 4; ++m) _Pragma("unroll") for (int k = 0; k < 2; ++k) dst[m][k] = *(const LAS bf16x8*)(lds + PG8_SA(b, h) + aoff + m * 2048 + k * 1024); } while (0)
#define PG8_LDB(dst, b, h) do { _Pragma("unroll") for (int n = 0; n < 2; ++n) _Pragma("unroll") for (int k = 0; k < 2; ++k) dst[n][k] = *(const LAS bf16x8*)(lds + PG8_SB(b, h) + boff + n * 2048 + k * 1024); } while (0)
#define PG8_MMA(ai, bj, At, Bt) do { __builtin_amdgcn_s_setprio(1); _Pragma("unroll") for (int m = 0; m < 4; ++m) _Pragma("unroll") for (int n = 0; n < 2; ++n) _Pragma("unroll") for (int k = 0; k < 2; ++k) \
        acc[ai][bj][m][n] = __builtin_amdgcn_mfma_f32_16x16x32_bf16(Bt[n][k], At[m][k], acc[ai][bj][m][n], 0, 0, 0); __builtin_amdgcn_s_setprio(0); } while (0)
#define PG8_WAIT_V(n) asm volatile("s_waitcnt vmcnt(" #n ")" ::: "memory")
#define PG8_WAIT_L(n) asm volatile("s_waitcnt lgkmcnt(" #n ")" ::: "memory")
#define PG8_BAR __builtin_amdgcn_s_barrier()
#define PG8_SCHED __builtin_amdgcn_sched_barrier(0)
  Unit cur, nxt; int ui = 0;
  if (!S.next(0, cur)) return;
  f32x4 acc[2][2][4][2];
#pragma unroll
  for (int a = 0; a < 2; ++a)
#pragma unroll
    for (int b = 0; b < 2; ++b)
#pragma unroll
      for (int m = 0; m < 4; ++m)
#pragma unroll
        for (int n = 0; n < 2; ++n) acc[a][b][m][n] = (f32x4){0.f, 0.f, 0.f, 0.f};
  bf16x8 At[4][2], B0[2][2], B1[2][2];
  const char* cA = (const char*)g.A + (size_t)cur.pm * tstep; const char* cB = (const char*)g.Bt + (size_t)cur.pn * tstep;
  S.a_ready(cur);
  if constexpr (SP2) {
    PG8_STAGE(PG8_SB(0, 0), cB, voffB); PG8_STAGE(PG8_SB(0, 1), cB + hstep, voffB); PG8_STAGE(PG8_SA(0, 0), cA, voffA); PG8_STAGE(PG8_SA(0, 1), cA + hstep, voffA);
    if (wr == 1) PG8_BAR;
    PG8_WAIT_V(2); PG8_BAR;
    PG8_STAGE(PG8_SB(1, 0), cB + kstep, voffB); PG8_STAGE(PG8_SA(1, 0), cA + kstep, voffA); PG8_STAGE(PG8_SB(1, 1), cB + hstep + kstep, voffB);
    PG8_WAIT_V(6); PG8_BAR;
  } else {
    PG8_STAGE(PG8_SB(0, 0), cB, voffB); PG8_STAGE(PG8_SA(0, 0), cA, voffA); PG8_STAGE(PG8_SB(0, 1), cB + hstep, voffB); PG8_STAGE(PG8_SA(0, 1), cA + hstep, voffA);
    if (wr == 1) PG8_BAR;
    PG8_WAIT_V(4); PG8_BAR;
    PG8_STAGE(PG8_SB(1, 0), cB + kstep, voffB); PG8_STAGE(PG8_SA(1, 0), cA + kstep, voffA); PG8_STAGE(PG8_SB(1, 1), cB + hstep + kstep, voffB);
    PG8_WAIT_V(6); PG8_BAR;
  }
  for (;;) {
    const bool has_next = S.next(ui + 1, nxt);
    const char* nA = has_next ? (const char*)g.A + (size_t)nxt.pm * tstep : cA; const char* nB = has_next ? (const char*)g.Bt + (size_t)nxt.pn * tstep : cB;
#pragma unroll 1
    for (int t = 0; t < nt; t += 2) {
      const bool last = (t == nt - 2);
      const char* a1 = cA + (size_t)(t + 1) * kstep;
      const char* a2 = last ? nA : cA + (size_t)(t + 2) * kstep; const char* b2 = last ? nB : cB + (size_t)(t + 2) * kstep;
      const char* a3 = a2 + kstep; const char* b3 = b2 + kstep;
      if (last && has_next) S.a_ready(nxt);
      if constexpr (SP2) {
        PG8_LDB(B0, 0, 0); PG8_LDB(B1, 0, 1); PG8_SCHED; PG8_LDA(At, 0, 0); PG8_STAGE(PG8_SA(1, 1), a1 + hstep, voffA);
        PG8_WAIT_V(8); PG8_WAIT_L(0); PG8_BAR; PG8_MMA(0, 0, At, B0); PG8_MMA(0, 1, At, B1); PG8_BAR; PG8_SCHED;
        PG8_LDA(At, 0, 1); PG8_STAGE(PG8_SB(0, 0), b2, voffB); PG8_STAGE(PG8_SB(0, 1), b2 + hstep, voffB); PG8_STAGE(PG8_SA(0, 0), a2, voffA);
        PG8_WAIT_V(8); PG8_WAIT_L(0); PG8_BAR; PG8_MMA(1, 0, At, B0); PG8_MMA(1, 1, At, B1); PG8_BAR; PG8_SCHED;
        PG8_LDB(B0, 1, 0); PG8_LDB(B1, 1, 1); PG8_SCHED; PG8_LDA(At, 1, 0); PG8_STAGE(PG8_SA(0, 1), a2 + hstep, voffA);
        PG8_WAIT_V(8); PG8_WAIT_L(0); PG8_BAR; PG8_MMA(0, 0, At, B0); PG8_MMA(0, 1, At, B1); PG8_BAR; PG8_SCHED;
        PG8_LDA(At, 1, 1); PG8_STAGE(PG8_SB(1, 0), b3, voffB); PG8_STAGE(PG8_SB(1, 1), b3 + hstep, voffB); PG8_STAGE(PG8_SA(1, 0), a3, voffA);
        PG8_WAIT_V(8); PG8_WAIT_L(0); PG8_BAR; PG8_MMA(1, 0, At, B0); PG8_MMA(1, 1, At, B1); PG8_BAR; PG8_SCHED;
      } else {
        PG8_LDB(B0, 0, 0); PG8_SCHED; PG8_LDA(At, 0, 0); PG8_STAGE(PG8_SA(1, 1), a1 + hstep, voffA);
        PG8_WAIT_L(8); PG8_BAR; PG8_WAIT_L(0); PG8_MMA(0, 0, At, B0); PG8_BAR; PG8_SCHED;
        PG8_LDB(B1, 0, 1); PG8_STAGE(PG8_SB(0, 0), b2, voffB);
        PG8_BAR; PG8_WAIT_L(0); PG8_MMA(0, 1, At, B1); PG8_BAR;
        PG8_LDA(At, 0, 1); PG8_STAGE(PG8_SA(0, 0), a2, voffA);
        PG8_BAR; PG8_WAIT_L(0); PG8_MMA(1, 0, At, B0); PG8_BAR; PG8_SCHED;
        PG8_STAGE(PG8_SB(0, 1), b2 + hstep, voffB);
        PG8_WAIT_V(6); PG8_BAR; PG8_MMA(1, 1, At, B1); PG8_BAR;
        PG8_LDB(B0, 1, 0); PG8_SCHED; PG8_LDA(At, 1, 0); PG8_STAGE(PG8_SA(0, 1), a2 + hstep, voffA);
        PG8_WAIT_L(8); PG8_BAR; PG8_WAIT_L(0); PG8_MMA(0, 0, At, B0); PG8_BAR; PG8_SCHED;
        PG8_LDB(B1, 1, 1); PG8_STAGE(PG8_SB(1, 0), b3, voffB);
        PG8_BAR; PG8_WAIT_L(0); PG8_MMA(0, 1, At, B1); PG8_BAR;
        PG8_LDA(At, 1, 1); PG8_STAGE(PG8_SA(1, 0), a3, voffA);
        PG8_BAR; PG8_WAIT_L(0); PG8_MMA(1, 0, At, B0); PG8_BAR; PG8_SCHED;
        PG8_STAGE(PG8_SB(1, 1), b3 + hstep, voffB);
        PG8_WAIT_V(6); PG8_BAR; PG8_MMA(1, 1, At, B1); PG8_BAR;
      }
    }
    if constexpr (ALIGN_EPI) { if (wr == 0) PG8_BAR; }
    if constexpr (!Epi::AFTER_DRAIN) { E(acc, cur, wr, wc, fr, fq); S.done(cur); }
    if (!has_next) break;
#pragma unroll
    for (int a = 0; a < 2; ++a)
#pragma unroll
      for (int b = 0; b < 2; ++b)
#pragma unroll
        for (int m = 0; m < 4; ++m)
#pragma unroll
          for (int n = 0; n < 2; ++n) acc[a][b][m][n] = (f32x4){0.f, 0.f, 0.f, 0.f};
    cur = nxt; cA = nA; cB = nB; ++ui;
    if constexpr (ALIGN_EPI) { if (wr == 1) PG8_BAR; }
  }
  PG8_WAIT_V(0);
  if constexpr (!ALIGN_EPI) { if (wr == 0) PG8_BAR; }
  PG8_BAR;
#undef PG8_SA
#undef PG8_SB
#undef PG8_STAGE
#undef PG8_LDA
#undef PG8_LDB
#undef PG8_MMA
#undef PG8_WAIT_V
#undef PG8_WAIT_L
#undef PG8_BAR
#undef PG8_SCHED
}
}

template <class Epi>
__device__ __forceinline__ void run_gemm(unsigned char* lds, const bf16_t* A, const bf16_t* Bt, int N, int K, const Epi E) {
  pg8::Gemm g{A, Bt, MTOK, N, K}; pg8::StaticOrder S; S.init(MTOK, N, (int)gridDim.x, (int)blockIdx.x);
  pg8::gemm_phase<Epi, pg8::StaticOrder, true, true>((LAS unsigned char*)lds, g, S, E);
  __syncthreads();
}

template <class F>
__device__ __forceinline__ void cvt_tile(F src, bf16_t* dst, int ldd, int n0, int k0, float* tile) {
  const int tid = otid();
  float v[8];
#pragma unroll
  for (int i = 0; i < 8; ++i) { const int k = i * 8 + (tid >> 6), n = tid & 63; v[i] = src(k0 + k, n0 + n); }
#pragma unroll
  for (int i = 0; i < 8; ++i) { const int k = i * 8 + (tid >> 6), n = tid & 63; tile[k * 65 + n] = v[i]; }
  __syncthreads();
  { const int n = tid >> 3, kc = (tid & 7) * 8; const float* s = tile + kc * 65 + n;
    u32x4 o; o.x = cvt_pk_bf16(s[0], s[65]); o.y = cvt_pk_bf16(s[2 * 65], s[3 * 65]); o.z = cvt_pk_bf16(s[4 * 65], s[5 * 65]); o.w = cvt_pk_bf16(s[6 * 65], s[7 * 65]);
    *(u32x4*)(dst + (size_t)(n0 + n) * ldd + k0 + kc) = o; }
  __syncthreads();
}

__device__ __forceinline__ void phase0(const Params& p, unsigned char* lds) {
  float* tile = (float*)lds;
  const int tid = otid();
  constexpr int N_ADA = DEPTH * 18 * 8;
  constexpr int T_GU = 88 * 16, T_D = 16 * 44, T_IN = 52 * 16, T_MLA = 20 * 6, T_OUT = 16 * 16;
  constexpr int T_LAYER = 2 * T_GU + 2 * T_D + T_IN + T_MLA + T_OUT;
  constexpr int NITEMS = N_ADA + DEPTH * T_LAYER;
  for (int it = blockIdx.x; it < NITEMS; it += gridDim.x) {
    if (it < N_ADA) {
      const int l = it / 144, r = it % 144, cb = r / 8, ks = r % 8;
      __syncthreads();
      for (int e = tid; e < 16 * 128; e += 512) { const int b = e >> 7, k = e & 127; const float v = p.c[b * DM + ks * 128 + k]; tile[e] = v / (1.f + __expf(-v)); }
      __syncthreads();
      const int j = cb * 512 + tid;
      const float* w = p.ada_w + (size_t)l * DM * MODW + (size_t)(ks * 128) * MODW + j;
      float acc[16];
#pragma unroll
      for (int b = 0; b < 16; ++b) acc[b] = 0.f;
#pragma unroll 1
      for (int k0 = 0; k0 < 128; k0 += 16) { float wv[16];
#pragma unroll
        for (int kk = 0; kk < 16; ++kk) wv[kk] = w[(size_t)(k0 + kk) * MODW];
#pragma unroll
        for (int kk = 0; kk < 16; ++kk)
#pragma unroll
          for (int b = 0; b < 16; ++b) acc[b] += tile[b * 128 + k0 + kk] * wv[kk]; }
      float* dstp = (float*)(p.ws + WS_ADAP) + ((size_t)(ks * DEPTH + l) * 16) * MODW + j;
#pragma unroll
      for (int b = 0; b < 16; ++b) dstp[(size_t)b * MODW] = acc[b];
      __syncthreads();
      continue;
    }
    int r = it - N_ADA; const int l = r / T_LAYER; r -= l * T_LAYER;
    unsigned char* wl = p.ws + WS_W + (size_t)l * WL_STRIDE;
    if (r < 2 * T_GU) {
      const int f = r / T_GU; r -= f * T_GU; const int nt = r / 16, kt = r % 16, n0 = nt * 64;
      const int pn = n0 >> 8, bj = (n0 >> 7) & 1, i0 = n0 & 127, scol0 = bj * DFF + pn * 128 + i0 - n0;
      const float* W = (f ? p.ffn2_gu : p.ffn1_gu) + (size_t)l * DM * NGU;
      cvt_tile([=](int k, int n) { return W[(size_t)k * NGU + n + scol0]; }, (bf16_t*)(wl + (f ? WO_GU2 : WO_GU1)), DM, n0, kt * 64, tile);
      continue;
    }
    r -= 2 * T_GU;
    if (r < 2 * T_D) {
      const int f = r / T_D; r -= f * T_D; const int nt = r / 44, kt = r % 44;
      const float* W = (f ? p.ffn2_down : p.ffn1_down) + (size_t)l * DFF * DM;
      cvt_tile([=](int k, int n) { return W[(size_t)k * DM + n]; }, (bf16_t*)(wl + (f ? WO_D2 : WO_D1)), DFF, nt * 64, kt * 64, tile);
      continue;
    }
    r -= 2 * T_D;
    if (r < T_IN) {
      const int nt = r / 16, kt = r % 16;
      const float* W = p.w_in + (size_t)l * DM * INW;
      cvt_tile([=](int k, int n) { return n < INW ? W[(size_t)k * INW + n] : 0.f; }, (bf16_t*)(wl + WO_IN), DM, nt * 64, kt * 64, tile);
      continue;
    }
    r -= T_IN;
    if (r < T_MLA) {
      const int nt = r / 6, kt = r % 6;
      const float* Wq = p.w_uq + (size_t)l * 256 * 480; const float* Wkv = p.w_ukv + (size_t)l * 128 * 640;
      cvt_tile([=](int k, int n) { float v = 0.f; if (n < 480) { if (k < 256) v = Wq[(size_t)k * 480 + n]; } else if (n < 1120) { if (k >= 256) v = Wkv[(size_t)(k - 256) * 640 + (n - 480)]; } return v; },
               (bf16_t*)(wl + WO_MLA), MLA_K, nt * 64, kt * 64, tile);
      continue;
    }
    r -= T_MLA;
    { const int nt = r / 16, kt = r % 16;
      const float* W = p.w_out + (size_t)l * DM * DM;
      cvt_tile([=](int k, int n) { return W[(size_t)k * DM + n]; }, (bf16_t*)(wl + WO_OUT), DM, nt * 64, kt * 64, tile); }
  }
}
__device__ __forceinline__ void phase_mod_reduce(const Params& p) {
  float* mod = (float*)(p.ws + WS_MOD); const float* part = (const float*)(p.ws + WS_ADAP);
  constexpr int TOT = DEPTH * 16 * MODW;
  for (int e = blockIdx.x * 512 + otid(); e < TOT; e += gridDim.x * 512) {
    const int l = e / (16 * MODW), j = e % MODW;
    float s = p.ada_b[l * MODW + j];
#pragma unroll
    for (int ks = 0; ks < 8; ++ks) s += part[(size_t)ks * TOT + e];
    mod[e] = s;
  }
}

__device__ __forceinline__ void phase_norm(const float* src, const float* gain, const float* shift, const float* scale, bf16_t* dst) {
  const int tid_ = otid(), lane = tid_ & 63, gw = blockIdx.x * 8 + (tid_ >> 6), NGW = gridDim.x * 8;
  for (int m = gw; m < MTOK; m += NGW) {
    const f32x4* xr = (const f32x4*)(src + (size_t)m * DM) + lane;
    f32x4 v[4]; float s = 0.f;
#pragma unroll
    for (int j = 0; j < 4; ++j) { v[j] = xr[64 * j]; s += (v[j].x * v[j].x + v[j].y * v[j].y) + (v[j].z * v[j].z + v[j].w * v[j].w); }
    const float rs = 1.f / sqrtf(wave_sum(s) * (1.f / DM) + RMS_EPS);
    const int b = m / SEQ;
    const f32x4* gp = (const f32x4*)gain + lane; const f32x4* shp = (const f32x4*)(shift + (size_t)b * MODW) + lane; const f32x4* scp = (const f32x4*)(scale + (size_t)b * MODW) + lane;
    u64* o8 = (u64*)(dst + (size_t)m * DM) + lane;
#pragma unroll
    for (int j = 0; j < 4; ++j) { const f32x4 g = gp[64 * j], sh = shp[64 * j], sc = scp[64 * j];
      const f32x4 y = (v[j] * rs) * g * (sc + 1.f) + sh;
      o8[64 * j] = (u64)cvt_pk_bf16(y.x, y.y) | ((u64)cvt_pk_bf16(y.z, y.w) << 32); }
  }
}
__device__ __forceinline__ void phase_final_norm(float* h, const float* gain) {
  const int tid_ = otid(), lane = tid_ & 63, gw = blockIdx.x * 8 + (tid_ >> 6), NGW = gridDim.x * 8;
  f32x4 g[4];
#pragma unroll
  for (int j = 0; j < 4; ++j) g[j] = ((const f32x4*)gain)[lane + 64 * j];
  constexpr int RB = 4;
  for (int m0 = gw * RB; m0 < MTOK; m0 += NGW * RB) {
    f32x4 v[RB][4]; float s[RB];
#pragma unroll
    for (int r = 0; r < RB; ++r) { const f32x4* xr = (const f32x4*)(h + (size_t)(m0 + r) * DM) + lane;
#pragma unroll
      for (int j = 0; j < 4; ++j) v[r][j] = xr[64 * j]; }
#pragma unroll
    for (int r = 0; r < RB; ++r) { float a = 0.f;
#pragma unroll
      for (int j = 0; j < 4; ++j) a += (v[r][j].x * v[r][j].x + v[r][j].y * v[r][j].y) + (v[r][j].z * v[r][j].z + v[r][j].w * v[r][j].w);
      s[r] = a; }
#pragma unroll
    for (int r = 0; r < RB; ++r) s[r] = __builtin_amdgcn_rsqf(wave_sum(s[r]) * (1.f / DM) + RMS_EPS);
#pragma unroll
    for (int r = 0; r < RB; ++r) { f32x4* xr = (f32x4*)(h + (size_t)(m0 + r) * DM) + lane;
#pragma unroll
      for (int j = 0; j < 4; ++j) xr[64 * j] = (v[r][j] * s[r]) * g[j]; }
  }
}

__device__ __forceinline__ void phase_cvec(const Params& p) {
  const int tid_ = otid(), lane = tid_ & 63, fr = lane & 15, fq = lane >> 4, gw = blockIdx.x * 8 + (tid_ >> 6), NGW = gridDim.x * 8;
  constexpr int G_GU = NGU / 16, G_IN = INWP / 16, G_L = 2 * G_GU + G_IN;
  for (int it = gw; it < DEPTH * G_L; it += NGW) {
    const int l = it / G_L; int r = it % G_L; int g, ncols; size_t wo;
    if (r < G_GU) { g = 0; wo = WO_GU1; ncols = NGU; } else if (r < G_GU + G_IN) { r -= G_GU; g = 1; wo = WO_IN; ncols = INWP; } else { r -= G_GU + G_IN; g = 2; wo = WO_GU2; ncols = NGU; }
    const bf16_t* wt = (const bf16_t*)(p.ws + WS_W + (size_t)l * WL_STRIDE + wo) + (size_t)(r * 16 + fr) * DM + fq * 8;
    const float* sh = (const float*)(p.ws + WS_MOD) + ((size_t)l * 16 + fr) * MODW + (g * 3) * DM + fq * 8;
    f32x4 acc = (f32x4){0.f, 0.f, 0.f, 0.f};
#pragma unroll 4
    for (int s = 0; s < 32; ++s) {
      const bf16x8 wf = *(const bf16x8*)(wt + s * 32);
      const f32x4 a0 = *(const f32x4*)(sh + s * 32), a1 = *(const f32x4*)(sh + s * 32 + 4);
      u32x4 w; w.x = cvt_pk_bf16(a0[0], a0[1]); w.y = cvt_pk_bf16(a0[2], a0[3]); w.z = cvt_pk_bf16(a1[0], a1[1]); w.w = cvt_pk_bf16(a1[2], a1[3]);
      acc = __builtin_amdgcn_mfma_f32_16x16x32_bf16(wf, __builtin_bit_cast(bf16x8, w), acc, 0, 0, 0);
    }
    float* cvp = (float*)(p.ws + WS_CV) + ((size_t)(l * 3 + g) * 16 + fr) * 5632 + r * 16 + fq * 4;
    *(f32x4*)cvp = acc;
  }
}
__device__ __forceinline__ void phase_norm0(const float* src, const float* gain, const float* scale, bf16_t* dst, float* ssq) {
  const int tid_ = otid(), lane = tid_ & 63, gw = blockIdx.x * 8 + (tid_ >> 6), NGW = gridDim.x * 8;
  for (int m = gw; m < MTOK; m += NGW) {
    const f32x4* xr = (const f32x4*)(src + (size_t)m * DM) + lane;
    f32x4 v[4]; float s = 0.f;
#pragma unroll
    for (int j = 0; j < 4; ++j) { v[j] = xr[64 * j]; s += (v[j].x * v[j].x + v[j].y * v[j].y) + (v[j].z * v[j].z + v[j].w * v[j].w); }
    s = wave_sum(s);
    const int b = m / SEQ;
    const f32x4* gp = (const f32x4*)gain + lane; const f32x4* scp = (const f32x4*)(scale + (size_t)b * MODW) + lane;
    u64* o8 = (u64*)(dst + (size_t)m * DM) + lane;
#pragma unroll
    for (int j = 0; j < 4; ++j) { const f32x4 y = v[j] * gp[64 * j] * (scp[64 * j] + 1.f);
      o8[64 * j] = (u64)cvt_pk_bf16(y.x, y.y) | ((u64)cvt_pk_bf16(y.z, y.w) << 32); }
    if (lane == 0) *(f32x4*)(ssq + (size_t)m * 4) = (f32x4){s, 0.f, 0.f, 0.f};
  }
}

__device__ __forceinline__ float sumsq8(u32x4 w) { float a = 0.f;
  a += bflo(w.x) * bflo(w.x); a += bfhi(w.x) * bfhi(w.x); a += bflo(w.y) * bflo(w.y); a += bfhi(w.y) * bfhi(w.y);
  a += bflo(w.z) * bflo(w.z); a += bfhi(w.z) * bfhi(w.z); a += bflo(w.w) * bflo(w.w); a += bfhi(w.w) * bfhi(w.w); return a; }
__device__ __forceinline__ float group8_sum(float v) { v += __shfl_xor(v, 1); v += __shfl_xor(v, 2); v += __shfl_xor(v, 4); return v; }
constexpr size_t WS_KMAX = WS_BAR + 14336;
__device__ __forceinline__ void phase_prep(const Params& p, int l) {
  const int tid_ = otid(), lane = tid_ & 63, gw = blockIdx.x * 8 + (tid_ >> 6), NGW = gridDim.x * 8;
  bf16_t* proj = (bf16_t*)(p.ws + WS_BIG); bf16_t* mlaa = (bf16_t*)(p.ws + WS_MLAA); bf16_t* krope = (bf16_t*)(p.ws + WS_KROPE); bf16_t* ikn = (bf16_t*)(p.ws + WS_IKN);
  const float* qn = p.q_norm + l * 256; const float* kvn = p.kv_norm + l * 128;
  const float inv = rope_inv(lane & 15);
  const f32x4 gq = *(const f32x4*)(qn + 4 * lane); const f32x2 gkv = *(const f32x2*)(kvn + 2 * lane); const float gik = p.ik_norm[l * 64 + lane];
  unsigned* kmaxp = (unsigned*)(p.ws + WS_KMAX) + l * 256;
  constexpr int TB = 4;
  for (int base = gw * 16; base < MTOK; base += NGW * 16) {
   float kA = 0.f, kC = 0.f;
   for (int tg = 0; tg < 16; tg += TB) {
    u32x2 cqw[TB]; unsigned ckvw[TB]; float kr1[TB], kr2[TB], q1[TB][2], q2[TB][2], ikv[TB], ang[TB]; u32x4 wa[TB], wc[TB];
#pragma unroll
    for (int t = 0; t < TB; ++t) { const int m = base + tg + t; const bf16_t* pr = proj + (size_t)m * INWP;
      cqw[t] = *(const u32x2*)(pr + OFF_CQ + 4 * lane); ckvw[t] = *(const unsigned*)(pr + OFF_CKV + 2 * lane);
      kr1[t] = bf2f(pr[OFF_KR + (lane & 15)]); kr2[t] = bf2f(pr[OFF_KR + 16 + (lane & 15)]);
#pragma unroll
      for (int j = 0; j < 2; ++j) { const int pp = lane + 64 * j; const bf16_t* q = pr + OFF_IQ + (pp >> 4) * 64 + (pp & 15); q1[t][j] = bf2f(q[0]); q2[t][j] = bf2f(q[16]); }
      ikv[t] = bf2f(pr[OFF_IK + lane]);
      wa[t] = *(const u32x4*)(pr + OFF_KA + (lane < 48 ? lane : 0) * 8); wc[t] = *(const u32x4*)(pr + OFF_KC + (lane < 40 ? lane : 0) * 8);
      ang[t] = (float)p.pos[m] * inv; }
    u32x2 cqo[TB]; unsigned ckvo[TB]; unsigned short kro1[TB], kro2[TB], qo1[TB][2], qo2[TB][2], iko[TB];
#pragma unroll
    for (int t = 0; t < TB; ++t) {
      float sn, cs; sincos_big(ang[t], sn, cs);
      kA = fmaxf(kA, group8_sum(sumsq8(wa[t]))); kC = fmaxf(kC, group8_sum(sumsq8(wc[t])));
      { const float a0 = bflo(cqw[t].x), a1 = bfhi(cqw[t].x), a2 = bflo(cqw[t].y), a3 = bfhi(cqw[t].y);
        const float rs = __builtin_amdgcn_rsqf(wave_sum(a0 * a0 + a1 * a1 + a2 * a2 + a3 * a3) * (1.f / 256) + RMS_EPS);
        cqo[t].x = cvt_pk_bf16(a0 * rs * gq.x, a1 * rs * gq.y); cqo[t].y = cvt_pk_bf16(a2 * rs * gq.z, a3 * rs * gq.w); }
      { const float a0 = bflo(ckvw[t]), a1 = bfhi(ckvw[t]);
        const float rs = __builtin_amdgcn_rsqf(wave_sum(a0 * a0 + a1 * a1) * (1.f / 128) + RMS_EPS);
        ckvo[t] = cvt_pk_bf16(a0 * rs * gkv.x, a1 * rs * gkv.y); }
      kro1[t] = f2bf(kr1[t] * cs - kr2[t] * sn); kro2[t] = f2bf(kr2[t] * cs + kr1[t] * sn);
#pragma unroll
      for (int j = 0; j < 2; ++j) { qo1[t][j] = f2bf(q1[t][j] * cs - q2[t][j] * sn); qo2[t][j] = f2bf(q2[t][j] * cs + q1[t][j] * sn); }
      { const float a = ikv[t];
        const float rs = __builtin_amdgcn_rsqf(wave_sum(a * a) * (1.f / 64) + RMS_EPS);
        const float y = a * rs * gik, pa = __shfl_xor(y, 16);
        float o = y;
        if (lane < 16) o = y * cs - pa * sn; else if (lane < 32) o = y * cs + pa * sn;
        iko[t] = f2bf(o); }
    }
#pragma unroll
    for (int t = 0; t < TB; ++t) { const int m = base + tg + t; bf16_t* pr = proj + (size_t)m * INWP;
      *(u32x2*)(mlaa + (size_t)m * MLA_K + 4 * lane) = cqo[t];
      *(unsigned*)(mlaa + (size_t)m * MLA_K + 256 + 2 * lane) = ckvo[t];
      if (lane < 16) { krope[(size_t)m * 32 + lane] = kro1[t]; krope[(size_t)m * 32 + 16 + lane] = kro2[t]; }
#pragma unroll
      for (int j = 0; j < 2; ++j) { const int pp = lane + 64 * j; bf16_t* q = pr + OFF_IQ + (pp >> 4) * 64 + (pp & 15); q[0] = qo1[t][j]; q[16] = qo2[t][j]; }
      ikn[(size_t)m * 64 + lane] = iko[t]; }
   }
   const int bb = base / SEQ;
   if ((lane & 7) == 0) {
     if (lane < 48) __hip_atomic_fetch_max(kmaxp + bb * 16 + (lane >> 3), __builtin_bit_cast(unsigned, kA), __ATOMIC_RELAXED, __HIP_MEMORY_SCOPE_AGENT);
     if (lane < 40) __hip_atomic_fetch_max(kmaxp + bb * 16 + 11 + (lane >> 3), __builtin_bit_cast(unsigned, kC), __ATOMIC_RELAXED, __HIP_MEMORY_SCOPE_AGENT);
   }
  }
}
__device__ __forceinline__ void phase_qrope(const Params& p, int l) {
  const int tid_ = otid(), lane = tid_ & 63, gw = blockIdx.x * 8 + (tid_ >> 6), NGW = gridDim.x * 8;
  bf16_t* mlao = (bf16_t*)(p.ws + WS_MLAO); const bf16_t* krope = (const bf16_t*)(p.ws + WS_KROPE);
  unsigned* kmaxp = (unsigned*)(p.ws + WS_KMAX) + l * 256;
  const float inv = rope_inv(lane & 15);
  constexpr int TB = 4;
  for (int base = gw * 16; base < MTOK; base += NGW * 16) {
   float kM = 0.f;
   for (int tg = 0; tg < 16; tg += TB) {
    u32x4 wn[TB], wr[TB]; float q1[TB][2], q2[TB][2], ang[TB];
#pragma unroll
    for (int t = 0; t < TB; ++t) { const int m = base + tg + t; const int ll = lane < 40 ? lane : 0;
      wn[t] = *(const u32x4*)(mlao + (size_t)m * MLA_N + 480 + (ll >> 3) * 128 + (ll & 7) * 8); wr[t] = *(const u32x4*)(krope + (size_t)m * 32 + (lane & 3) * 8);
#pragma unroll
      for (int j = 0; j < 2; ++j) { const int pp = (lane + 64 * j < 80) ? lane + 64 * j : 0; const bf16_t* q = mlao + (size_t)m * MLA_N + (pp >> 4) * 96 + 64 + (pp & 15); q1[t][j] = bf2f(q[0]); q2[t][j] = bf2f(q[16]); }
      ang[t] = (float)p.pos[m] * inv; }
    unsigned short qo1[TB][2], qo2[TB][2];
#pragma unroll
    for (int t = 0; t < TB; ++t) {
      float sn, cs; sincos_big(ang[t], sn, cs);
      float r2 = sumsq8(wr[t]); r2 += __shfl_xor(r2, 1); r2 += __shfl_xor(r2, 2);
      kM = fmaxf(kM, group8_sum(sumsq8(wn[t])) + r2);
#pragma unroll
      for (int j = 0; j < 2; ++j) { qo1[t][j] = f2bf(q1[t][j] * cs - q2[t][j] * sn); qo2[t][j] = f2bf(q2[t][j] * cs + q1[t][j] * sn); }
    }
#pragma unroll
    for (int t = 0; t < TB; ++t) { const int m = base + tg + t;
#pragma unroll
      for (int j = 0; j < 2; ++j) { const int pp = lane + 64 * j;
        if (pp < 80) { bf16_t* q = mlao + (size_t)m * MLA_N + (pp >> 4) * 96 + 64 + (pp & 15); q[0] = qo1[t][j]; q[16] = qo2[t][j]; } } }
   }
   const int bb = base / SEQ;
   if ((lane & 7) == 0 && lane < 40) __hip_atomic_fetch_max(kmaxp + bb * 16 + 6 + (lane >> 3), __builtin_bit_cast(unsigned, kM), __ATOMIC_RELAXED, __HIP_MEMORY_SCOPE_AGENT);
  }
}

constexpr int SC_STRIDE = 2117;
__device__ __forceinline__ int wave_count(int c) { int t = 0;
#pragma unroll
  for (int b = 0; b < 6; ++b) t += (int)__popcll(__ballot((c >> b) & 1)) << b;
  return t; }
__device__ __forceinline__ unsigned fkey(float v) { const unsigned u = __builtin_bit_cast(unsigned, v + 0.0f); return (u & 0x80000000u) ? ~u : (u | 0x80000000u); }
#define DEF_WCOUNT(NAME, OP) \
__device__ __forceinline__ int NAME(const unsigned (&key)[32], unsigned thr) { \
  int cnt = 0; const unsigned m = __builtin_amdgcn_readfirstlane(thr); \
  _Pragma("unroll") for (int j = 0; j < 32; j += 4) { u64 a, b, c, d; int ta, tb, tc, td; \
    asm volatile("v_cmp_" OP "_u32 %[a], %[k0], %[m]\n\tv_cmp_" OP "_u32 %[b], %[k1], %[m]\n\tv_cmp_" OP "_u32 %[c], %[k2], %[m]\n\tv_cmp_" OP "_u32 %[d], %[k3], %[m]\n\t" \
                 "s_bcnt1_i32_b64 %[ta], %[a]\n\ts_bcnt1_i32_b64 %[tb], %[b]\n\ts_bcnt1_i32_b64 %[tc], %[c]\n\ts_bcnt1_i32_b64 %[td], %[d]\n\t" \
                 "s_add_i32 %[ta], %[ta], %[tb]\n\ts_add_i32 %[tc], %[tc], %[td]\n\ts_add_i32 %[cnt], %[cnt], %[ta]\n\ts_add_i32 %[cnt], %[cnt], %[tc]" \
      : [cnt] "+s"(cnt), [a] "=&s"(a), [b] "=&s"(b), [c] "=&s"(c), [d] "=&s"(d), [ta] "=&s"(ta), [tb] "=&s"(tb), [tc] "=&s"(tc), [td] "=&s"(td) \
      : [k0] "v"(key[j]), [k1] "v"(key[j + 1]), [k2] "v"(key[j + 2]), [k3] "v"(key[j + 3]), [m] "s"(m) : "scc"); } \
  return cnt; }
DEF_WCOUNT(wcount_ge, "ge")
DEF_WCOUNT(wcount_gt, "gt")
DEF_WCOUNT(wcount_eq, "eq")
__device__ __forceinline__ float unfkey(unsigned k) { const unsigned u = (k & 0x80000000u) ? (k & 0x7fffffffu) : ~k; return __builtin_bit_cast(float, u); }
__device__ __forceinline__ void phase_indexer(const Params& p, unsigned char* lds) {
  float* sc = (float*)lds;
  const int tid = otid(), lane = tid & 63, wave = __builtin_amdgcn_readfirstlane(tid >> 6), fr = lane & 15, fq = lane >> 4;
  const bf16_t* proj = (const bf16_t*)(p.ws + WS_BIG); const bf16_t* ikn = (const bf16_t*)(p.ws + WS_IKN); u64* mask = (u64*)(p.ws + WS_MASK);
  constexpr int NITEMS = BATCH * (SEQ / 16);
  for (int it = blockIdx.x; it < NITEMS; it += gridDim.x) {
    const int b = it % BATCH, qg = (SEQ / 16 - 1) - it / BATCH, t0 = qg * 16;
    const size_t rowb = (size_t)b * SEQ;
    if (t0 + 16 <= 256) {
      if (lane < 32) { mask[(rowb + t0 + 2 * wave) * 32 + lane] = ~0ull; mask[(rowb + t0 + 2 * wave + 1) * 32 + lane] = ~0ull; }
      continue;
    }
    __syncthreads();
    {
      const bf16_t* qrow = proj + (rowb + t0 + fr) * INWP;
      bf16x8 qf[8][2];
#pragma unroll
      for (int h = 0; h < 8; ++h)
#pragma unroll
        for (int s = 0; s < 2; ++s) qf[h][s] = *(const bf16x8*)(qrow + OFF_IQ + h * 64 + s * 32 + fq * 8);
      float wq[8];
      { const u32x4 w = *(const u32x4*)(qrow + OFF_IW); const float cw = 0.04419417382415922f;
        wq[0] = bflo(w.x) * cw; wq[1] = bfhi(w.x) * cw; wq[2] = bflo(w.y) * cw; wq[3] = bfhi(w.y) * cw; wq[4] = bflo(w.z) * cw; wq[5] = bfhi(w.z) * cw; wq[6] = bflo(w.w) * cw; wq[7] = bfhi(w.w) * cw; }
      const int nkt = qg + 1;
      bf16x8 ka[4][2], kb[4][2];
#define IDX_LOAD(X, base) do { _Pragma("unroll") for (int g = 0; g < 4; ++g) { int kk = (base) + 8 * g; kk = (kk < nkt) ? kk : 0; \
          const bf16_t* krow = ikn + (rowb + kk * 16 + fr) * 64 + fq * 8; X[g][0] = *(const bf16x8*)krow; X[g][1] = *(const bf16x8*)(krow + 32); } } while (0)
#define IDX_COMP(X, base) do { _Pragma("unroll") for (int g = 0; g < 4; ++g) { const int kk = (base) + 8 * g; if (kk < nkt) { \
          f32x4 a[8]; \
          _Pragma("unroll") for (int h = 0; h < 8; ++h) a[h] = __builtin_amdgcn_mfma_f32_16x16x32_bf16(X[g][0], qf[h][0], (f32x4){0.f, 0.f, 0.f, 0.f}, 0, 0, 0); \
          _Pragma("unroll") for (int h = 0; h < 8; ++h) a[h] = __builtin_amdgcn_mfma_f32_16x16x32_bf16(X[g][1], qf[h][1], a[h], 0, 0, 0); \
          f32x4 s4 = (f32x4){0.f, 0.f, 0.f, 0.f}; \
          _Pragma("unroll") for (int h = 0; h < 8; ++h) _Pragma("unroll") for (int jj = 0; jj < 4; ++jj) s4[jj] = __builtin_fmaf(wq[h], __builtin_amdgcn_fmed3f(a[h][jj], 0.f, __builtin_inff()), s4[jj]); \
          const int c0 = kk * 16 + fq * 4; float* dp = sc + fr * SC_STRIDE + c0 + (c0 >> 5); dp[0] = s4[0]; dp[1] = s4[1]; dp[2] = s4[2]; dp[3] = s4[3]; } } } while (0)
      int kt = wave;
      IDX_LOAD(ka, kt);
#pragma unroll 1
      while (kt < nkt) {
        IDX_LOAD(kb, kt + 32);
        IDX_COMP(ka, kt);
        kt += 32;
        if (kt >= nkt) break;
        IDX_LOAD(ka, kt + 32);
        IDX_COMP(kb, kt);
        kt += 32;
      }
#undef IDX_LOAD
#undef IDX_COMP
    }
    __syncthreads();
    for (int rr = 0; rr < 2; ++rr) {
      const int r = 2 * wave + rr, t = t0 + r;
      unsigned key[32];
      float kv[32];
#pragma unroll
      for (int j = 0; j < 32; ++j) kv[j] = sc[r * SC_STRIDE + lane * 33 + j];
#pragma unroll
      for (int j = 0; j < 32; ++j) asm volatile("" : "+v"(kv[j]));
#pragma unroll
      for (int j = 0; j < 32; ++j) { const int idx = lane * 32 + j; key[j] = (idx <= t) ? fkey(kv[j]) : 0u; }
      unsigned kmx = 0u, kmn = 0xffffffffu;
#pragma unroll
      for (int j = 0; j < 32; ++j) { kmx = max(kmx, key[j]); kmn = min(kmn, key[j] ? key[j] : 0xffffffffu); }
#pragma unroll
      for (int o = 1; o < 64; o <<= 1) { kmx = max(kmx, (unsigned)__shfl_xor((int)kmx, o)); kmn = min(kmn, (unsigned)__shfl_xor((int)kmn, o)); }
      unsigned lo = kmn, hi = kmx + 1u; int clo = t + 1, chi = 0;
#pragma unroll 1
      for (int itn = 0; itn < 128; ++itn) {
        if (clo == 256 || hi - lo <= 1u || clo - chi <= 64) break;
        unsigned mid;
        if (itn % 3 == 2) mid = lo + ((hi - lo) >> 1);
        else { const float flo = unfkey(lo), fhi = unfkey(hi - 1u); const int gap = clo - chi;
          const float off = (gap <= 8) ? 0.5f : fminf((float)gap * 0.125f, 16.f);
          const float tgt = 256.f + (((clo - 256) > (256 - chi)) ? off : -off);
          const float fm = flo + (fhi - flo) * (((float)clo - tgt) / (float)gap);
          mid = fkey(fm); }
        mid = max(lo + 1u, min(mid, hi - 1u));
        const int c = wcount_ge(key, mid);
        if (c >= 256) { lo = mid; clo = c; } else { hi = mid; chi = c; }
      }
      if (clo != 256 && hi - lo > 1u && clo - chi <= 64) {
        unsigned* cand = (unsigned*)(sc + r * SC_STRIDE);
        const unsigned range = hi - lo;
        int cl = 0;
#pragma unroll
        for (int j = 0; j < 32; ++j) cl += (key[j] - lo < range) ? 1 : 0;
        int incl = cl;
#pragma unroll
        for (int o = 1; o < 64; o <<= 1) { const int v = __shfl_up(incl, o); if (lane >= o) incl += v; }
        int pos = incl - cl;
        asm volatile("s_waitcnt lgkmcnt(0)" ::: "memory");
#pragma unroll
        for (int j = 0; j < 32; ++j) { if (key[j] - lo < range) { cand[pos] = key[j]; ++pos; } }
        asm volatile("s_waitcnt lgkmcnt(0)" ::: "memory");
        const int m = clo - chi;
        const unsigned x = (lane < m) ? cand[lane] : 0u;
        int g = 0, e = 0;
#pragma unroll 4
        for (int i = 0; i < m; ++i) { const unsigned y = (unsigned)__builtin_amdgcn_readlane((int)x, i); g += (y > x) ? 1 : 0; e += (y == x) ? 1 : 0; }
        const u64 bal = __ballot(lane < m && chi + g < 256 && chi + g + e >= 256);
        lo = (unsigned)__builtin_amdgcn_readlane((int)x, (int)__builtin_ctzll(bal | (1ull << 63)));
      }
      const unsigned T = lo;
      const int cgt = wcount_gt(key, T), ceq = wcount_eq(key, T);
      const int need = 256 - cgt;
      int cutoff = 4096;
      if (ceq > need) {
        int ceql = 0;
#pragma unroll
        for (int j = 0; j < 32; ++j) ceql += (key[j] == T) ? 1 : 0;
        int incl = ceql;
#pragma unroll
        for (int o = 1; o < 64; o <<= 1) { const int v = __shfl_up(incl, o); if (lane >= o) incl += v; }
        const int excl = incl - ceql;
        int mycut = 4096;
        if (excl < need && incl >= need) { int k = need - excl;
#pragma unroll
          for (int j = 0; j < 32; ++j) { if (key[j] == T) { --k; if (k == 0) mycut = lane * 32 + j; } } }
#pragma unroll
        for (int o = 1; o < 64; o <<= 1) mycut = min(mycut, __shfl_xor(mycut, o));
        cutoff = mycut;
      }
      unsigned W = 0u;
#pragma unroll
      for (int j = 0; j < 32; ++j) { const int idx = lane * 32 + j; W |= ((key[j] > T || (key[j] == T && idx <= cutoff)) ? 1u : 0u) << j; __builtin_amdgcn_sched_barrier(0); }
      ((unsigned*)mask)[(rowb + t) * 64 + lane] = W;
    }
  }
  __syncthreads();
}

constexpr int KROW = 208, VROW = 144;
constexpr int AT_BUF = 64 * KROW + 64 * VROW;
constexpr int AT_VOFF = 64 * KROW, AT_TAB = 2 * AT_BUF, TAB_PAD = 96, AT_END = AT_TAB + (2048 + TAB_PAD) * 4;
constexpr float LOG2E = 1.4426950408889634f;
__device__ __forceinline__ s16x4 vtr(const LAS unsigned char* ptr) { return __builtin_bit_cast(s16x4, __builtin_amdgcn_ds_read_tr16_b64_v4i16((LAS s16x4*)ptr)); }

template <int KS, int TYPE>
__device__ __forceinline__ void attn_item(const Params& p, unsigned char* lds, int b, int head, int qb, int l) {
  const int tid = otid(), lane = tid & 63, wave = __builtin_amdgcn_readfirstlane(tid >> 6), fr = lane & 15, fq = lane >> 4;
  const bf16_t* proj = (const bf16_t*)(p.ws + WS_BIG); const bf16_t* mlao = (const bf16_t*)(p.ws + WS_MLAO);
  const bf16_t* Qp; const bf16_t* Kp; const bf16_t* Vp; int qpitch, kpitch; float c2;
  const size_t rowb = (size_t)b * SEQ;
  if (TYPE == 0) { Qp = proj + OFF_QA + head * 64; Kp = proj + OFF_KA + head * 64; Vp = proj + OFF_VA + head * 64; qpitch = kpitch = INWP; c2 = 0.125f * LOG2E; }
  else if (TYPE == 1) { const int hb = head - 6; Qp = mlao + hb * 96; Kp = mlao + 480 + hb * 128; Vp = Kp + 64; qpitch = kpitch = MLA_N; c2 = 0.10206207261596575f * LOG2E; }
  else { const int hc = head - 11; Qp = proj + OFF_QC + hc * 64; Kp = proj + OFF_KC + hc * 64; Vp = proj + OFF_VC + hc * 64; qpitch = kpitch = INWP; c2 = 0.125f * LOG2E; }
  const bf16_t* K2p = (const bf16_t*)(p.ws + WS_KROPE);
  const u64* mask = (const u64*)(p.ws + WS_MASK);
  float* tab = (float*)(lds + AT_TAB);
  LAS unsigned char* l3 = (LAS unsigned char*)lds;

  __syncthreads();
  if (TYPE != 1) {
    const int col = (TYPE == 0) ? head : (head - 11 + 6);
    for (int e = tid; e < 2048 + TAB_PAD; e += 512) {
      const int d = e - TAB_PAD; float v = NEGV;
      if (d >= 0) { v = p.rel_bias[t5_bucket(d) * 11 + col];
        if (TYPE == 0) { const int mult = (d <= 128) + ((d & 3) == 0 && d <= 512) + ((d & 15) == 0);
          v = (mult == 0) ? NEGV : v + (mult == 1 ? 0.f : (mult == 2 ? 0.6931471805599453f : 1.0986122886681098f)); }
        v = (v <= -1e29f) ? NEGV : v * LOG2E; }
      tab[e] = v;
    }
  }
  const int q0 = qb * 256 + wave * 32;
  bf16x8 qf[2][KS];
#pragma unroll
  for (int u = 0; u < 2; ++u)
#pragma unroll
    for (int s = 0; s < KS; ++s) qf[u][s] = *(const bf16x8*)(Qp + (rowb + q0 + u * 16 + fr) * qpitch + s * 32 + fq * 8);
  float tabmax = 0.f;
  if (TYPE != 1) { const int col = (TYPE == 0) ? head : (head - 11 + 6);
    float tv = p.rel_bias[(lane & 31) * 11 + col];
#pragma unroll
    for (int o_ = 1; o_ < 32; o_ <<= 1) tv = fmaxf(tv, __shfl_xor(tv, o_));
    tabmax = tv * LOG2E + (TYPE == 0 ? 1.5849625007211563f : 0.f); }
  const float kmax = sqrtf(__builtin_bit_cast(float, ((const unsigned*)(p.ws + WS_KMAX))[l * 256 + b * 16 + head]));
  f32x4 o[4][2]; float sinit[2], lrow[2];
#pragma unroll
  for (int u = 0; u < 2; ++u) {
    float q2 = 0.f;
#pragma unroll
    for (int s_ = 0; s_ < KS; ++s_) q2 += sumsq8(__builtin_bit_cast(u32x4, qf[u][s_]));
    q2 += __shfl_xor(q2, 16); q2 += __shfl_xor(q2, 32);
    sinit[u] = -(sqrtf(q2) * kmax * 1.0001f + tabmax / c2 + 1e-3f);
    lrow[u] = 0.f;
#pragma unroll
    for (int dt = 0; dt < 4; ++dt) o[dt][u] = (f32x4){0.f, 0.f, 0.f, 0.f}; }

  const int nkt = (qb + 1) * 4;
  const int lkey = tid >> 3, lch = tid & 7;
  u32x4 kreg, vreg, k2reg; u64 mreg[2] = {0ull, 0ull};
#define AT_PREFETCH(kt_) do { const size_t r_ = rowb + (kt_) * 64 + lkey; \
    kreg = *(const u32x4*)(Kp + r_ * kpitch + lch * 8); vreg = *(const u32x4*)(Vp + r_ * kpitch + lch * 8); \
    if (KS == 3) { if (tid < 256) k2reg = *(const u32x4*)(K2p + (rowb + (kt_) * 64 + (tid >> 2)) * 32 + (tid & 3) * 8); } \
    if (TYPE == 2) { mreg[0] = mask[(rowb + q0 + fr) * 32 + (kt_)]; mreg[1] = mask[(rowb + q0 + 16 + fr) * 32 + (kt_)]; } } while (0)
#define AT_STORE(bufo_) do { *(u32x4*)(lds + (bufo_) + lkey * KROW + lch * 16) = kreg; *(u32x4*)(lds + (bufo_) + AT_VOFF + lkey * VROW + lch * 16) = vreg; \
    if (KS == 3) { if (tid < 256) *(u32x4*)(lds + (bufo_) + (tid >> 2) * KROW + 128 + (tid & 3) * 16) = k2reg; } } while (0)
  AT_PREFETCH(0);
  AT_STORE(0);
  __syncthreads();
  float tvfar[4] = {0.f, 0.f, 0.f, 0.f};
  if (TYPE != 1) { const float bfar = tab[TAB_PAD + (TYPE == 0 ? 2032 : 2047)];
#pragma unroll
    for (int j = 0; j < 4; ++j) tvfar[j] = (TYPE == 2 || ((fr - 4 * fq - j) & 15) == 0) ? bfar : NEGV; }
#pragma unroll 1
  for (int kt = 0; kt < nkt; ++kt) {
    const int bufo = (kt & 1) * AT_BUF;
    const u64 mcur0 = mreg[0], mcur1 = mreg[1];
    if (kt + 1 < nkt) AT_PREFETCH(kt + 1);
    const int kbase = kt * 64;
    if (kbase <= q0 + 31) {
      bf16x8 kf[4][KS];
#pragma unroll
      for (int k16 = 0; k16 < 4; ++k16)
#pragma unroll
        for (int ss = 0; ss < KS; ++ss) kf[k16][ss] = *(const LAS bf16x8*)(l3 + bufo + (k16 * 16 + fr) * KROW + ss * 64 + fq * 16);
      float tv[2][16];
      if (TYPE != 1) {
        if (q0 - kbase - 63 >= (TYPE == 0 ? 513 : 113)) {
#pragma unroll
          for (int u = 0; u < 2; ++u)
#pragma unroll
            for (int k16 = 0; k16 < 4; ++k16)
#pragma unroll
              for (int j = 0; j < 4; ++j) tv[u][k16 * 4 + j] = tvfar[j];
        } else {
#pragma unroll
          for (int u = 0; u < 2; ++u) { const float* tp = tab + (q0 + u * 16 + fr - kbase + TAB_PAD - fq * 4);
#pragma unroll
            for (int k16 = 0; k16 < 4; ++k16)
#pragma unroll
              for (int j = 0; j < 4; ++j) tv[u][k16 * 4 + j] = tp[-(k16 * 16 + j)]; }
        }
      }
      __builtin_amdgcn_sched_barrier(0);
      f32x4 s[4][2];
#pragma unroll
      for (int k16 = 0; k16 < 4; ++k16) {
        s[k16][0] = (f32x4){sinit[0], sinit[0], sinit[0], sinit[0]}; s[k16][1] = (f32x4){sinit[1], sinit[1], sinit[1], sinit[1]};
#pragma unroll
        for (int ss = 0; ss < KS; ++ss) {
          s[k16][0] = __builtin_amdgcn_mfma_f32_16x16x32_bf16(kf[k16][ss], qf[0][ss], s[k16][0], 0, 0, 0);
          s[k16][1] = __builtin_amdgcn_mfma_f32_16x16x32_bf16(kf[k16][ss], qf[1][ss], s[k16][1], 0, 0, 0);
        }
      }
      __builtin_amdgcn_sched_barrier(0);
      s16x4 vv[2][4][2];
#pragma unroll
      for (int kc = 0; kc < 2; ++kc)
#pragma unroll
        for (int dt = 0; dt < 4; ++dt) {
          const LAS unsigned char* vb = l3 + bufo + AT_VOFF + (kc * 32 + 4 * fq + (fr >> 2)) * VROW + (dt * 16 + 4 * (fr & 3)) * 2;
          vv[kc][dt][0] = vtr(vb); vv[kc][dt][1] = vtr(vb + 16 * VROW);
        }
      __builtin_amdgcn_sched_barrier(0);
      const bool diag = (kbase + 63 > q0);
      bf16x8 pb[2][2];
#pragma unroll
      for (int u = 0; u < 2; ++u) {
        const int qpos = q0 + u * 16 + fr;
        unsigned wlo = 0u, whi = 0u;
        if (TYPE == 2) { const u64 mw = u ? mcur1 : mcur0; wlo = (unsigned)mw >> (fq * 4); whi = (unsigned)(mw >> 32) >> (fq * 4); }
        float ps = 0.f;
#pragma unroll
        for (int k16 = 0; k16 < 4; ++k16)
#pragma unroll
          for (int j = 0; j < 4; ++j) {
            float v;
            if (TYPE != 1) v = __builtin_fmaf(s[k16][u][j], c2, tv[u][k16 * 4 + j]);
            else { v = s[k16][u][j] * c2; if (diag) v = (kbase + k16 * 16 + fq * 4 + j > qpos) ? NEGV : v; }
            float e = __builtin_amdgcn_exp2f(v);
            if (TYPE == 2) { unsigned sel; asm("v_bfe_i32 %0, %1, %2, 1" : "=v"(sel) : "v"((k16 < 2) ? wlo : whi), "n"((k16 & 1) * 16 + j));
              e = __builtin_bit_cast(float, __builtin_bit_cast(unsigned, e) & sel); }
            s[k16][u][j] = e; ps += e;
          }
        lrow[u] += ps;
#pragma unroll
        for (int kc = 0; kc < 2; ++kc) {
          u32x4 w; w.x = cvt_pk_bf16(s[2 * kc][u][0], s[2 * kc][u][1]); w.y = cvt_pk_bf16(s[2 * kc][u][2], s[2 * kc][u][3]);
          w.z = cvt_pk_bf16(s[2 * kc + 1][u][0], s[2 * kc + 1][u][1]); w.w = cvt_pk_bf16(s[2 * kc + 1][u][2], s[2 * kc + 1][u][3]);
          pb[u][kc] = __builtin_bit_cast(bf16x8, w);
        }
      }
#pragma unroll
      for (int kc = 0; kc < 2; ++kc)
#pragma unroll
        for (int dt = 0; dt < 4; ++dt) {
          const bf16x8 vf = __builtin_shufflevector(vv[kc][dt][0], vv[kc][dt][1], 0, 1, 2, 3, 4, 5, 6, 7);
          o[dt][0] = __builtin_amdgcn_mfma_f32_16x16x32_bf16(vf, pb[0][kc], o[dt][0], 0, 0, 0);
          o[dt][1] = __builtin_amdgcn_mfma_f32_16x16x32_bf16(vf, pb[1][kc], o[dt][1], 0, 0, 0);
        }
    }
    if (kt + 1 < nkt) AT_STORE(AT_BUF - bufo);
    __syncthreads();
  }
#undef AT_PREFETCH
#undef AT_STORE
  bf16_t* outp = (bf16_t*)(p.ws + WS_NB);
#pragma unroll
  for (int u = 0; u < 2; ++u) {
    float l = lrow[u]; l += __shfl_xor(l, 16); l += __shfl_xor(l, 32);
    const float il = 1.f / l;
    bf16_t* orow = outp + (rowb + q0 + u * 16 + fr) * DM + head * 64 + fq * 4;
#pragma unroll
    for (int dt = 0; dt < 4; ++dt) { u32x2 w; w.x = cvt_pk_bf16(o[dt][u][0] * il, o[dt][u][1] * il); w.y = cvt_pk_bf16(o[dt][u][2] * il, o[dt][u][3] * il);
      *(u32x2*)(orow + dt * 16) = w; }
  }
}
__device__ __forceinline__ void phase_attn(const Params& p, unsigned char* lds, int l) {
  constexpr int NITEMS = BATCH * 16 * 8;
  for (int it = blockIdx.x; it < NITEMS; it += gridDim.x) {
    const int r = it >> 8, c = it & 255;
    const int qb = (r & 1) ? (r >> 1) : 7 - (r >> 1), b = c >> 4, head = ((c & 15) + 2 * r) & 15;
    if (head < 6) attn_item<2, 0>(p, lds, b, head, qb, l);
    else if (head < 11) attn_item<3, 1>(p, lds, b, head, qb, l);
    else attn_item<2, 2>(p, lds, b, head, qb, l);
  }
  __syncthreads();
}

#define XB_TMO      128
#define XB_XCNT(j)  (256  + 64 * (j))
#define XB_XSUB(j)  (1280 + 64 * (j))
#define XB_XGEN(j)  (2304 + 64 * (j))
#define XB_TOP      3328
#define XB_TOPGEN   3392
#define XCD_BAR_WORDS 3456
#define XB_SPIN_CAP (1u << 18)
__device__ __forceinline__ unsigned xb_ld(unsigned* p)              { return __hip_atomic_load(p, __ATOMIC_RELAXED, __HIP_MEMORY_SCOPE_AGENT); }
__device__ __forceinline__ unsigned xb_add(unsigned* p, unsigned v) { return __hip_atomic_fetch_add(p, v, __ATOMIC_RELAXED, __HIP_MEMORY_SCOPE_AGENT); }
__device__ __forceinline__ unsigned xb_xcc_id() { return (unsigned)__builtin_amdgcn_s_getreg((3 << 11) | 20) & 0xFu; }
#define XB_SPIN(cond, bar) do { unsigned _sp = 0; while (cond) { __builtin_amdgcn_s_sleep(1); \
    if ((++_sp & 255u) == 0u) { if (xb_ld(&(bar)[XB_TMO])) break; if (_sp > XB_SPIN_CAP) { atomicAdd(&(bar)[XB_TMO], 1u); break; } } } } while (0)
struct XcdBarrier { unsigned* bar; unsigned x; volatile LAS unsigned* st; };
__device__ __forceinline__ XcdBarrier xcd_barrier_post(unsigned* bar, volatile LAS unsigned* st) {
  XcdBarrier b; b.bar = bar; b.x = xb_xcc_id(); b.st = st;
  if (threadIdx.x == 0) (void)xb_add(&bar[XB_XCNT(b.x)], 1u);
  return b;
}
__device__ __forceinline__ void xcd_barrier_complete(unsigned* bar, unsigned x, unsigned& nloc, unsigned& nx) {
  const unsigned G = gridDim.x * gridDim.y * gridDim.z;
  unsigned sum, cnt, mine, sp = 0u;
  for (;;) {
    sum = 0u; cnt = 0u; mine = 0u;
#pragma unroll
    for (unsigned j = 0; j < 16; ++j) { const unsigned c = xb_ld(&bar[XB_XCNT(j)]); sum += c; cnt += (c > 0u) ? 1u : 0u; mine = (j == x) ? c : mine; }
    if (sum == G) break;
    __builtin_amdgcn_s_sleep(1);
    if ((++sp & 255u) == 0u) { if (xb_ld(&bar[XB_TMO])) break; if (sp > XB_SPIN_CAP) { atomicAdd(&bar[XB_TMO], 1u); break; } }
  }
  nloc = mine > 0u ? mine : 1u; nx = cnt > 0u ? cnt : 1u;
}
__device__ __forceinline__ void xcd_barrier(const XcdBarrier& b) {
  asm volatile("s_waitcnt vmcnt(0)" ::: "memory");
  __syncthreads();
  if (threadIdx.x == 0) {
    unsigned* bar = b.bar;
    __builtin_amdgcn_s_waitcnt(0);
    unsigned nloc = b.st[0], nx = b.st[1];
    if (nloc == 0u) { xcd_barrier_complete(bar, b.x, nloc, nx); b.st[0] = nloc; b.st[1] = nx; }
    const unsigned old = xb_add(&bar[XB_XSUB(b.x)], 1u);
    const unsigned gen = old / nloc;
    if (old + 1u == (gen + 1u) * nloc) {
      __builtin_amdgcn_fence(__ATOMIC_RELEASE, "agent");
      asm volatile("s_waitcnt vmcnt(0)" ::: "memory");
      const unsigned og = xb_add(&bar[XB_TOP], 1u);
      const unsigned tg = og / nx;
      if (og + 1u == (tg + 1u) * nx) xb_add(&bar[XB_TOPGEN], 1u);
      else XB_SPIN(xb_ld(&bar[XB_TOPGEN]) == tg, bar);
      __builtin_amdgcn_fence(__ATOMIC_ACQUIRE, "agent");
      xb_add(&bar[XB_XGEN(b.x)], 1u);
      asm volatile("s_waitcnt vmcnt(0)" ::: "memory");
    } else {
      XB_SPIN(xb_ld(&bar[XB_XGEN(b.x)]) == gen, bar);
      __builtin_amdgcn_fence(__ATOMIC_ACQUIRE, "agent");
      asm volatile("s_waitcnt vmcnt(0)" ::: "memory");
    }
  }
  __syncthreads();
}

#ifndef PHMASK
#define PHMASK 0xFFFFu
#endif
#ifndef DUPMASK
#define DUPMASK 0u
#endif
__global__ void __launch_bounds__(512) mega(Params p_unused) {
#if defined(__HIP_DEVICE_COMPILE__)
  extern __shared__ __attribute__((aligned(16))) unsigned char lds[];
  cg::grid_group grid = cg::this_grid();
  { volatile LAS unsigned* st = (volatile LAS unsigned*)((LAS unsigned char*)lds + (LDS_BYTES - 16)); if (threadIdx.x < 2) st[threadIdx.x] = 0u; }
  __syncthreads();
  (void)xcd_barrier_post((unsigned*)((*kparams()).ws + WS_BAR), (volatile LAS unsigned*)((LAS unsigned char*)lds + (LDS_BYTES - 16)));
  int nsteps = 3 + 10 * DEPTH + 1;
  asm volatile("" : "+s"(nsteps));
#pragma unroll 1
  for (int step = 0; step < nsteps; ++step) {
    const Params p = *kparams();
    if (step == 0) { phase0(p, lds); }
    else if (step == 1) { phase_mod_reduce(p); }
    else if (step == 2) { phase_cvec(p); phase_norm0(p.x, p.norm_ffn1, (const float*)(p.ws + WS_MOD) + 1 * DM, (bf16_t*)(p.ws + WS_NB), (float*)(p.ws + WS_SSQ)); }
    else if (step == nsteps - 1) { phase_final_norm(p.out, p.final_norm); }
    else {
      const int l = (step - 3) / 10, si = (step - 3) % 10, sub = si + 1 + (si >= 2) + (si >= 8);
      unsigned char* wl = p.ws + WS_W + (size_t)l * WL_STRIDE;
      const float* mod = (const float*)(p.ws + WS_MOD) + (size_t)l * 16 * MODW;
      const float* hin = (l == 0) ? p.x : p.out;
      bf16_t* NB = (bf16_t*)(p.ws + WS_NB); bf16_t* BIG = (bf16_t*)(p.ws + WS_BIG); bf16_t* HID2 = (bf16_t*)(p.ws + WS_BIG + 64 * MiB);
      float* ssq = (float*)(p.ws + WS_SSQ); const float* cvl = (const float*)(p.ws + WS_CV) + (size_t)l * 3 * CV_STRIDE;
      if (sub == 5) { phase_prep(p, l); }
      else if (sub == 7) { phase_qrope(p, l); phase_indexer(p, lds); }
      else if (sub == 8) { phase_attn(p, lds, l); }
      else {
        const bool isgu = (sub == 1 || sub == 11), isdn = (sub == 2 || sub == 12);
        const bf16_t* A = (sub == 2 || sub == 11) ? BIG : (sub == 12) ? HID2 : (sub == 6) ? (const bf16_t*)(p.ws + WS_MLAA) : NB;
        const size_t wo = (sub == 1) ? WO_GU1 : (sub == 11) ? WO_GU2 : (sub == 2) ? WO_D1 : (sub == 12) ? WO_D2 : (sub == 4) ? WO_IN : (sub == 6) ? WO_MLA : WO_OUT;
        const bf16_t* Bt = (const bf16_t*)(wl + wo);
        const int N = isgu ? NGU : (sub == 4) ? INWP : (sub == 6) ? MLA_N : DM, K = isdn ? DFF : (sub == 6) ? MLA_K : DM;
        pg8::EpiDyn E; E.sub = sub; E.l = l;
        run_gemm(lds, A, Bt, N, K, E);
      }
    }
    if (step == 0) grid.sync();
    else { XcdBarrier xbar; xbar.bar = (unsigned*)((*kparams()).ws + WS_BAR); xbar.x = xb_xcc_id(); xbar.st = (volatile LAS unsigned*)((LAS unsigned char*)lds + (LDS_BYTES - 16)); xcd_barrier(xbar); }
  }
#endif
}

extern "C" void kernel_launch(void* const* d_in, const int* in_sizes, int n_in, void* d_out, int out_size, void* d_ws, size_t ws_size, hipStream_t stream) {
  static int grid_blocks = 0;
  if (!grid_blocks) {
    int dev = 0, cus = 0, per_cu = 0;
    (void)hipGetDevice(&dev);
    (void)hipDeviceGetAttribute(&cus, hipDeviceAttributeMultiprocessorCount, dev);
    (void)hipFuncSetAttribute((const void*)mega, hipFuncAttributeMaxDynamicSharedMemorySize, LDS_BYTES);
    (void)hipOccupancyMaxActiveBlocksPerMultiprocessor(&per_cu, (const void*)mega, 512, LDS_BYTES);
    if (per_cu < 1) per_cu = 1;
    grid_blocks = cus * per_cu;
    if (ws_size < WS_END) fprintf(stderr, "kernel_launch: workspace too small: %zu < %zu\n", ws_size, (size_t)WS_END);
  }
  Params p{};
  p.x = (const float*)d_in[0]; p.c = (const float*)d_in[1]; p.pos = (const int*)d_in[2]; p.rel_bias = (const float*)d_in[3]; p.ada_w = (const float*)d_in[4]; p.ada_b = (const float*)d_in[5];
  p.norm_ffn1 = (const float*)d_in[6]; p.ffn1_gu = (const float*)d_in[7]; p.ffn1_down = (const float*)d_in[8]; p.norm_mix = (const float*)d_in[9]; p.w_in = (const float*)d_in[10];
  p.q_norm = (const float*)d_in[11]; p.w_uq = (const float*)d_in[12]; p.kv_norm = (const float*)d_in[13]; p.w_ukv = (const float*)d_in[14]; p.ik_norm = (const float*)d_in[15]; p.w_out = (const float*)d_in[16];
  p.norm_ffn2 = (const float*)d_in[17]; p.ffn2_gu = (const float*)d_in[18]; p.ffn2_down = (const float*)d_in[19]; p.final_norm = (const float*)d_in[20];
  p.out = (float*)d_out; p.ws = (unsigned char*)d_ws;
  (void)hipMemsetAsync((unsigned char*)d_ws + WS_BAR, 0, 16384, stream);
  void* args[] = {&p};
  hipError_t e = hipLaunchCooperativeKernel((void*)mega, dim3(grid_blocks), dim3(512), args, LDS_BYTES, stream);
  if (e != hipSuccess) fprintf(stderr, "cooperative launch failed: %s (grid %d)\n", hipGetErrorString(e), grid_blocks);
}
```
